# Optimizing an MI355X kernel written in HIP

```python
import math
import jax, jax.numpy as jnp
from jax import lax
import numpy as np

D_MODEL = 2048
BATCH = 4
SEQ = 4096
DEPTH = 2

HG_HEADS = 4
HG_DK = 128
HG_DV = 128
HG_WIDTH = HG_HEADS * HG_DV
HG_CHUNK = 128
SW_Q_HEADS = 16
SW_KV_HEADS = 2
SW_HEAD_DIM = 64
SW_WIDTH = SW_Q_HEADS * SW_HEAD_DIM
SW_KV_WIDTH = SW_KV_HEADS * SW_HEAD_DIM
SW_WINDOW = 128
SW_BLOCK = 128
SG_GROUPS = 4
SG_GROUP_DIM = 128
SG_WIDTH = SG_GROUPS * SG_GROUP_DIM
SG_CHUNK = 128
D_MIX = HG_WIDTH + SW_WIDTH + SG_WIDTH
IN_WIDTHS = (HG_WIDTH, HG_HEADS * HG_DK, HG_WIDTH, HG_WIDTH, SW_WIDTH, SW_KV_WIDTH, SW_KV_WIDTH, SG_WIDTH, SG_WIDTH)
D_IN = sum(IN_WIDTHS)
N_EXPERTS = 64
TOP_K = 8
D_EXPERT = 512
D_SHARED = 512
N_EXPERT_GROUPS = 8
TOPK_GROUPS = 4
ROUTED_SCALE = 2.5
MOE_BLOCK = 512
ALPHA = (2 * DEPTH) ** 0.25
BETA = (8 * DEPTH) ** -0.25
LN_EPS = 1e-5
RMS_EPS = 1e-6

kernel_name = 'hybrid_hgrn2_swa_gmlp_moe_deepnorm'


def layer_norm(x, g, b):
    xf = x.astype(jnp.float32)
    mu = jnp.mean(xf, axis=-1, keepdims=True)
    xc = xf - mu
    var = jnp.mean(xc * xc, axis=-1, keepdims=True)
    return (xc * lax.rsqrt(var + LN_EPS) * g.astype(jnp.float32) + b.astype(jnp.float32)).astype(x.dtype)


def rms_norm(x, g):
    xf = x.astype(jnp.float32)
    return xf * lax.rsqrt(jnp.mean(xf * xf, axis=-1, keepdims=True) + RMS_EPS) * g.astype(jnp.float32)


def hgrn_lower_bounds(lb_logits):
    p = jax.nn.softmax(lb_logits.astype(jnp.float32), axis=0)
    c = jnp.cumsum(p, axis=0)
    return c - c[0:1]


def hgrn2_mixer(q, f_logit, i, g, lb, gain):
    B, S, _ = q.shape
    nc = S // HG_CHUNK
    f32 = jnp.float32
    q = jax.nn.silu(q.astype(f32))
    f_logit = f_logit.astype(f32)
    lb = lb.astype(f32)
    log_f = jnp.logaddexp(jnp.log(lb), jnp.log1p(-lb) + jax.nn.log_sigmoid(f_logit))
    k = (1.0 - lb) * jax.nn.sigmoid(-f_logit)

    def to_chunks(a):
        return a.reshape(B, nc, HG_CHUNK, HG_HEADS, -1).transpose(1, 0, 3, 2, 4)

    tri = jnp.tril(jnp.ones((HG_CHUNK, HG_CHUNK), bool))[:, :, None]

    def step(state, inp):
        qc, kc, vc, lfc = inp
        b = jnp.cumsum(lfc, axis=2)
        o_inter = jnp.einsum('bhtk,bhkv->bhtv', qc * jnp.exp(b), state)
        diff = b[:, :, :, None, :] - b[:, :, None, :, :]
        decay = jnp.exp(jnp.where(tri, diff, -jnp.inf))
        scores = jnp.einsum('bhtsk,bhsk->bhts', qc[:, :, :, None, :] * decay, kc)
        o_intra = jnp.einsum('bhts,bhsv->bhtv', scores, vc)
        b_end = b[:, :, -1, :]
        k_dec = kc * jnp.exp(b_end[:, :, None, :] - b)
        state = jnp.exp(b_end)[..., None] * state + jnp.einsum('bhsk,bhsv->bhkv', k_dec, vc)
        return state, o_inter + o_intra

    s0 = jnp.zeros((B, HG_HEADS, HG_DK, HG_DV), f32)
    _, o = lax.scan(step, s0, (to_chunks(q), to_chunks(k), to_chunks(i.astype(f32)), to_chunks(log_f)))
    o = o.transpose(1, 0, 3, 2, 4).reshape(B, S, HG_HEADS, HG_DV)
    o = rms_norm(o, gain.reshape(HG_HEADS, HG_DV))
    return o.reshape(B, S, HG_WIDTH) * jax.nn.silu(g.astype(f32))


def swa_mixer(q, k, v, sinks, gain):
    B, S, _ = q.shape
    nb = S // SW_BLOCK
    G = SW_Q_HEADS // SW_KV_HEADS
    f32 = jnp.float32
    qb = q.astype(f32).reshape(B, nb, SW_BLOCK, SW_KV_HEADS, G, SW_HEAD_DIM)
    pad = ((0, 0), (SW_BLOCK, 0), (0, 0))
    kp = jnp.pad(k.astype(f32), pad).reshape(B, nb + 1, SW_BLOCK, SW_KV_HEADS, SW_HEAD_DIM)
    vp = jnp.pad(v.astype(f32), pad).reshape(B, nb + 1, SW_BLOCK, SW_KV_HEADS, SW_HEAD_DIM)
    kband = jnp.concatenate([kp[:, :-1], kp[:, 1:]], axis=2)
    vband = jnp.concatenate([vp[:, :-1], vp[:, 1:]], axis=2)
    scores = jnp.einsum('bntkgd,bnskd->bnkgts', qb, kband) * (SW_HEAD_DIM ** -0.5)
    t = jnp.arange(SW_BLOCK)[:, None]
    s = jnp.arange(2 * SW_BLOCK)[None, :]
    rel = t + SW_BLOCK - s
    band = (rel >= 0) & (rel < SW_WINDOW)
    key_pos = jnp.arange(nb)[:, None] * SW_BLOCK + jnp.arange(2 * SW_BLOCK)[None, :] - SW_BLOCK
    mask = band[None] & (key_pos >= 0)[:, None, :]
    scores = jnp.where(mask[None, :, None, None], scores, -jnp.inf)
    sink = sinks.astype(f32).reshape(1, 1, SW_KV_HEADS, G, 1, 1)
    m = jnp.maximum(scores.max(axis=-1, keepdims=True), sink)
    p = jnp.exp(scores - m)
    denom = p.sum(axis=-1, keepdims=True) + jnp.exp(sink - m)
    o = jnp.einsum('bnkgts,bnskd->bntkgd', p / denom, vband)
    return rms_norm(o.reshape(B, S, SW_WIDTH), gain)


def sgu_mixer(u, v, ln_g, ln_b, w_s, b_s, gain):
    B, S, _ = u.shape
    nc = S // SG_CHUNK
    f32 = jnp.float32
    u = jax.nn.gelu(u.astype(f32), approximate=False)
    v = jax.nn.gelu(v.astype(f32), approximate=False)
    v = layer_norm(v, ln_g, ln_b)
    v = v.reshape(B, nc, SG_CHUNK, SG_GROUPS, SG_GROUP_DIM)
    w = w_s.astype(f32) * jnp.tril(jnp.ones((SG_CHUNK, SG_CHUNK), f32))[None]
    mixed = jnp.einsum('gts,bnsgc->bntgc', w, v) + b_s.astype(f32).T[None, None, :, :, None]
    o = u * mixed.reshape(B, S, SG_WIDTH)
    return rms_norm(o, gain)


def swiglu(x, wg, wu, wd):
    return (jax.nn.silu(x @ wg) * (x @ wu)) @ wd


def moe_ffn(x, router_w, router_bias, w_gate, w_up, w_down, sh_gate, sh_up, sh_down):
    B, S, D = x.shape
    T = B * S
    TK = T * TOP_K
    xf = x.reshape(T, D)
    scores = jax.nn.sigmoid((xf @ router_w).astype(jnp.float32))
    sel = scores + router_bias.astype(jnp.float32)
    per_group = N_EXPERTS // N_EXPERT_GROUPS
    grp_score = lax.top_k(sel.reshape(T, N_EXPERT_GROUPS, per_group), 2)[0].sum(-1)
    _, top_grp = lax.top_k(grp_score, TOPK_GROUPS)
    grp_mask = jnp.any(top_grp[..., None] == jnp.arange(N_EXPERT_GROUPS), axis=-2)
    sel = jnp.where(jnp.repeat(grp_mask, per_group, axis=-1), sel, -jnp.inf)
    _, eidx = lax.top_k(sel, TOP_K)
    gates = jnp.take_along_axis(scores, eidx, axis=-1)
    gates = gates / gates.sum(-1, keepdims=True) * ROUTED_SCALE

    flat_e = eidx.reshape(TK).astype(jnp.int32)
    flat_g = gates.reshape(TK)
    sorted_e, order = lax.sort((flat_e, jnp.arange(TK, dtype=jnp.int32)), num_keys=1, is_stable=True)
    counts = jnp.bincount(flat_e, length=N_EXPERTS)
    starts = jnp.cumsum(counts) - counts
    padded = (counts + MOE_BLOCK - 1) // MOE_BLOCK * MOE_BLOCK
    pend = jnp.cumsum(padded)
    pstart = pend - padded
    dest = pstart[sorted_e] + (jnp.arange(TK) - starts[sorted_e])
    n_blocks = TK // MOE_BLOCK + N_EXPERTS
    P = n_blocks * MOE_BLOCK
    slot = jnp.full((P,), TK, jnp.int32).at[dest].set(order)
    valid = slot < TK
    tok = jnp.where(valid, slot // TOP_K, 0)
    wts = jnp.where(valid, flat_g[jnp.minimum(slot, TK - 1)], 0.0)
    block_e = jnp.minimum(jnp.searchsorted(pend, jnp.arange(n_blocks) * MOE_BLOCK, side='right'), N_EXPERTS - 1)

    def body(y, inp):
        tk, wt, e = inp
        xb = xf[tk]
        yb = swiglu(xb, w_gate[e], w_up[e], w_down[e]) * wt[:, None]
        return y.at[tk].add(yb.astype(y.dtype)), None

    y0 = swiglu(xf, sh_gate, sh_up, sh_down)
    y, _ = lax.scan(body, y0, (tok.reshape(n_blocks, MOE_BLOCK), wts.reshape(n_blocks, MOE_BLOCK), block_e))
    return y.reshape(B, S, D)


def setup_inputs(seed: int = 0) -> dict:
    key = jax.random.key(seed)
    ks = jax.random.split(key, 32)
    n = jax.random.normal
    f32 = jnp.float32
    L, D, E, F = DEPTH, D_MODEL, N_EXPERTS, D_EXPERT
    return {
        'x': n(ks[0], (BATCH, SEQ, D), f32),
        'ln0_gain': 1.0 + 0.01 * n(ks[1], (D,), f32),
        'ln0_bias': 0.01 * n(ks[2], (D,), f32),
        'w_in': n(ks[3], (L, D, D_IN), f32) * D ** -0.5,
        'b_in': 0.01 * n(ks[4], (L, D_IN), f32),
        'hg_lb_logits': n(ks[5], (L, HG_HEADS * HG_DK), f32),
        'sw_sinks': n(ks[6], (L, SW_Q_HEADS), f32),
        'sg_ln_gain': 1.0 + 0.01 * n(ks[7], (L, SG_WIDTH), f32),
        'sg_ln_bias': 0.01 * n(ks[8], (L, SG_WIDTH), f32),
        'sg_w_s': n(ks[9], (L, SG_GROUPS, SG_CHUNK, SG_CHUNK), f32) * SG_CHUNK ** -0.5,
        'sg_b_s': 1.0 + 0.1 * n(ks[10], (L, SG_GROUPS, SG_CHUNK), f32),
        'mix_gain': 1.0 + 0.01 * n(ks[11], (L, D_MIX), f32),
        'w_out': n(ks[12], (L, D_MIX, D), f32) * (D_MIX ** -0.5 * BETA),
        'ln1_gain': 1.0 + 0.01 * n(ks[13], (L, D), f32),
        'ln1_bias': 0.01 * n(ks[14], (L, D), f32),
        'router_w': n(ks[15], (L, D, E), f32) * D ** -0.5,
        'router_bias': 0.01 * n(ks[16], (L, E), f32),
        'exp_w_gate': n(ks[17], (L, E, D, F), f32) * D ** -0.5,
        'exp_w_up': n(ks[18], (L, E, D, F), f32) * D ** -0.5,
        'exp_w_down': n(ks[19], (L, E, F, D), f32) * (F ** -0.5 * BETA),
        'sh_w_gate': n(ks[20], (L, D, D_SHARED), f32) * D ** -0.5,
        'sh_w_up': n(ks[21], (L, D, D_SHARED), f32) * D ** -0.5,
        'sh_w_down': n(ks[22], (L, D_SHARED, D), f32) * (D_SHARED ** -0.5 * BETA),
        'ln2_gain': 1.0 + 0.01 * n(ks[23], (L, D), f32),
        'ln2_bias': 0.01 * n(ks[24], (L, D), f32),
    }


def reference(x, ln0_gain, ln0_bias, w_in, b_in, hg_lb_logits, sw_sinks, sg_ln_gain, sg_ln_bias, sg_w_s, sg_b_s, mix_gain, w_out, ln1_gain, ln1_bias, router_w, router_bias, exp_w_gate, exp_w_up, exp_w_down, sh_w_gate, sh_w_up, sh_w_down, ln2_gain, ln2_bias):
    lbs = hgrn_lower_bounds(hg_lb_logits)
    offs = []
    acc = 0
    for w in IN_WIDTHS[:-1]:
        acc += w
        offs.append(acc)
    a0, a1 = HG_WIDTH, HG_WIDTH + SW_WIDTH
    h = layer_norm(x, ln0_gain, ln0_bias)
    for l in range(DEPTH):
        proj = jnp.einsum('bsd,dn->bsn', h, w_in[l]) + b_in[l]
        hq, hf, hi, hg, aq, ak, av, su, sv = jnp.split(proj, offs, axis=-1)
        o_a = hgrn2_mixer(hq, hf, hi, hg, lbs[l], mix_gain[l, :a0])
        o_b = swa_mixer(aq, ak, av, sw_sinks[l], mix_gain[l, a0:a1])
        o_c = sgu_mixer(su, sv, sg_ln_gain[l], sg_ln_bias[l], sg_w_s[l], sg_b_s[l], mix_gain[l, a1:])
        mixed = jnp.concatenate([o_a, o_b, o_c], axis=-1).astype(h.dtype)
        mixed = jnp.einsum('bsm,md->bsd', mixed, w_out[l])
        h = layer_norm(ALPHA * h + mixed, ln1_gain[l], ln1_bias[l])
        ffn = moe_ffn(h, router_w[l], router_bias[l], exp_w_gate[l], exp_w_up[l], exp_w_down[l], sh_w_gate[l], sh_w_up[l], sh_w_down[l])
        h = layer_norm(ALPHA * h + ffn.astype(h.dtype), ln2_gain[l], ln2_bias[l])
    return h
```

```cpp
#include <hip/hip_runtime.h>
#include <cstdio>
#include <cstdint>

#define GAS __attribute__((address_space(1)))
#define LAS __attribute__((address_space(3)))
typedef unsigned short bf16;
typedef unsigned short bf16_t;
typedef short bf16x8 __attribute__((ext_vector_type(8)));
typedef float f32x4 __attribute__((ext_vector_type(4)));
typedef float f32x2 __attribute__((ext_vector_type(2)));
typedef unsigned u32x4 __attribute__((ext_vector_type(4)));
typedef unsigned u32x2 __attribute__((ext_vector_type(2)));

constexpr int NTOK = 16384, DM = 2048, DIN = 4352, SEQ = 4096, NBATCH = 4;
constexpr int NE = 64, TOPK = 8, DE = 512;
constexpr float ALPHA = 1.4142135623730951f, LN_EPS = 1e-5f, RMS_EPS = 1e-6f, ROUTED_SCALE = 2.5f;
constexpr int C_HQ = 0, C_HF = 512, C_HI = 1024, C_HG = 1536, C_AQ = 2048, C_AK = 3072, C_AV = 3200, C_SU = 3328, C_SV = 3840;
constexpr int MAXTILES = 576;
constexpr int SH_ROW0 = MAXTILES * 256;
constexpr int HS_ROWS = SH_ROW0 + NTOK;

constexpr size_t MiB = 1u << 20;
constexpr size_t WS_CTL = 0, CTL_ZERO_BYTES = 1 * MiB;
constexpr size_t WS_LIST = 1 * MiB;
constexpr size_t WS_WLIST = 5 * MiB;
constexpr size_t WS_SLOT = 9 * MiB;
constexpr size_t WS_DEND = 10 * MiB;
constexpr size_t WS_STATE = 16 * MiB;
constexpr size_t WS_HF = 64 * MiB;
constexpr size_t WS_HB = 192 * MiB;
constexpr size_t WS_PROJ = 256 * MiB;
constexpr size_t WS_MIXED = 392 * MiB;
constexpr size_t WS_HS = 456 * MiB;
constexpr size_t WS_Y = 616 * MiB;
constexpr size_t WS_W = 1192 * MiB;
constexpr size_t W_IN_B = (size_t)DIN * DM * 2, W_OUT_B = (size_t)DM * DM * 2, W_GU_B = (size_t)1024 * DM * 2, W_D_B = (size_t)DM * DE * 2;
constexpr size_t WL_IN = 0, WL_OUT = W_IN_B, WL_GU = WL_OUT + W_OUT_B, WL_D = WL_GU + 65 * W_GU_B, WL_BYTES = WL_D + 65 * W_D_B;
constexpr size_t WS_END = WS_W + 2 * WL_BYTES;
static_assert(WS_HS + (size_t)HS_ROWS * 512 * 2 <= WS_Y && WS_Y + (size_t)MAXTILES * 256 * DM * 2 <= WS_W && WS_END <= 2048 * MiB, "d_ws map");
constexpr int CW_CNT = 64;
constexpr int CW_BAR = 4096;

constexpr int LDS_BYTES = 147456;
constexpr int MISC_OFF = LDS_BYTES - 256;
constexpr int TAB_OFF = 131072;
constexpr int NWAVES = 8, NTHR = 512;

#define LDS_WAIT() asm volatile("s_waitcnt lgkmcnt(0)" ::: "memory")
#define VM_WAIT() asm volatile("s_waitcnt vmcnt(0)" ::: "memory")
#define RLX_AGENT __ATOMIC_RELAXED, __HIP_MEMORY_SCOPE_AGENT

__device__ __forceinline__ unsigned f2bf(float f) { unsigned u = __builtin_bit_cast(unsigned, f); return (u + 0x7fffu + ((u >> 16) & 1u)) >> 16; }
__device__ __forceinline__ unsigned pk2(float lo, float hi) { return f2bf(lo) | (f2bf(hi) << 16); }
__device__ __forceinline__ float bflo(unsigned w) { return __uint_as_float(w << 16); }
__device__ __forceinline__ float bfhi(unsigned w) { return __uint_as_float(w & 0xffff0000u); }
__device__ __forceinline__ float bf2f(bf16 v) { return __uint_as_float((unsigned)v << 16); }
__device__ __forceinline__ float wave_sum(float v) {
#pragma unroll
    for (int o = 1; o < 64; o <<= 1) v += __shfl_xor(v, o);
    return v;
}
__device__ __forceinline__ float sigmoidf_(float x) { return 1.0f / (1.0f + __expf(-x)); }
__device__ __forceinline__ float siluf_(float x) { return x / (1.0f + __expf(-x)); }
__device__ __forceinline__ float geluf_(float x) { return 0.5f * x * (1.0f + erff(x * 0.70710678118654752f)); }

namespace pg8 {
#define PG8_LAS __attribute__((address_space(3)))
constexpr int BM = 256, BK = 64, HALF = 128, HTB = HALF * BK * 2, STAGE_BYTES = 8 * HTB, NXCD = 8, WGM = 8;
__host__ __device__ __forceinline__ int lds_byte(int r, int c) { const int st = (r >> 4) * 2 + (c >> 5), rr = r & 15, cc = c & 31, ob = rr * 64 + cc * 2; return st * 1024 + (ob ^ (((ob >> 9) & 1) << 5)); }
__host__ __device__ __forceinline__ void stage_rc(int b, int& R, int& C) { const int st = b / 1024, sb = b % 1024, swz = sb ^ (((sb >> 9) & 1) << 5); R = (st >> 1) * 16 + swz / 64; C = (st & 1) * 32 + (swz % 64) / 2; }
__host__ __device__ __forceinline__ int perm32(int rho) { const int n = rho >> 4, i = rho & 15; return 8 * (i >> 2) + 4 * n + (i & 3); }

struct Unit { int pm, pn, e, p0, nv; };

__device__ __forceinline__ unsigned cvt_pk_bf16(float lo, float hi) { unsigned r; asm volatile("v_cvt_pk_bf16_f32 %0, %1, %2" : "=v"(r) : "v"(lo), "v"(hi)); return r; }

struct PlainSched {
    static constexpr bool GATHER = false;
    int nM, nN, nwg, G, c, K; const char* Bt;
    __device__ void init(int M, int N, int K_, int G_, int c_, const void* Bt_) { nM = M / BM; nN = N / BM; nwg = nM * nN; G = G_; c = c_; K = K_; Bt = (const char*)Bt_; }
    __device__ __forceinline__ bool next(int i, Unit& u) const {
        const long L = (long)i * G + c; if (L >= nwg) return false;
        int wgid = (int)L; { const int q = nwg / NXCD, r = nwg % NXCD, xcd = wgid % NXCD, off = wgid / NXCD; wgid = (xcd < r ? xcd * (q + 1) : r * (q + 1) + (xcd - r) * q) + off; }
        const int nig = WGM * nN, gid = wgid / nig, fm = gid * WGM, gsz = (nM - fm) < WGM ? (nM - fm) : WGM;
        u.pm = fm + ((wgid % nig) % gsz); u.pn = (wgid % nig) / gsz; u.e = 0; u.p0 = 0; u.nv = 256; return true;
    }
    __device__ __forceinline__ unsigned arow(const Unit& u, int r) const { return 0u; }
    __device__ __forceinline__ size_t aoff(const Unit& u) const { return (size_t)u.pm * BM * K * 2; }
    __device__ __forceinline__ const char* bbase(const Unit& u) const { return Bt + (size_t)u.pn * BM * K * 2; }
};
template <bool GATHER_> struct MoeSched {
    static constexpr bool GATHER = GATHER_;
    const PG8_LAS int* cnts; const PG8_LAS int* tstart; const PG8_LAS int* tile_e;
    int ntiles, npn, G, vcu, K; const int* list; const char* Bt; size_t estride;
    __device__ __forceinline__ bool next(int i, Unit& u) const {
        const int U = i * G + vcu; if (U >= ntiles * npn) return false;
        u.pm = U / npn; u.pn = U % npn; u.e = __builtin_amdgcn_readfirstlane(tile_e[u.pm]); u.p0 = (u.pm - __builtin_amdgcn_readfirstlane(tstart[u.e])) * BM; const int rem = __builtin_amdgcn_readfirstlane(cnts[u.e]) - u.p0; u.nv = rem < BM ? rem : BM; return true;
    }
    __device__ __forceinline__ unsigned arow(const Unit& u, int r) const { const int tok = (r < u.nv) ? list[u.e * NTOK + u.p0 + r] : 0; return (unsigned)tok * (unsigned)(K * 2); }
    __device__ __forceinline__ size_t aoff(const Unit& u) const { return (size_t)u.pm * BM * K * 2; }
    __device__ __forceinline__ const char* bbase(const Unit& u) const { return Bt + (size_t)u.e * estride + (size_t)u.pn * BM * K * 2; }
};

struct EpiBf16Bias {
    static constexpr bool PERM = true;
    bf16_t* O; int ldc; const float* bias;
    __device__ __forceinline__ void operator()(const f32x4 (&acc)[2][2][4][2], const Unit& u, int wr, int wc, int fr, int fq) const {
        const int row0 = u.pm * BM + wr * 64 + fr, col0 = u.pn * BM + wc * 32 + 8 * fq;
        f32x4 bv[2][2];
#pragma unroll
        for (int bj = 0; bj < 2; ++bj)
#pragma unroll
            for (int n = 0; n < 2; ++n) bv[bj][n] = *(const f32x4*)(bias + col0 + bj * HALF + 4 * n);
#pragma unroll
        for (int ai = 0; ai < 2; ++ai)
#pragma unroll
            for (int m = 0; m < 4; ++m) { bf16_t* rowp = O + (size_t)(row0 + ai * HALF + m * 16) * ldc + col0;
#pragma unroll
                for (int bj = 0; bj < 2; ++bj) { const f32x4 v0 = acc[ai][bj][m][0] + bv[bj][0], v1 = acc[ai][bj][m][1] + bv[bj][1];
                    u32x4 w; w.x = cvt_pk_bf16(v0[0], v0[1]); w.y = cvt_pk_bf16(v0[2], v0[3]); w.z = cvt_pk_bf16(v1[0], v1[1]); w.w = cvt_pk_bf16(v1[2], v1[3]);
                    *(u32x4*)(rowp + bj * HALF) = w; } }
    }
};
struct EpiResF32 {
    static constexpr bool PERM = false;
    float* C; int ldc; float alpha;
    __device__ __forceinline__ void operator()(const f32x4 (&acc)[2][2][4][2], const Unit& u, int wr, int wc, int fr, int fq) const {
        const int row0 = u.pm * BM + wr * 64 + fr, col0 = u.pn * BM + wc * 32 + 4 * fq;
#pragma unroll
        for (int ai = 0; ai < 2; ++ai)
#pragma unroll
            for (int m = 0; m < 4; ++m) { float* rowp = C + (size_t)(row0 + ai * HALF + m * 16) * ldc + col0;
#pragma unroll
                for (int bj = 0; bj < 2; ++bj)
#pragma unroll
                    for (int n = 0; n < 2; ++n) { f32x4* p = (f32x4*)(rowp + bj * HALF + n * 16); const f32x4 o = *p; *p = o * alpha + acc[ai][bj][m][n]; } }
    }
};
struct EpiSwiGLU {
    static constexpr bool PERM = true;
    bf16_t* O;
    __device__ __forceinline__ void operator()(const f32x4 (&acc)[2][2][4][2], const Unit& u, int wr, int wc, int fr, int fq) const {
        const int row0 = u.pm * BM + wr * 64 + fr, col0 = u.pn * HALF + wc * 32 + 8 * fq;
#pragma unroll
        for (int ai = 0; ai < 2; ++ai)
#pragma unroll
            for (int m = 0; m < 4; ++m) { bf16_t* rowp = O + (size_t)(row0 + ai * HALF + m * 16) * DE + col0;
                float o[8];
#pragma unroll
                for (int n = 0; n < 2; ++n)
#pragma unroll
                    for (int j = 0; j < 4; ++j) { const float g = acc[ai][0][m][n][j], up = acc[ai][1][m][n][j]; o[n * 4 + j] = g / (1.0f + __expf(-g)) * up; }
                u32x4 w; w.x = cvt_pk_bf16(o[0], o[1]); w.y = cvt_pk_bf16(o[2], o[3]); w.z = cvt_pk_bf16(o[4], o[5]); w.w = cvt_pk_bf16(o[6], o[7]);
                *(u32x4*)rowp = w; }
    }
};
struct EpiDownY {
    static constexpr bool PERM = true;
    bf16_t* Y; const float* wlist;
    __device__ __forceinline__ void operator()(const f32x4 (&acc)[2][2][4][2], const Unit& u, int wr, int wc, int fr, int fq) const {
        const int rl0 = wr * 64 + fr, col0 = u.pn * BM + wc * 32 + 8 * fq;
#pragma unroll
        for (int ai = 0; ai < 2; ++ai)
#pragma unroll
            for (int m = 0; m < 4; ++m) { const int rl = rl0 + ai * HALF + m * 16; const float w8 = (rl < u.nv) ? wlist[u.e * NTOK + u.p0 + rl] : 0.f;
                bf16_t* rowp = Y + (size_t)(u.pm * BM + rl) * DM + col0;
#pragma unroll
                for (int bj = 0; bj < 2; ++bj) { const f32x4 v0 = acc[ai][bj][m][0] * w8, v1 = acc[ai][bj][m][1] * w8;
                    u32x4 w; w.x = cvt_pk_bf16(v0[0], v0[1]); w.y = cvt_pk_bf16(v0[2], v0[3]); w.z = cvt_pk_bf16(v1[0], v1[1]); w.w = cvt_pk_bf16(v1[2], v1[3]);
                    *(u32x4*)(rowp + bj * HALF) = w; } }
    }
};

template <class Epi, class Sched, bool ALIGN_EPI>
__device__ __forceinline__ void gemm_phase(PG8_LAS unsigned char* lds, const char* Abase, const int K, const Sched& S, const Epi& E) {
    int tid_ = threadIdx.x; asm volatile("" : "+v"(tid_));
    const int tid = tid_, wid = __builtin_amdgcn_readfirstlane(tid >> 6), lane = tid & 63, wr = wid >> 2, wc = wid & 3, fr = lane & 15, fq = lane >> 4;
    const int nt = K / BK;
    int RA[2]; unsigned CA2[2], voffB[2];
#pragma unroll
    for (int i = 0; i < 2; ++i) { int R, C; stage_rc(tid * 16 + i * 8192, R, C); const int Rb = Epi::PERM ? ((R & ~31) + perm32(R & 31)) : R;
        RA[i] = R; CA2[i] = (unsigned)C * 2u; voffB[i] = (unsigned)(Rb * K + C) * 2u; }
    const size_t kstep = (size_t)(BK * 2);
    const size_t hstep = (size_t)HALF * K * 2;
    const unsigned ldsw = (unsigned)wid * 1024u;
    const int aoff = lds_byte(wr * 64 + fr, fq * 8), boff = lds_byte(wc * 32 + fr, fq * 8);
#define PG8_SA(b, h) (((b) * 2 + (h)) * HTB)
#define PG8_SB(b, h) ((4 + (b) * 2 + (h)) * HTB)
#define PG8_STAGE(bufoff, gbase, voff) do { _Pragma("unroll") for (int _i = 0; _i < 2; ++_i) \
        __builtin_amdgcn_global_load_lds((const unsigned*)((const char*)(gbase) + (voff)[_i]), (PG8_LAS unsigned*)(lds + (bufoff) + ldsw + _i * 8192), 16, 0, 0); } while (0)
#define PG8_LDA(dst, b, h) do { _Pragma("unroll") for (int m = 0; m < 4; ++m) _Pragma("unroll") for (int k = 0; k < 2; ++k) dst[m][k] = *(const PG8_LAS bf16x8*)(lds + PG8_SA(b, h) + aoff + m * 2048 + k * 1024); } while (0)
#define PG8_LDB(dst, b, h) do { _Pragma("unroll") for (int n = 0; n < 2; ++n) _Pragma("unroll") for (int k = 0; k < 2; ++k) dst[n][k] = *(const PG8_LAS bf16x8*)(lds + PG8_SB(b, h) + boff + n * 2048 + k * 1024); } while (0)
#define PG8_MMA(ai, bj, At, Bt) do { __builtin_amdgcn_s_setprio(1); _Pragma("unroll") for (int m = 0; m < 4; ++m) _Pragma("unroll") for (int n = 0; n < 2; ++n) _Pragma("unroll") for (int k = 0; k < 2; ++k) \
        acc[ai][bj][m][n] = __builtin_amdgcn_mfma_f32_16x16x32_bf16(Bt[n][k], At[m][k], acc[ai][bj][m][n], 0, 0, 0); __builtin_amdgcn_s_setprio(0); } while (0)
#define PG8_WAIT_V(n) asm volatile("s_waitcnt vmcnt(" #n ")" ::: "memory")
#define PG8_WAIT_L(n) asm volatile("s_waitcnt lgkmcnt(" #n ")" ::: "memory")
#define PG8_BAR __builtin_amdgcn_s_barrier()
#define PG8_SCHED __builtin_amdgcn_sched_barrier(0)
    Unit cur, nxt; int ui = 0;
    if (!S.next(0, cur)) return;
    f32x4 acc[2][2][4][2];
#pragma unroll
    for (int a = 0; a < 2; ++a)
#pragma unroll
        for (int b = 0; b < 2; ++b)
#pragma unroll
            for (int m = 0; m < 4; ++m)
#pragma unroll
                for (int n = 0; n < 2; ++n) acc[a][b][m][n] = (f32x4){0.f, 0.f, 0.f, 0.f};
    bf16x8 At[4][2], B0[2][2], B1[2][2];
    unsigned voffA[2], ca0[2], ca1[2], na0[2], na1[2];
#pragma unroll
    for (int i = 0; i < 2; ++i) { voffA[i] = (unsigned)(RA[i] * K) * 2u + CA2[i]; ca0[i] = ca1[i] = na0[i] = na1[i] = 0u; }
    const char* cA = Abase; const char* cB = S.bbase(cur);
    if constexpr (Sched::GATHER) {
#pragma unroll
        for (int i = 0; i < 2; ++i) { ca0[i] = S.arow(cur, RA[i]) + CA2[i]; ca1[i] = S.arow(cur, HALF + RA[i]) + CA2[i]; }
    } else cA = Abase + S.aoff(cur);
#define PG8_STAGE_A(bufoff, p, h, g0, g1) do { if constexpr (Sched::GATHER) { if ((h) == 0) PG8_STAGE(bufoff, p, g0); else PG8_STAGE(bufoff, p, g1); } \
        else { PG8_STAGE(bufoff, (p) + (h) * hstep, voffA); } } while (0)
    PG8_STAGE(PG8_SB(0, 0), cB, voffB); PG8_STAGE(PG8_SB(0, 1), cB + hstep, voffB); PG8_STAGE_A(PG8_SA(0, 0), cA, 0, ca0, ca1); PG8_STAGE_A(PG8_SA(0, 1), cA, 1, ca0, ca1);
    if (wr == 1) PG8_BAR;
    PG8_WAIT_V(2); PG8_BAR;
    PG8_STAGE(PG8_SB(1, 0), cB + kstep, voffB); PG8_STAGE_A(PG8_SA(1, 0), cA + kstep, 0, ca0, ca1); PG8_STAGE(PG8_SB(1, 1), cB + hstep + kstep, voffB);
    PG8_WAIT_V(6); PG8_BAR;
    for (;;) {
        const bool has_next = S.next(ui + 1, nxt);
        const char* nA = cA; const char* nB = has_next ? S.bbase(nxt) : cB;
        if constexpr (Sched::GATHER) {
            if (has_next) {
#pragma unroll
                for (int i = 0; i < 2; ++i) { na0[i] = S.arow(nxt, RA[i]) + CA2[i]; na1[i] = S.arow(nxt, HALF + RA[i]) + CA2[i]; }
            } else {
#pragma unroll
                for (int i = 0; i < 2; ++i) { na0[i] = ca0[i]; na1[i] = ca1[i]; }
            }
        } else { if (has_next) nA = Abase + S.aoff(nxt); }
        for (int t = 0; t < nt; t += 2) {
            const bool last = (t == nt - 2);
            const char* a1 = cA + (size_t)(t + 1) * kstep;
            const char* a2 = last ? nA : cA + (size_t)(t + 2) * kstep; const char* b2 = last ? nB : cB + (size_t)(t + 2) * kstep;
            const char* a3 = a2 + kstep; const char* b3 = b2 + kstep;
            unsigned s0[2], s1[2];
#pragma unroll
            for (int i = 0; i < 2; ++i) { s0[i] = last ? na0[i] : ca0[i]; s1[i] = last ? na1[i] : ca1[i]; }
            PG8_LDB(B0, 0, 0); PG8_LDB(B1, 0, 1); PG8_SCHED; PG8_LDA(At, 0, 0); PG8_STAGE_A(PG8_SA(1, 1), a1, 1, ca0, ca1);
            PG8_WAIT_V(8); PG8_WAIT_L(0); PG8_BAR; PG8_MMA(0, 0, At, B0); PG8_MMA(0, 1, At, B1); PG8_BAR; PG8_SCHED;
            PG8_LDA(At, 0, 1); PG8_STAGE(PG8_SB(0, 0), b2, voffB); PG8_STAGE(PG8_SB(0, 1), b2 + hstep, voffB); PG8_STAGE_A(PG8_SA(0, 0), a2, 0, s0, s1);
            PG8_WAIT_V(8); PG8_WAIT_L(0); PG8_BAR; PG8_MMA(1, 0, At, B0); PG8_MMA(1, 1, At, B1); PG8_BAR; PG8_SCHED;
            PG8_LDB(B0, 1, 0); PG8_LDB(B1, 1, 1); PG8_SCHED; PG8_LDA(At, 1, 0); PG8_STAGE_A(PG8_SA(0, 1), a2, 1, s0, s1);
            PG8_WAIT_V(8); PG8_WAIT_L(0); PG8_BAR; PG8_MMA(0, 0, At, B0); PG8_MMA(0, 1, At, B1); PG8_BAR; PG8_SCHED;
            PG8_LDA(At, 1, 1); PG8_STAGE(PG8_SB(1, 0), b3, voffB); PG8_STAGE(PG8_SB(1, 1), b3 + hstep, voffB); PG8_STAGE_A(PG8_SA(1, 0), a3, 0, s0, s1);
            PG8_WAIT_V(8); PG8_WAIT_L(0); PG8_BAR; PG8_MMA(1, 0, At, B0); PG8_MMA(1, 1, At, B1); PG8_BAR; PG8_SCHED;
        }
        if constexpr (ALIGN_EPI) { if (wr == 0) PG8_BAR; }
        E(acc, cur, wr, wc, fr, fq);
        if (!has_next) break;
#pragma unroll
        for (int a = 0; a < 2; ++a)
#pragma unroll
            for (int b = 0; b < 2; ++b)
#pragma unroll
                for (int m = 0; m < 4; ++m)
#pragma unroll
                    for (int n = 0; n < 2; ++n) acc[a][b][m][n] = (f32x4){0.f, 0.f, 0.f, 0.f};
        cur = nxt; cA = nA; cB = nB; ++ui;
        if constexpr (Sched::GATHER) {
#pragma unroll
            for (int i = 0; i < 2; ++i) { ca0[i] = na0[i]; ca1[i] = na1[i]; }
        }
        if constexpr (ALIGN_EPI) { if (wr == 1) PG8_BAR; }
    }
    PG8_WAIT_V(0);
    if constexpr (!ALIGN_EPI) { if (wr == 0) PG8_BAR; }
    PG8_BAR;
#undef PG8_SA
#undef PG8_SB
#undef PG8_STAGE
#undef PG8_LDA
#undef PG8_LDB
#undef PG8_MMA
#undef PG8_WAIT_V
#undef PG8_WAIT_L
#undef PG8_BAR
#undef PG8_SCHED
#undef PG8_STAGE_A
}
}

#define XB_TMO      128
#define XB_XCNT(j)  (256  + 64 * (j))
#define XB_XSUB(j)  (1280 + 64 * (j))
#define XB_XGEN(j)  (2304 + 64 * (j))
#define XB_TOP      3328
#define XB_TOPGEN   3392
#define XCD_BAR_WORDS 3456
#define XB_SPIN_CAP (1u << 18)
__device__ __forceinline__ unsigned xb_ld(unsigned* p)              { return __hip_atomic_load(p, __ATOMIC_RELAXED, __HIP_MEMORY_SCOPE_AGENT); }
__device__ __forceinline__ unsigned xb_add(unsigned* p, unsigned v) { return __hip_atomic_fetch_add(p, v, __ATOMIC_RELAXED, __HIP_MEMORY_SCOPE_AGENT); }
__device__ __forceinline__ unsigned xb_xcc_id() { return (unsigned)__builtin_amdgcn_s_getreg((3 << 11) | 20) & 0xFu; }
#define XB_SPIN(cond, bar) do { unsigned _sp = 0; while (cond) { __builtin_amdgcn_s_sleep(1); \
    if ((++_sp & 255u) == 0u) { if (xb_ld(&(bar)[XB_TMO])) break; if (_sp > XB_SPIN_CAP) { atomicAdd(&(bar)[XB_TMO], 1u); break; } } } } while (0)
struct XcdBarrier { unsigned* bar; unsigned x; volatile LAS unsigned* st; };
__device__ __forceinline__ XcdBarrier xcd_barrier_post(unsigned* bar, volatile LAS unsigned* st) {
    XcdBarrier b; b.bar = bar; b.x = xb_xcc_id(); b.st = st;
    if (threadIdx.x == 0) (void)xb_add(&bar[XB_XCNT(b.x)], 1u);
    return b;
}
__device__ __forceinline__ void xcd_barrier_complete(unsigned* bar, unsigned x, unsigned& nloc, unsigned& nx) {
    const unsigned G = gridDim.x * gridDim.y * gridDim.z;
    unsigned sum, cnt, mine, sp = 0u;
    for (;;) {
        sum = 0u; cnt = 0u; mine = 0u;
#pragma unroll
        for (unsigned j = 0; j < 16; ++j) { const unsigned c = xb_ld(&bar[XB_XCNT(j)]); sum += c; cnt += (c > 0u) ? 1u : 0u; mine = (j == x) ? c : mine; }
        if (sum == G) break;
        __builtin_amdgcn_s_sleep(1);
        if ((++sp & 255u) == 0u) { if (xb_ld(&bar[XB_TMO])) break; if (sp > XB_SPIN_CAP) { atomicAdd(&bar[XB_TMO], 1u); break; } }
    }
    nloc = mine > 0u ? mine : 1u; nx = cnt > 0u ? cnt : 1u;
}
__device__ __forceinline__ void xcd_barrier(const XcdBarrier& b) {
    asm volatile("s_waitcnt vmcnt(0)" ::: "memory");
    __syncthreads();
    if (threadIdx.x == 0) {
        unsigned* bar = b.bar;
        __builtin_amdgcn_s_waitcnt(0);
        unsigned nloc = b.st[0], nx = b.st[1];
        if (nloc == 0u) { xcd_barrier_complete(bar, b.x, nloc, nx); b.st[0] = nloc; b.st[1] = nx; }
        const unsigned old = xb_add(&bar[XB_XSUB(b.x)], 1u);
        const unsigned gen = old / nloc;
        if (old + 1u == (gen + 1u) * nloc) {
            __builtin_amdgcn_fence(__ATOMIC_RELEASE, "agent");
            asm volatile("s_waitcnt vmcnt(0)" ::: "memory");
            const unsigned og = xb_add(&bar[XB_TOP], 1u);
            const unsigned tg = og / nx;
            if (og + 1u == (tg + 1u) * nx) xb_add(&bar[XB_TOPGEN], 1u);
            else XB_SPIN(xb_ld(&bar[XB_TOPGEN]) == tg, bar);
            __builtin_amdgcn_fence(__ATOMIC_ACQUIRE, "agent");
            xb_add(&bar[XB_XGEN(b.x)], 1u);
            asm volatile("s_waitcnt vmcnt(0)" ::: "memory");
        } else {
            XB_SPIN(xb_ld(&bar[XB_XGEN(b.x)]) == gen, bar);
            __builtin_amdgcn_fence(__ATOMIC_ACQUIRE, "agent");
            asm volatile("s_waitcnt vmcnt(0)" ::: "memory");
        }
    }
    __syncthreads();
}

struct Args { const float* in[25]; float* out; unsigned char* ws; int ph_lo, ph_hi, use_bar, pad; };
struct Frame {
    LAS unsigned char* lds; unsigned* ctl; int tid, lane, wave, vcu, G;
    const float* const* in_;
};

__device__ __forceinline__ void transpose_item(const float* W, int K, int N, bf16* WT, int mode, LAS float* scr, int item, int lane) {
    const int nblk = N / 32, kb = item / nblk, nb = item % nblk, k0 = 64 * kb, n0 = 32 * nb;
#pragma unroll 8
    for (int i = 0; i < 32; ++i) { const int kk = 2 * i + (lane >> 5); scr[kk * 33 + (lane & 31)] = W[(size_t)(k0 + kk) * N + n0 + (lane & 31)]; }
    LDS_WAIT(); asm volatile("" ::: "memory");
    const int r0 = mode ? ((n0 >> 7) * 256 + (n0 & 127) + (mode == 2 ? 128 : 0)) : n0;
    const int c = lane & 7;
#pragma unroll
    for (int j = 0; j < 4; ++j) { const int n = (lane >> 3) + 8 * j; const LAS float* s = scr + (8 * c) * 33 + n;
        u32x4 o; o.x = pk2(s[0 * 33], s[1 * 33]); o.y = pk2(s[2 * 33], s[3 * 33]); o.z = pk2(s[4 * 33], s[5 * 33]); o.w = pk2(s[6 * 33], s[7 * 33]);
        *(u32x4*)(WT + (size_t)(r0 + n) * K + k0 + 8 * c) = o; }
    LDS_WAIT(); asm volatile("" ::: "memory");
}
constexpr int IT_IN = (DM / 64) * (DIN / 32), IT_OUT = (DM / 64) * (DM / 32), IT_G = (DM / 64) * (DE / 32), IT_D = (DE / 64) * (DM / 32);
constexpr int IT_LAYER = IT_IN + IT_OUT + 65 * (2 * IT_G + IT_D);

__device__ __forceinline__ void ln_regs(f32x4 (&v)[8], const float* gain, const float* bias, int lane) {
    float s = 0.f;
#pragma unroll
    for (int j = 0; j < 8; ++j) s += (v[j].x + v[j].y) + (v[j].z + v[j].w);
    const float mean = wave_sum(s) * (1.f / DM); float s2 = 0.f;
#pragma unroll
    for (int j = 0; j < 8; ++j) { v[j] = v[j] - mean; s2 += (v[j].x * v[j].x + v[j].y * v[j].y) + (v[j].z * v[j].z + v[j].w * v[j].w); }
    const float rstd = 1.f / sqrtf(wave_sum(s2) * (1.f / DM) + LN_EPS);
#pragma unroll
    for (int j = 0; j < 8; ++j) { const f32x4 g = ((const f32x4*)gain)[j * 64 + lane], b = ((const f32x4*)bias)[j * 64 + lane]; v[j] = v[j] * rstd * g + b; }
}
__device__ __forceinline__ void store_row_f32(float* dst, const f32x4 (&v)[8], int lane) {
#pragma unroll
    for (int j = 0; j < 8; ++j) ((f32x4*)dst)[j * 64 + lane] = v[j];
}
__device__ __forceinline__ void store_row_bf16(bf16* dst, const f32x4 (&v)[8], int lane) {
#pragma unroll
    for (int j = 0; j < 8; ++j) { u32x2 w; w.x = pk2(v[j].x, v[j].y); w.y = pk2(v[j].z, v[j].w); ((u32x2*)dst)[j * 64 + lane] = w; }
}

#define KAS __attribute__((address_space(4)))
#define PHASE_PTRS const char KAS* kp_ = (const char KAS*)__builtin_amdgcn_kernarg_segment_ptr(); asm volatile("" : "+s"(kp_)); unsigned char* const ws = *(unsigned char* const KAS*)(kp_ + 26 * 8); (void)ws;
#define INP(k) (*(const float* const KAS*)(kp_ + (k) * 8))
#define x_in INP(0)
#define ln0_g INP(1)
#define ln0_b INP(2)
#define w_in INP(3)
#define b_in INP(4)
#define lb_logits INP(5)
#define sw_sinks INP(6)
#define sg_ln_g INP(7)
#define sg_ln_b INP(8)
#define sg_w_s INP(9)
#define sg_b_s INP(10)
#define mix_gain INP(11)
#define w_out INP(12)
#define ln1_g INP(13)
#define ln1_b INP(14)
#define router_w INP(15)
#define router_b INP(16)
#define ew_gate INP(17)
#define ew_up INP(18)
#define ew_down INP(19)
#define sh_gate INP(20)
#define sh_up INP(21)
#define sh_down INP(22)
#define ln2_g INP(23)
#define ln2_b INP(24)
#define OUTP (*(float* const KAS*)(kp_ + 25 * 8))
#define list ((int*)(ws + WS_LIST))
#define wlist ((float*)(ws + WS_WLIST))
#define slot ((int*)(ws + WS_SLOT))
#define dendG ((float*)(ws + WS_DEND))
#define stateG ((float*)(ws + WS_STATE))
#define Hf ((float*)(ws + WS_HF))
#define Hb ((bf16*)(ws + WS_HB))
#define proj ((bf16*)(ws + WS_PROJ))
#define mixed ((bf16*)(ws + WS_MIXED))
#define Hs ((bf16*)(ws + WS_HS))
#define Yb ((bf16*)(ws + WS_Y))
#define ctl ((unsigned*)(ws + WS_CTL))
#define WLp ((const char*)(ws + WS_W + (size_t)l * WL_BYTES))
#define cntG (ctl + CW_CNT + l * 64)
__global__ void __launch_bounds__(NTHR, 2) fwd_kernel(Args args) {
    extern __shared__ __attribute__((aligned(16))) unsigned char lds_raw[];
    LAS unsigned char* const lds = (LAS unsigned char*)lds_raw;
    const int tid = threadIdx.x, lane = tid & 63, wave = __builtin_amdgcn_readfirstlane(tid >> 6);
    const int G = gridDim.x, bx = blockIdx.x;
    const int vcu = (G % 8 == 0) ? (bx % 8) * (G / 8) + bx / 8 : bx;
    volatile LAS unsigned* MISC = (volatile LAS unsigned*)(lds + MISC_OFF);
    if (tid < 64) MISC[tid] = 0u;
    __syncthreads();
    XcdBarrier bar; bar.bar = (unsigned*)(args.ws + WS_CTL) + CW_BAR; bar.x = 0; bar.st = nullptr;
    if (args.use_bar) bar = xcd_barrier_post((unsigned*)(args.ws + WS_CTL) + CW_BAR, MISC + 8);
    const int lo = args.ph_lo, hi = args.ph_hi;
#define PHASE_TID int tid_o_ = threadIdx.x; asm volatile("" : "+v"(tid_o_)); const int tid = tid_o_, lane = tid & 63; (void)lane; (void)tid;
#ifndef BSEL
#define BSEL 7
#endif
#ifndef PHMASK
#define PHMASK 0x3ff
#endif
#define IN(k) (lo <= (k) && (k) < hi)
#define EN(i) ((PHMASK >> (i)) & 1)
#define SEAM(k) do { if (IN(k) && IN((k) + 1)) xcd_barrier(bar); } while (0)

    if (EN(0) && IN(0)) { PHASE_TID PHASE_PTRS
        LAS float* scr = (LAS float*)(lds + wave * 16384);
        const int gw = vcu * NWAVES + wave, NGW = G * NWAVES;
        for (int it = gw; it < 2 * IT_LAYER; it += NGW) {
            const int l = it / IT_LAYER; int r = it % IT_LAYER;
            bf16* const WL = (bf16*)(ws + WS_W + (size_t)l * WL_BYTES);
            if (r < IT_IN) { transpose_item(w_in + (size_t)l * DM * DIN, DM, DIN, (bf16*)((char*)WLp + WL_IN), 0, scr, r, lane); continue; } r -= IT_IN;
            if (r < IT_OUT) { transpose_item(w_out + (size_t)l * DM * DM, DM, DM, (bf16*)((char*)WLp + WL_OUT), 0, scr, r, lane); continue; } r -= IT_OUT;
            const int e = r / (2 * IT_G + IT_D); r = r % (2 * IT_G + IT_D);
            bf16* const gu = (bf16*)((char*)WLp + WL_GU + (size_t)e * W_GU_B); bf16* const dn = (bf16*)((char*)WLp + WL_D + (size_t)e * W_D_B);
            if (r < IT_G) { const float* src = (e < 64) ? ew_gate + ((size_t)l * 64 + e) * DM * DE : sh_gate + (size_t)l * DM * DE; transpose_item(src, DM, DE, gu, 1, scr, r, lane); continue; } r -= IT_G;
            if (r < IT_G) { const float* src = (e < 64) ? ew_up + ((size_t)l * 64 + e) * DM * DE : sh_up + (size_t)l * DM * DE; transpose_item(src, DM, DE, gu, 2, scr, r, lane); continue; } r -= IT_G;
            { const float* src = (e < 64) ? ew_down + ((size_t)l * 64 + e) * DE * DM : sh_down + (size_t)l * DE * DM; transpose_item(src, DE, DM, dn, 0, scr, r, lane); }
        }
        for (int m = gw; m < NTOK; m += NGW) {
            f32x4 v[8];
#pragma unroll
            for (int j = 0; j < 8; ++j) v[j] = ((const f32x4*)(x_in + (size_t)m * DM))[j * 64 + lane];
            ln_regs(v, ln0_g, ln0_b, lane);
            store_row_f32(Hf + (size_t)m * DM, v, lane); store_row_bf16(Hb + (size_t)m * DM, v, lane);
        }
    }
    SEAM(0);

    for (int l = 0; l < 2; ++l) {
        const int pb = 1 + l * 9;

        if (EN(1) && IN(pb + 0)) { PHASE_PTRS
            pg8::PlainSched S; S.init(NTOK, DIN, DM, G, bx, WLp + WL_IN);
            pg8::EpiBf16Bias E{proj, DIN, b_in + (size_t)l * DIN};
            pg8::gemm_phase<pg8::EpiBf16Bias, pg8::PlainSched, true>(lds, (const char*)Hb, DM, S, E);
        }
        SEAM(pb + 0);

        if (EN(2) && IN(pb + 1)) {
            if (BSEL & 1) { PHASE_TID PHASE_PTRS
            for (int unit = bx; unit < 512; unit += G) {
                const int bh = unit >> 5, c = unit & 31, b = bh >> 2, h = bh & 3, row0 = b * SEQ + c * 128;
                LAS float* bL = (LAS float*)lds;
                LAS bf16* kkb = (LAS bf16*)(lds + 65536);
                LAS bf16* vb = (LAS bf16*)(lds + 98304);
                LAS float* segtot = (LAS float*)(lds + 131072);
                LAS float* bendL = (LAS float*)(lds + 131072 + 2048);
                LAS float* lbs = (LAS float*)(lds + 131072 + 2560);
                if (tid < 128) { float lb = 0.f; if (l == 1) { const float a0 = lb_logits[h * 128 + tid], a1 = lb_logits[512 + h * 128 + tid]; lb = 1.0f / (1.0f + expf(a0 - a1)); } lbs[tid] = lb; }
                __syncthreads();
#pragma unroll
                for (int i = 0; i < 4; ++i) {
                    const int idx = tid + NTHR * i, t = idx >> 4, kg = idx & 15;
                    const bf16* rowp = proj + (size_t)(row0 + t) * DIN + h * 128 + kg * 8;
                    const u32x4 z8 = *(const u32x4*)(rowp + C_HF); const u32x4 v8 = *(const u32x4*)(rowp + C_HI);
                    const unsigned zw[4] = {z8.x, z8.y, z8.z, z8.w};
                    unsigned kw[4];
#pragma unroll
                    for (int j = 0; j < 4; ++j) {
                        float kk2[2];
#pragma unroll
                        for (int q = 0; q < 2; ++q) {
                            const float z = q ? bfhi(zw[j]) : bflo(zw[j]); const int k = kg * 8 + j * 2 + q; const float lb = lbs[k];
                            const float ls = fminf(z, 0.f) - log1pf(expf(-fabsf(z)));
                            const float lf = (lb == 0.f) ? ls : logf(lb + (1.f - lb) * expf(ls));
                            bL[t * 128 + k] = lf; kk2[q] = (1.f - lb) / (1.f + expf(z));
                        }
                        kw[j] = pk2(kk2[0], kk2[1]);
                    }
                    *(LAS u32x4*)(kkb + t * 128 + kg * 8) = (u32x4){kw[0], kw[1], kw[2], kw[3]};
                    *(LAS u32x4*)(vb + t * 128 + kg * 8) = v8;
                }
                __syncthreads();
                { const int k = tid & 127, seg = tid >> 7; float run = 0.f;
                    for (int tt = 0; tt < 32; ++tt) { const int t = seg * 32 + tt; run += bL[t * 128 + k]; bL[t * 128 + k] = run; }
                    segtot[seg * 128 + k] = run;
                    __syncthreads();
                    float off = 0.f, tot = 0.f;
#pragma unroll
                    for (int s = 0; s < 4; ++s) { const float v = segtot[s * 128 + k]; if (s < seg) off += v; tot += v; }
                    if (seg > 0) for (int tt = 0; tt < 32; ++tt) { const int t = seg * 32 + tt; bL[t * 128 + k] += off; }
                    if (seg == 0) { bendL[k] = tot; dendG[(size_t)(bh * 32 + c) * 128 + k] = expf(tot); }
                }
                __syncthreads();
                for (int i = 0; i < 32; ++i) { const int idx = tid + NTHR * i, t = idx >> 7, k = idx & 127; bL[idx] = bf2f(kkb[idx]) * expf(bendL[k] - bL[idx]); (void)t; }
                __syncthreads();
                { const int kq = tid >> 4, vq = tid & 15, k0 = 4 * kq, v0 = 8 * vq;
                    float acc[4][8];
#pragma unroll
                    for (int i = 0; i < 4; ++i)
#pragma unroll
                        for (int j = 0; j < 8; ++j) acc[i][j] = 0.f;
                    for (int t = 0; t < 128; ++t) {
                        const f32x4 a4 = *(const LAS f32x4*)(bL + t * 128 + k0); const u32x4 v8 = *(const LAS u32x4*)(vb + t * 128 + v0);
                        const float vf[8] = {bflo(v8.x), bfhi(v8.x), bflo(v8.y), bfhi(v8.y), bflo(v8.z), bfhi(v8.z), bflo(v8.w), bfhi(v8.w)};
#pragma unroll
                        for (int i = 0; i < 4; ++i)
#pragma unroll
                            for (int j = 0; j < 8; ++j) acc[i][j] += a4[i] * vf[j];
                    }
                    float* sp = stateG + ((size_t)(bh * 32 + c) * 128 + k0) * 128 + v0;
#pragma unroll
                    for (int i = 0; i < 4; ++i) { *(f32x4*)(sp + i * 128) = (f32x4){acc[i][0], acc[i][1], acc[i][2], acc[i][3]}; *(f32x4*)(sp + i * 128 + 4) = (f32x4){acc[i][4], acc[i][5], acc[i][6], acc[i][7]}; }
                }
                __syncthreads();
            }
            }
            if (BSEL & 2) { PHASE_TID PHASE_PTRS
            for (int unit = bx; unit < 256; unit += G) {
                const int b = unit >> 6, blk = (unit >> 1) & 31, half = unit & 1;
                const int kp0 = blk * 128 - 128 + 64 * half;
                const int qp0 = blk * 128 + 64 * half;
                LAS float* Kl = (LAS float*)lds;
                LAS float* Vl = (LAS float*)(lds + 49152);
                LAS float* ssq = (LAS float*)(lds + 98304);
                const int dh = lane & 1;
                for (int pi = 0; pi < 4; ++pi) {
                    const int combo = pi * 8 + wave, hd = combo >> 1, r = (combo & 1) * 32 + (lane >> 1), kvh = pi >> 1;
                    if ((pi & 1) == 0) {
                        __syncthreads();
                        for (int i = 0; i < 6; ++i) {
                            const int idx = tid + NTHR * i, arr = idx / 1536, rem = idx % 1536, s = rem >> 3, ch = rem & 7, kp = kp0 + s;
                            u32x4 w = (u32x4){0u, 0u, 0u, 0u};
                            if (kp >= 0) w = *(const u32x4*)(proj + (size_t)(b * SEQ + kp) * DIN + (arr ? C_AV : C_AK) + kvh * 64 + ch * 8);
                            LAS float* d = (arr ? Vl : Kl) + s * 64 + ch * 8;
                            *(LAS f32x4*)d = (f32x4){bflo(w.x), bfhi(w.x), bflo(w.y), bfhi(w.y)}; *(LAS f32x4*)(d + 4) = (f32x4){bflo(w.z), bfhi(w.z), bflo(w.w), bfhi(w.w)};
                        }
                        __syncthreads();
                    }
                    float q[32], acc[32];
                    { const bf16* qp = proj + (size_t)(b * SEQ + qp0 + r) * DIN + C_AQ + hd * 64 + dh * 32;
#pragma unroll
                        for (int c8 = 0; c8 < 4; ++c8) { const u32x4 w = *(const u32x4*)(qp + c8 * 8);
                            q[c8 * 8 + 0] = bflo(w.x) * 0.125f; q[c8 * 8 + 1] = bfhi(w.x) * 0.125f; q[c8 * 8 + 2] = bflo(w.y) * 0.125f; q[c8 * 8 + 3] = bfhi(w.y) * 0.125f;
                            q[c8 * 8 + 4] = bflo(w.z) * 0.125f; q[c8 * 8 + 5] = bfhi(w.z) * 0.125f; q[c8 * 8 + 6] = bflo(w.w) * 0.125f; q[c8 * 8 + 7] = bfhi(w.w) * 0.125f; } }
#pragma unroll
                    for (int d = 0; d < 32; ++d) acc[d] = 0.f;
                    float mrun = sw_sinks[l * 16 + hd], lsum = 1.0f;
                    for (int s = 1; s < 192; ++s) {
                        const bool valid = (s > r) && (s <= r + 128) && (kp0 + s >= 0);
                        float sc = 0.f;
#pragma unroll
                        for (int c4 = 0; c4 < 8; ++c4) { const f32x4 k4 = *(const LAS f32x4*)(Kl + s * 64 + dh * 32 + c4 * 4); sc += q[c4 * 4 + 0] * k4.x + q[c4 * 4 + 1] * k4.y + q[c4 * 4 + 2] * k4.z + q[c4 * 4 + 3] * k4.w; }
                        sc += __shfl_xor(sc, 1);
                        if (valid && sc > mrun) { const float corr = __expf(mrun - sc); lsum *= corr;
#pragma unroll
                            for (int d = 0; d < 32; ++d) acc[d] *= corr;
                            mrun = sc; }
                        const float p = valid ? __expf(sc - mrun) : 0.f;
                        lsum += p;
#pragma unroll
                        for (int c4 = 0; c4 < 8; ++c4) { const f32x4 v4 = *(const LAS f32x4*)(Vl + s * 64 + dh * 32 + c4 * 4); acc[c4 * 4 + 0] += p * v4.x; acc[c4 * 4 + 1] += p * v4.y; acc[c4 * 4 + 2] += p * v4.z; acc[c4 * 4 + 3] += p * v4.w; }
                    }
                    const float inv = 1.0f / lsum; float ss = 0.f;
                    bf16* op = mixed + (size_t)(b * SEQ + qp0 + r) * DM + 512 + hd * 64 + dh * 32;
#pragma unroll
                    for (int c8 = 0; c8 < 4; ++c8) { unsigned w[4];
#pragma unroll
                        for (int j = 0; j < 4; ++j) { const float o0 = acc[c8 * 8 + 2 * j] * inv, o1 = acc[c8 * 8 + 2 * j + 1] * inv; ss += o0 * o0 + o1 * o1; w[j] = pk2(o0, o1); }
                        *(u32x4*)(op + c8 * 8) = (u32x4){w[0], w[1], w[2], w[3]}; }
                    ss += __shfl_xor(ss, 1);
                    if (dh == 0) ssq[r * 16 + hd] = ss;
                }
                __syncthreads();
                for (int pi = 0; pi < 4; ++pi) {
                    const int combo = pi * 8 + wave, hd = combo >> 1, r = (combo & 1) * 32 + (lane >> 1);
                    float tot = 0.f;
#pragma unroll
                    for (int j = 0; j < 16; ++j) tot += ssq[r * 16 + j];
                    const float rr = 1.0f / sqrtf(tot * (1.0f / 1024.0f) + RMS_EPS);
                    const float* gp = mix_gain + (size_t)l * DM + 512 + hd * 64 + dh * 32;
                    bf16* op = mixed + (size_t)(b * SEQ + qp0 + r) * DM + 512 + hd * 64 + dh * 32;
#pragma unroll
                    for (int c8 = 0; c8 < 4; ++c8) { const u32x4 o = *(const u32x4*)(op + c8 * 8); const f32x4 g0 = *(const f32x4*)(gp + c8 * 8), g1 = *(const f32x4*)(gp + c8 * 8 + 4);
                        u32x4 w; w.x = pk2(bflo(o.x) * rr * g0.x, bfhi(o.x) * rr * g0.y); w.y = pk2(bflo(o.y) * rr * g0.z, bfhi(o.y) * rr * g0.w);
                        w.z = pk2(bflo(o.z) * rr * g1.x, bfhi(o.z) * rr * g1.y); w.w = pk2(bflo(o.w) * rr * g1.z, bfhi(o.w) * rr * g1.w);
                        *(u32x4*)(op + c8 * 8) = w; }
                }
                __syncthreads();
            }
            }
            if (BSEL & 4) { PHASE_TID PHASE_PTRS
            for (int unit = bx; unit < 128; unit += G) {
                const int row0 = unit * 128;
                LAS float* vn = (LAS float*)lds;
                LAS float* wT = (LAS float*)(lds + 65536);
                LAS f32x2* stats = (LAS f32x2*)(lds + 133120);
                __syncthreads();
#pragma unroll 1
                for (int i = 0; i < 16; ++i) { const int s = wave * 16 + i;
                    const u32x4 w = *(const u32x4*)(proj + (size_t)(row0 + s) * DIN + C_SV + lane * 8);
                    float g[8] = {geluf_(bflo(w.x)), geluf_(bfhi(w.x)), geluf_(bflo(w.y)), geluf_(bfhi(w.y)), geluf_(bflo(w.z)), geluf_(bfhi(w.z)), geluf_(bflo(w.w)), geluf_(bfhi(w.w))};
                    float sm = 0.f;
#pragma unroll
                    for (int j = 0; j < 8; ++j) sm += g[j];
                    const float mean = wave_sum(sm) * (1.0f / 512.0f); float s2 = 0.f;
#pragma unroll
                    for (int j = 0; j < 8; ++j) { const float d = g[j] - mean; s2 += d * d; }
                    const float rstd = 1.0f / sqrtf(wave_sum(s2) * (1.0f / 512.0f) + LN_EPS);
                    if (lane == 0) stats[s] = (f32x2){mean, rstd};
                }
                float ssr[4] = {0.f, 0.f, 0.f, 0.f};
                const int tq = tid >> 4, cq = tid & 15, t0 = 4 * tq, c0 = 8 * cq;
#pragma unroll 1
                for (int g = 0; g < 4; ++g) {
                    __syncthreads();
#pragma unroll 1
                    for (int i = 0; i < 4; ++i) { const int idx = tid + NTHR * i, s = idx >> 4, cg = idx & 15;
                        const u32x4 w = *(const u32x4*)(proj + (size_t)(row0 + s) * DIN + C_SV + g * 128 + cg * 8);
                        const f32x2 st = stats[s]; const float* lg = sg_ln_g + (size_t)l * 512 + g * 128 + cg * 8; const float* lbp = sg_ln_b + (size_t)l * 512 + g * 128 + cg * 8;
                        const float x8[8] = {bflo(w.x), bfhi(w.x), bflo(w.y), bfhi(w.y), bflo(w.z), bfhi(w.z), bflo(w.w), bfhi(w.w)};
#pragma unroll
                        for (int j = 0; j < 8; ++j) vn[s * 128 + cg * 8 + j] = (geluf_(x8[j]) - st.x) * st.y * lg[j] + lbp[j];
                    }
                    { const float* wsrc = sg_w_s + ((size_t)l * 4 + g) * 128 * 128;
#pragma unroll
                        for (int i = 0; i < 8; ++i) { const int idx = tid + NTHR * i, s4 = (idx >> 7) * 4, t = idx & 127;
                            const f32x4 w4 = *(const f32x4*)(wsrc + t * 128 + s4);
#pragma unroll
                            for (int j = 0; j < 4; ++j) wT[(s4 + j) * 132 + t] = (s4 + j <= t) ? w4[j] : 0.f; } }
                    __syncthreads();
                    float acc[4][8];
#pragma unroll
                    for (int i = 0; i < 4; ++i)
#pragma unroll
                        for (int j = 0; j < 8; ++j) acc[i][j] = 0.f;
                    for (int s = 0; s <= t0 + 3; ++s) {
                        const f32x4 w4 = *(const LAS f32x4*)(wT + s * 132 + t0); const f32x4 va = *(const LAS f32x4*)(vn + s * 128 + c0), vb2 = *(const LAS f32x4*)(vn + s * 128 + c0 + 4);
                        const float vf[8] = {va.x, va.y, va.z, va.w, vb2.x, vb2.y, vb2.z, vb2.w};
#pragma unroll
                        for (int i = 0; i < 4; ++i)
#pragma unroll
                            for (int j = 0; j < 8; ++j) acc[i][j] += w4[i] * vf[j];
                    }
#pragma unroll 1
                    for (int i = 0; i < 4; ++i) { const float bs = sg_b_s[((size_t)l * 4 + g) * 128 + t0 + i];
                        const u32x4 w = *(const u32x4*)(proj + (size_t)(row0 + t0 + i) * DIN + C_SU + g * 128 + c0);
                        const float u8[8] = {bflo(w.x), bfhi(w.x), bflo(w.y), bfhi(w.y), bflo(w.z), bfhi(w.z), bflo(w.w), bfhi(w.w)};
                        float o8[8];
#pragma unroll
                        for (int j = 0; j < 8; ++j) { o8[j] = geluf_(u8[j]) * (acc[i][j] + bs); ssr[i] += o8[j] * o8[j]; }
                        *(u32x4*)(mixed + (size_t)(row0 + t0 + i) * DM + 1536 + g * 128 + c0) = (u32x4){pk2(o8[0], o8[1]), pk2(o8[2], o8[3]), pk2(o8[4], o8[5]), pk2(o8[6], o8[7])}; }
                }
                __syncthreads();
#pragma unroll
                for (int i = 0; i < 4; ++i) { float ss = ssr[i];
                    ss += __shfl_xor(ss, 1); ss += __shfl_xor(ss, 2); ss += __shfl_xor(ss, 4); ss += __shfl_xor(ss, 8);
                    const float rr = 1.0f / sqrtf(ss * (1.0f / 512.0f) + RMS_EPS);
#pragma unroll
                    for (int g = 0; g < 4; ++g) { const float* gp = mix_gain + (size_t)l * DM + 1536 + g * 128 + c0; bf16* op = mixed + (size_t)(row0 + t0 + i) * DM + 1536 + g * 128 + c0;
                        const u32x4 o = *(const u32x4*)op; const f32x4 g0 = *(const f32x4*)gp, g1 = *(const f32x4*)(gp + 4);
                        u32x4 w; w.x = pk2(bflo(o.x) * rr * g0.x, bfhi(o.x) * rr * g0.y); w.y = pk2(bflo(o.y) * rr * g0.z, bfhi(o.y) * rr * g0.w);
                        w.z = pk2(bflo(o.z) * rr * g1.x, bfhi(o.z) * rr * g1.y); w.w = pk2(bflo(o.w) * rr * g1.z, bfhi(o.w) * rr * g1.w);
                        *(u32x4*)op = w; }
                }
                __syncthreads();
            }
            }
        }
        SEAM(pb + 1);

        if (EN(3) && IN(pb + 2)) { PHASE_TID PHASE_PTRS
            for (int gi = bx * NTHR + tid; gi < 16 * 8192; gi += G * NTHR) {
                const int bh = gi >> 13, rem = gi & 8191, k = rem >> 6;
                f32x2 carry = (f32x2){0.f, 0.f};
                for (int c = 0; c < 32; ++c) {
                    f32x2* p = (f32x2*)(stateG + (size_t)(bh * 32 + c) * 16384) + rem;
                    const f32x2 tmp = *p; *p = carry; const float d = dendG[(size_t)(bh * 32 + c) * 128 + k]; carry = carry * d + tmp;
                }
            }
        }
        SEAM(pb + 2);

        if (EN(4) && IN(pb + 3)) { PHASE_TID PHASE_PTRS
            for (int unit = bx; unit < 512; unit += G) {
                const int bh = unit >> 5, c = unit & 31, b = bh >> 2, h = bh & 3, row0 = b * SEQ + c * 128;
                LAS float* bT = (LAS float*)lds;
                LAS bf16* qT = (LAS bf16*)(lds + 67584);
                LAS bf16* kT = (LAS bf16*)(lds + 100352);
                LAS float* segtot = (LAS float*)(lds + 133120);
                LAS float* lbs = (LAS float*)(lds + 133120 + 2048);
                __syncthreads();
                if (tid < 128) { float lb = 0.f; if (l == 1) { const float a0 = lb_logits[h * 128 + tid], a1 = lb_logits[512 + h * 128 + tid]; lb = 1.0f / (1.0f + expf(a0 - a1)); } lbs[tid] = lb; }
                __syncthreads();
#pragma unroll
                for (int i = 0; i < 4; ++i) {
                    const int idx = tid + NTHR * i, t = idx >> 4, kg = idx & 15;
                    const bf16* rowp = proj + (size_t)(row0 + t) * DIN + h * 128 + kg * 8;
                    const u32x4 z8 = *(const u32x4*)(rowp + C_HF); const u32x4 q8 = *(const u32x4*)(rowp + C_HQ);
                    const unsigned zw[4] = {z8.x, z8.y, z8.z, z8.w}; const unsigned qw[4] = {q8.x, q8.y, q8.z, q8.w};
#pragma unroll
                    for (int j = 0; j < 4; ++j)
#pragma unroll
                        for (int q = 0; q < 2; ++q) {
                            const float z = q ? bfhi(zw[j]) : bflo(zw[j]); const float qv = q ? bfhi(qw[j]) : bflo(qw[j]); const int k = kg * 8 + j * 2 + q; const float lb = lbs[k];
                            const float ls = fminf(z, 0.f) - log1pf(expf(-fabsf(z)));
                            const float lf = (lb == 0.f) ? ls : logf(lb + (1.f - lb) * expf(ls));
                            bT[k * 132 + t] = lf * 1.4426950408889634f;
                            kT[k * 128 + t] = (bf16)f2bf((1.f - lb) / (1.f + expf(z)));
                            qT[k * 128 + t] = (bf16)f2bf(siluf_(qv));
                        }
                }
                __syncthreads();
                { const int k = tid & 127, seg = tid >> 7; float run = 0.f;
                    for (int tt = 0; tt < 32; ++tt) { const int t = seg * 32 + tt; run += bT[k * 132 + t]; bT[k * 132 + t] = run; }
                    segtot[seg * 128 + k] = run;
                    __syncthreads();
                    float off = 0.f;
#pragma unroll
                    for (int s = 0; s < 4; ++s) { const float v = segtot[s * 128 + k]; if (s < seg) off += v; }
                    if (seg > 0) for (int tt = 0; tt < 32; ++tt) { const int t = seg * 32 + tt; bT[k * 132 + t] += off; }
                }
                __syncthreads();
                const int tq = tid >> 4, sq = tid & 15, t0 = 4 * tq, s0 = 8 * sq;
                float sc[4][8];
#pragma unroll
                for (int i = 0; i < 4; ++i)
#pragma unroll
                    for (int j = 0; j < 8; ++j) sc[i][j] = 0.f;
                if (s0 <= t0 + 3) {
                    for (int k = 0; k < 128; ++k) {
                        const f32x4 bt = *(const LAS f32x4*)(bT + k * 132 + t0); const f32x4 bs0 = *(const LAS f32x4*)(bT + k * 132 + s0), bs1 = *(const LAS f32x4*)(bT + k * 132 + s0 + 4);
                        const u32x2 qw = *(const LAS u32x2*)(qT + k * 128 + t0); const u32x4 kw = *(const LAS u32x4*)(kT + k * 128 + s0);
                        const float qf[4] = {bflo(qw.x), bfhi(qw.x), bflo(qw.y), bfhi(qw.y)};
                        const float kf[8] = {bflo(kw.x), bfhi(kw.x), bflo(kw.y), bfhi(kw.y), bflo(kw.z), bfhi(kw.z), bflo(kw.w), bfhi(kw.w)};
                        const float bsf[8] = {bs0.x, bs0.y, bs0.z, bs0.w, bs1.x, bs1.y, bs1.z, bs1.w};
#pragma unroll
                        for (int i = 0; i < 4; ++i)
#pragma unroll
                            for (int j = 0; j < 8; ++j) sc[i][j] += qf[i] * kf[j] * __builtin_amdgcn_exp2f(fminf(bt[i] - bsf[j], 0.f));
                    }
                }
#pragma unroll
                for (int i = 0; i < 4; ++i)
#pragma unroll
                    for (int j = 0; j < 8; ++j) if (s0 + j > t0 + i) sc[i][j] = 0.f;
                __syncthreads();
                for (int i = 0; i < 32; ++i) { const int idx = tid + NTHR * i, k = idx >> 7, t = idx & 127; qT[idx] = (bf16)f2bf(bf2f(qT[idx]) * __builtin_amdgcn_exp2f(bT[k * 132 + t])); }
                __syncthreads();
#pragma unroll
                for (int j = 0; j < 8; ++j) *(LAS f32x4*)(bT + (s0 + j) * 132 + t0) = (f32x4){sc[0][j], sc[1][j], sc[2][j], sc[3][j]};
                LAS bf16* vb = kT;
#pragma unroll
                for (int i = 0; i < 4; ++i) { const int idx = tid + NTHR * i, t = idx >> 4, kg = idx & 15;
                    *(LAS u32x4*)(vb + t * 128 + kg * 8) = *(const u32x4*)(proj + (size_t)(row0 + t) * DIN + C_HI + h * 128 + kg * 8); }
                __syncthreads();
                { const int vq = sq, v0 = 8 * vq;
                    float acc[4][8];
#pragma unroll
                    for (int i = 0; i < 4; ++i)
#pragma unroll
                        for (int j = 0; j < 8; ++j) acc[i][j] = 0.f;
                    const float* stp = stateG + (size_t)(bh * 32 + c) * 16384 + v0;
                    for (int k = 0; k < 128; ++k) {
                        const u32x2 qw = *(const LAS u32x2*)(qT + k * 128 + t0); const f32x4 sa = *(const f32x4*)(stp + k * 128), sb = *(const f32x4*)(stp + k * 128 + 4);
                        const float qf[4] = {bflo(qw.x), bfhi(qw.x), bflo(qw.y), bfhi(qw.y)}; const float sf[8] = {sa.x, sa.y, sa.z, sa.w, sb.x, sb.y, sb.z, sb.w};
#pragma unroll
                        for (int i = 0; i < 4; ++i)
#pragma unroll
                            for (int j = 0; j < 8; ++j) acc[i][j] += qf[i] * sf[j];
                    }
                    for (int s = 0; s <= t0 + 3; ++s) {
                        const f32x4 s4 = *(const LAS f32x4*)(bT + s * 132 + t0); const u32x4 vw = *(const LAS u32x4*)(vb + s * 128 + v0);
                        const float vf[8] = {bflo(vw.x), bfhi(vw.x), bflo(vw.y), bfhi(vw.y), bflo(vw.z), bfhi(vw.z), bflo(vw.w), bfhi(vw.w)};
#pragma unroll
                        for (int i = 0; i < 4; ++i)
#pragma unroll
                            for (int j = 0; j < 8; ++j) acc[i][j] += s4[i] * vf[j];
                    }
                    const float* gp = mix_gain + (size_t)l * DM + h * 128 + v0;
#pragma unroll
                    for (int i = 0; i < 4; ++i) { float ss = 0.f;
#pragma unroll
                        for (int j = 0; j < 8; ++j) ss += acc[i][j] * acc[i][j];
                        ss += __shfl_xor(ss, 1); ss += __shfl_xor(ss, 2); ss += __shfl_xor(ss, 4); ss += __shfl_xor(ss, 8);
                        const float rr = 1.0f / sqrtf(ss * (1.0f / 128.0f) + RMS_EPS);
                        const u32x4 gw = *(const u32x4*)(proj + (size_t)(row0 + t0 + i) * DIN + C_HG + h * 128 + v0);
                        const float gf[8] = {bflo(gw.x), bfhi(gw.x), bflo(gw.y), bfhi(gw.y), bflo(gw.z), bfhi(gw.z), bflo(gw.w), bfhi(gw.w)};
                        unsigned w[4];
#pragma unroll
                        for (int j = 0; j < 4; ++j) w[j] = pk2(acc[i][2 * j] * rr * gp[2 * j] * siluf_(gf[2 * j]), acc[i][2 * j + 1] * rr * gp[2 * j + 1] * siluf_(gf[2 * j + 1]));
                        *(u32x4*)(mixed + (size_t)(row0 + t0 + i) * DM + h * 128 + v0) = (u32x4){w[0], w[1], w[2], w[3]}; }
                }
                __syncthreads();
            }
        }
        SEAM(pb + 3);

        if (EN(5) && IN(pb + 4)) { PHASE_PTRS
            pg8::PlainSched S; S.init(NTOK, DM, DM, G, bx, WLp + WL_OUT);
            pg8::EpiResF32 E{Hf, DM, ALPHA};
            pg8::gemm_phase<pg8::EpiResF32, pg8::PlainSched, true>(lds, (const char*)mixed, DM, S, E);
        }
        SEAM(pb + 4);

        if (EN(6) && IN(pb + 5)) { PHASE_TID PHASE_PTRS
            LAS float* xs = (LAS float*)lds;
            LAS int* selr = (LAS int*)(lds + 131072);
            LAS float* gatel = (LAS float*)(lds + 131072 + 4096);
            const float* rw = router_w + (size_t)l * DM * NE;
            for (int bi = bx; bi < NTOK / 16; bi += G) {
                const int tok0 = bi * 16;
                __syncthreads();
#pragma unroll
                for (int jt = 0; jt < 2; ++jt) { const int tl = wave * 2 + jt, tok = tok0 + tl;
                    f32x4 v[8];
#pragma unroll
                    for (int j = 0; j < 8; ++j) v[j] = ((const f32x4*)(Hf + (size_t)tok * DM))[j * 64 + lane];
                    ln_regs(v, ln1_g + (size_t)l * DM, ln1_b + (size_t)l * DM, lane);
                    store_row_f32(Hf + (size_t)tok * DM, v, lane); store_row_bf16(Hb + (size_t)tok * DM, v, lane);
#pragma unroll
                    for (int j = 0; j < 8; ++j) ((LAS f32x4*)(xs + tl * DM))[j * 64 + lane] = v[j];
                }
                __syncthreads();
                float acc[16];
#pragma unroll
                for (int t = 0; t < 16; ++t) acc[t] = 0.f;
                for (int k4 = 0; k4 < 64; ++k4) { const int k = wave * 256 + k4 * 4;
                    const float w0 = rw[(size_t)(k + 0) * NE + lane], w1 = rw[(size_t)(k + 1) * NE + lane], w2 = rw[(size_t)(k + 2) * NE + lane], w3 = rw[(size_t)(k + 3) * NE + lane];
#pragma unroll
                    for (int t = 0; t < 16; ++t) { const f32x4 x4 = *(const LAS f32x4*)(xs + t * DM + k); acc[t] += x4.x * w0 + x4.y * w1 + x4.z * w2 + x4.w * w3; }
                }
                __syncthreads();
#pragma unroll
                for (int t = 0; t < 16; ++t) xs[(wave * 16 + t) * 64 + lane] = acc[t];
                __syncthreads();
#pragma unroll
                for (int jt = 0; jt < 2; ++jt) { const int tl = wave * 2 + jt;
                    float logit = 0.f;
#pragma unroll
                    for (int w = 0; w < 8; ++w) logit += xs[(w * 16 + tl) * 64 + lane];
                    const float score = 1.0f / (1.0f + expf(-logit));
                    const float sel = score + router_b[l * NE + lane];
                    float m1 = sel; m1 = fmaxf(m1, __shfl_xor(m1, 1)); m1 = fmaxf(m1, __shfl_xor(m1, 2)); m1 = fmaxf(m1, __shfl_xor(m1, 4));
                    const unsigned long long bm = __ballot(sel == m1); const int grp = lane >> 3; const unsigned gbits = (unsigned)(bm >> (grp * 8)) & 0xffu; const int first = __builtin_ctz(gbits);
                    float s2 = ((lane & 7) == first) ? -INFINITY : sel; s2 = fmaxf(s2, __shfl_xor(s2, 1)); s2 = fmaxf(s2, __shfl_xor(s2, 2)); s2 = fmaxf(s2, __shfl_xor(s2, 4));
                    const float gs = m1 + s2;
                    int grank = 0;
#pragma unroll
                    for (int j = 0; j < 8; ++j) { const float gj = __shfl(gs, j * 8); grank += (gj > gs || (gj == gs && j < grp)) ? 1 : 0; }
                    const bool chosen = grank < 4;
                    const float msel = chosen ? sel : -INFINITY;
                    int rk = 0;
#pragma unroll 8
                    for (int j = 0; j < 64; ++j) { const float vj = __shfl(msel, j); rk += (vj > msel || (vj == msel && j < lane)) ? 1 : 0; }
                    const bool selected = chosen && rk < 8;
                    const float ssum = wave_sum(selected ? score : 0.f);
                    selr[tl * 64 + lane] = selected ? rk : -1; gatel[tl * 64 + lane] = score / ssum * ROUTED_SCALE;
                }
                __syncthreads();
                if (wave == 0) {
                    int cl = 0; int lp[16];
#pragma unroll
                    for (int t = 0; t < 16; ++t) { lp[t] = cl; cl += (selr[t * 64 + lane] >= 0) ? 1 : 0; }
                    int base = 0; if (cl > 0) base = (int)__hip_atomic_fetch_add(cntG + lane, (unsigned)cl, RLX_AGENT);
#pragma unroll
                    for (int t = 0; t < 16; ++t) { const int rk = selr[t * 64 + lane];
                        if (rk >= 0) { const int pos = base + lp[t]; list[lane * NTOK + pos] = tok0 + t; wlist[lane * NTOK + pos] = gatel[t * 64 + lane]; slot[(size_t)(tok0 + t) * 8 + rk] = (lane << 16) | pos; } }
                }
            }
        }
        SEAM(pb + 5);

        LAS int* const cnts = (LAS int*)(lds + TAB_OFF); LAS int* const tstart = cnts + 64; LAS int* const tile_e = cnts + 192;
        int ntiles = 0;
        if ((EN(7) && IN(pb + 6)) || (EN(8) && IN(pb + 7)) || (EN(9) && IN(pb + 8))) { PHASE_TID PHASE_PTRS
            __syncthreads();
            if (tid < 64) cnts[tid] = (int)__hip_atomic_load(cntG + tid, RLX_AGENT);
            __syncthreads();
            if (tid == 0) { int s = 0; for (int e = 0; e < 64; ++e) { tstart[e] = s; s += (cnts[e] + 255) >> 8; } tstart[64] = s; }
            __syncthreads();
            if (tid < 64) for (int t = tstart[tid]; t < tstart[tid + 1]; ++t) tile_e[t] = tid;
            __syncthreads();
            ntiles = __builtin_amdgcn_readfirstlane(tstart[64]); if (ntiles > MAXTILES) ntiles = MAXTILES;
        }

        if (EN(7) && IN(pb + 6)) { PHASE_PTRS
            { pg8::MoeSched<true> S{cnts, tstart, tile_e, ntiles, 4, G, vcu, DM, list, WLp + WL_GU, W_GU_B};
              pg8::EpiSwiGLU E{Hs};
              pg8::gemm_phase<pg8::EpiSwiGLU, pg8::MoeSched<true>, true>(lds, (const char*)Hb, DM, S, E); }
            { pg8::PlainSched S; S.init(NTOK, 1024, DM, G, bx, WLp + WL_GU + 64 * W_GU_B);
              pg8::EpiSwiGLU E{Hs + (size_t)SH_ROW0 * DE};
              pg8::gemm_phase<pg8::EpiSwiGLU, pg8::PlainSched, true>(lds, (const char*)Hb, DM, S, E); }
        }
        SEAM(pb + 6);

        if (EN(8) && IN(pb + 7)) { PHASE_PTRS
#if !defined(HSEL) || HSEL == 1
            { pg8::MoeSched<false> S{cnts, tstart, tile_e, ntiles, 8, G, vcu, DE, nullptr, WLp + WL_D, W_D_B};
              pg8::EpiDownY E{Yb, wlist};
              pg8::gemm_phase<pg8::EpiDownY, pg8::MoeSched<false>, true>(lds, (const char*)Hs, DE, S, E); }
#endif
#if !defined(HSEL) || HSEL == 2
            { pg8::PlainSched S; S.init(NTOK, DM, DE, G, bx, WLp + WL_D + 64 * W_D_B);
              pg8::EpiResF32 E{Hf, DM, ALPHA};
              pg8::gemm_phase<pg8::EpiResF32, pg8::PlainSched, true>(lds, (const char*)(Hs + (size_t)SH_ROW0 * DE), DE, S, E); }
#endif
        }
        SEAM(pb + 7);

        if (EN(9) && IN(pb + 8)) { PHASE_TID PHASE_PTRS
            const int gw = vcu * NWAVES + wave, NGW = G * NWAVES;
            for (int tok = gw; tok < NTOK; tok += NGW) {
                f32x4 v[8];
#pragma unroll
                for (int j = 0; j < 8; ++j) v[j] = ((const f32x4*)(Hf + (size_t)tok * DM))[j * 64 + lane];
                const int myslot = slot[(size_t)tok * 8 + (lane & 7)];
#pragma unroll
                for (int k = 0; k < 8; ++k) { const int sl = __shfl(myslot, k); const int e = sl >> 16, pos = sl & 0xffff; const size_t row = (size_t)tstart[e] * 256 + pos;
                    const u32x2* yp = (const u32x2*)(Yb + row * DM);
#pragma unroll
                    for (int j = 0; j < 8; ++j) { const u32x2 w = yp[j * 64 + lane]; v[j].x += bflo(w.x); v[j].y += bfhi(w.x); v[j].z += bflo(w.y); v[j].w += bfhi(w.y); } }
                ln_regs(v, ln2_g + (size_t)l * DM, ln2_b + (size_t)l * DM, lane);
                if (l == 0) { store_row_f32(Hf + (size_t)tok * DM, v, lane); store_row_bf16(Hb + (size_t)tok * DM, v, lane); }
                else store_row_f32(OUTP + (size_t)tok * DM, v, lane);
            }
        }
        SEAM(pb + 8);
    }
#undef IN
#undef SEAM
}

constexpr int NPHASES = 19;
#ifndef ONE_LAUNCH
#define ONE_LAUNCH 0
#endif

extern "C" void kernel_launch(void* const* d_in, const int* in_sizes, int n_in, void* d_out, int out_size, void* d_ws, size_t ws_size, hipStream_t stream) {
    static int grid = 0;
    if (grid == 0) {
        if (n_in != 25 || out_size != NTOK * DM || ws_size < WS_END) { fprintf(stderr, "kernel_launch: unexpected shapes: n_in %d out %d ws %zu (need %zu)\n", n_in, out_size, ws_size, (size_t)WS_END); grid = -1; return; }
        int dev = 0, cus = 0, per_cu = 0;
        if (hipGetDevice(&dev) != hipSuccess || hipDeviceGetAttribute(&cus, hipDeviceAttributeMultiprocessorCount, dev) != hipSuccess) { grid = -1; return; }
        if (hipFuncSetAttribute((const void*)fwd_kernel, hipFuncAttributeMaxDynamicSharedMemorySize, LDS_BYTES) != hipSuccess) { fprintf(stderr, "kernel_launch: hipFuncSetAttribute failed\n"); grid = -1; return; }
        if (hipOccupancyMaxActiveBlocksPerMultiprocessor(&per_cu, (const void*)fwd_kernel, NTHR, LDS_BYTES) != hipSuccess || per_cu < 1) fprintf(stderr, "kernel_launch: occupancy query reports %d\n", per_cu);
        (void)hipGetLastError();
        grid = cus;
    }
    if (grid < 0) return;
    if (hipMemsetAsync((char*)d_ws + WS_CTL, 0, CTL_ZERO_BYTES, stream) != hipSuccess) return;
    Args a{};
    for (int i = 0; i < 25; ++i) a.in[i] = (const float*)d_in[i];
    a.out = (float*)d_out; a.ws = (unsigned char*)d_ws; a.pad = 0;
#if ONE_LAUNCH
    a.ph_lo = 0; a.ph_hi = NPHASES; a.use_bar = 1;
    hipLaunchKernelGGL(fwd_kernel, dim3(grid), dim3(NTHR), LDS_BYTES, stream, a);
#else
    for (int p = 0; p < NPHASES; ++p) { a.ph_lo = p; a.ph_hi = p + 1; a.use_bar = 0; hipLaunchKernelGGL(fwd_kernel, dim3(grid), dim3(NTHR), LDS_BYTES, stream, a); }
#endif
}
```

```cpp
#include <hip/hip_runtime.h>
#include <cstdio>
#include <cstdint>

#define GAS __attribute__((address_space(1)))
#define LAS __attribute__((address_space(3)))
typedef unsigned short bf16;
typedef unsigned short bf16_t;
typedef short bf16x8 __attribute__((ext_vector_type(8)));
typedef float f32x4 __attribute__((ext_vector_type(4)));
typedef float f32x2 __attribute__((ext_vector_type(2)));
typedef unsigned u32x4 __attribute__((ext_vector_type(4)));
typedef unsigned u32x2 __attribute__((ext_vector_type(2)));

constexpr int NTOK = 16384, DM = 2048, DIN = 4352, SEQ = 4096, NBATCH = 4;
constexpr int NE = 64, TOPK = 8, DE = 512;
constexpr float ALPHA = 1.4142135623730951f, LN_EPS = 1e-5f, RMS_EPS = 1e-6f, ROUTED_SCALE = 2.5f;
constexpr int C_HQ = 0, C_HF = 512, C_HI = 1024, C_HG = 1536, C_AQ = 2048, C_AK = 3072, C_AV = 3200, C_SU = 3328, C_SV = 3840;
constexpr int MAXTILES = 576;
constexpr int SH_ROW0 = MAXTILES * 256;
constexpr int HS_ROWS = SH_ROW0 + NTOK;

constexpr size_t MiB = 1u << 20;
constexpr size_t WS_CTL = 0, CTL_ZERO_BYTES = 1 * MiB;
constexpr size_t WS_LIST = 1 * MiB;
constexpr size_t WS_WLIST = 5 * MiB;
constexpr size_t WS_SLOT = 9 * MiB;
constexpr size_t WS_DEND = 10 * MiB;
constexpr size_t WS_STATE = 16 * MiB;
constexpr size_t WS_HF = 64 * MiB;
constexpr size_t WS_HB = 192 * MiB;
constexpr size_t WS_PROJ = 256 * MiB;
constexpr size_t WS_MIXED = 392 * MiB;
constexpr size_t WS_HS = 456 * MiB;
constexpr size_t WS_Y = 616 * MiB;
constexpr size_t WS_W = 1192 * MiB;
constexpr size_t W_IN_B = (size_t)DIN * DM * 2, W_OUT_B = (size_t)DM * DM * 2, W_GU_B = (size_t)1024 * DM * 2, W_D_B = (size_t)DM * DE * 2;
constexpr size_t WL_IN = 0, WL_OUT = W_IN_B, WL_GU = WL_OUT + W_OUT_B, WL_D = WL_GU + 65 * W_GU_B, WL_BYTES = WL_D + 65 * W_D_B;
constexpr size_t WS_END = WS_W + 2 * WL_BYTES;
static_assert(WS_HS + (size_t)HS_ROWS * 512 * 2 <= WS_Y && WS_Y + (size_t)MAXTILES * 256 * DM * 2 <= WS_W && WS_END <= 2048 * MiB, "d_ws map");
constexpr int CW_CNT = 64;
constexpr int CW_BAR = 4096;

constexpr int LDS_BYTES = 147456;
constexpr int MISC_OFF = LDS_BYTES - 256;
constexpr int TAB_OFF = 131072;
constexpr int NWAVES = 8, NTHR = 512;

#define LDS_WAIT() asm volatile("s_waitcnt lgkmcnt(0)" ::: "memory")
#define VM_WAIT() asm volatile("s_waitcnt vmcnt(0)" ::: "memory")
#define RLX_AGENT __ATOMIC_RELAXED, __HIP_MEMORY_SCOPE_AGENT

__device__ __forceinline__ unsigned f2bf(float f) { unsigned u = __builtin_bit_cast(unsigned, f); return (u + 0x7fffu + ((u >> 16) & 1u)) >> 16; }
__device__ __forceinline__ unsigned pk2(float lo, float hi) { return f2bf(lo) | (f2bf(hi) << 16); }
__device__ __forceinline__ float bflo(unsigned w) { return __uint_as_float(w << 16); }
__device__ __forceinline__ float bfhi(unsigned w) { return __uint_as_float(w & 0xffff0000u); }
__device__ __forceinline__ float bf2f(bf16 v) { return __uint_as_float((unsigned)v << 16); }
__device__ __forceinline__ float wave_sum(float v) {
#pragma unroll
    for (int o = 1; o < 64; o <<= 1) v += __shfl_xor(v, o);
    return v;
}
__device__ __forceinline__ float sigmoidf_(float x) { return 1.0f / (1.0f + __expf(-x)); }
__device__ __forceinline__ float siluf_(float x) { return x / (1.0f + __expf(-x)); }
__device__ __forceinline__ float geluf_(float x) { return 0.5f * x * (1.0f + erff(x * 0.70710678118654752f)); }

namespace pg8 {
#define PG8_LAS __attribute__((address_space(3)))
constexpr int BM = 256, BK = 64, HALF = 128, HTB = HALF * BK * 2, STAGE_BYTES = 8 * HTB, NXCD = 8, WGM = 8;
__host__ __device__ __forceinline__ int lds_byte(int r, int c) { const int st = (r >> 4) * 2 + (c >> 5), rr = r & 15, cc = c & 31, ob = rr * 64 + cc * 2; return st * 1024 + (ob ^ (((ob >> 9) & 1) << 5)); }
__host__ __device__ __forceinline__ void stage_rc(int b, int& R, int& C) { const int st = b / 1024, sb = b % 1024, swz = sb ^ (((sb >> 9) & 1) << 5); R = (st >> 1) * 16 + swz / 64; C = (st & 1) * 32 + (swz % 64) / 2; }
__host__ __device__ __forceinline__ int perm32(int rho) { const int n = rho >> 4, i = rho & 15; return 8 * (i >> 2) + 4 * n + (i & 3); }

struct Unit { int pm, pn, e, p0, nv; };

__device__ __forceinline__ unsigned cvt_pk_bf16(float lo, float hi) { unsigned r; asm volatile("v_cvt_pk_bf16_f32 %0, %1, %2" : "=v"(r) : "v"(lo), "v"(hi)); return r; }

struct PlainSched {
    static constexpr bool GATHER = false;
    int nM, nN, nwg, G, c, K; const char* Bt;
    __device__ void init(int M, int N, int K_, int G_, int c_, const void* Bt_) { nM = M / BM; nN = N / BM; nwg = nM * nN; G = G_; c = c_; K = K_; Bt = (const char*)Bt_; }
    __device__ __forceinline__ bool next(int i, Unit& u) const {
        const long L = (long)i * G + c; if (L >= nwg) return false;
        int wgid = (int)L; { const int q = nwg / NXCD, r = nwg % NXCD, xcd = wgid % NXCD, off = wgid / NXCD; wgid = (xcd < r ? xcd * (q + 1) : r * (q + 1) + (xcd - r) * q) + off; }
        const int nig = WGM * nN, gid = wgid / nig, fm = gid * WGM, gsz = (nM - fm) < WGM ? (nM - fm) : WGM;
        u.pm = fm + ((wgid % nig) % gsz); u.pn = (wgid % nig) / gsz; u.e = 0; u.p0 = 0; u.nv = 256; return true;
    }
    __device__ __forceinline__ unsigned arow(const Unit& u, int r) const { return 0u; }
    __device__ __forceinline__ size_t aoff(const Unit& u) const { return (size_t)u.pm * BM * K * 2; }
    __device__ __forceinline__ const char* bbase(const Unit& u) const { return Bt + (size_t)u.pn * BM * K * 2; }
};
template <bool GATHER_> struct MoeSched {
    static constexpr bool GATHER = GATHER_;
    const PG8_LAS int* cnts; const PG8_LAS int* tstart; const PG8_LAS int* tile_e;
    int ntiles, npn, G, vcu, K; const int* list; const char* Bt; size_t estride;
    __device__ __forceinline__ bool next(int i, Unit& u) const {
        const int U = i * G + vcu; if (U >= ntiles * npn) return false;
        u.pm = U / npn; u.pn = U % npn; u.e = __builtin_amdgcn_readfirstlane(tile_e[u.pm]); u.p0 = (u.pm - __builtin_amdgcn_readfirstlane(tstart[u.e])) * BM; const int rem = __builtin_amdgcn_readfirstlane(cnts[u.e]) - u.p0; u.nv = rem < BM ? rem : BM; return true;
    }
    __device__ __forceinline__ unsigned arow(const Unit& u, int r) const { const int tok = (r < u.nv) ? list[u.e * NTOK + u.p0 + r] : 0; return (unsigned)tok * (unsigned)(K * 2); }
    __device__ __forceinline__ size_t aoff(const Unit& u) const { return (size_t)u.pm * BM * K * 2; }
    __device__ __forceinline__ const char* bbase(const Unit& u) const { return Bt + (size_t)u.e * estride + (size_t)u.pn * BM * K * 2; }
};

struct EpiBf16Bias {
    static constexpr bool PERM = true;
    bf16_t* O; int ldc; const float* bias;
    __device__ __forceinline__ void operator()(const f32x4 (&acc)[2][2][4][2], const Unit& u, int wr, int wc, int fr, int fq) const {
        const int row0 = u.pm * BM + wr * 64 + fr, col0 = u.pn * BM + wc * 32 + 8 * fq;
        f32x4 bv[2][2];
#pragma unroll
        for (int bj = 0; bj < 2; ++bj)
#pragma unroll
            for (int n = 0; n < 2; ++n) bv[bj][n] = *(const f32x4*)(bias + col0 + bj * HALF + 4 * n);
#pragma unroll
        for (int ai = 0; ai < 2; ++ai)
#pragma unroll
            for (int m = 0; m < 4; ++m) { bf16_t* rowp = O + (size_t)(row0 + ai * HALF + m * 16) * ldc + col0;
#pragma unroll
                for (int bj = 0; bj < 2; ++bj) { const f32x4 v0 = acc[ai][bj][m][0] + bv[bj][0], v1 = acc[ai][bj][m][1] + bv[bj][1];
                    u32x4 w; w.x = cvt_pk_bf16(v0[0], v0[1]); w.y = cvt_pk_bf16(v0[2], v0[3]); w.z = cvt_pk_bf16(v1[0], v1[1]); w.w = cvt_pk_bf16(v1[2], v1[3]);
                    *(u32x4*)(rowp + bj * HALF) = w; } }
    }
};
struct EpiResF32 {
    static constexpr bool PERM = false;
    float* C; int ldc; float alpha;
    __device__ __forceinline__ void operator()(const f32x4 (&acc)[2][2][4][2], const Unit& u, int wr, int wc, int fr, int fq) const {
        const int row0 = u.pm * BM + wr * 64 + fr, col0 = u.pn * BM + wc * 32 + 4 * fq;
#pragma unroll
        for (int ai = 0; ai < 2; ++ai)
#pragma unroll
            for (int m = 0; m < 4; ++m) { float* rowp = C + (size_t)(row0 + ai * HALF + m * 16) * ldc + col0;
#pragma unroll
                for (int bj = 0; bj < 2; ++bj)
#pragma unroll
                    for (int n = 0; n < 2; ++n) { f32x4* p = (f32x4*)(rowp + bj * HALF + n * 16); const f32x4 o = *p; *p = o * alpha + acc[ai][bj][m][n]; } }
    }
};
struct EpiSwiGLU {
    static constexpr bool PERM = true;
    bf16_t* O;
    __device__ __forceinline__ void operator()(const f32x4 (&acc)[2][2][4][2], const Unit& u, int wr, int wc, int fr, int fq) const {
        const int row0 = u.pm * BM + wr * 64 + fr, col0 = u.pn * HALF + wc * 32 + 8 * fq;
#pragma unroll
        for (int ai = 0; ai < 2; ++ai)
#pragma unroll
            for (int m = 0; m < 4; ++m) { bf16_t* rowp = O + (size_t)(row0 + ai * HALF + m * 16) * DE + col0;
                float o[8];
#pragma unroll
                for (int n = 0; n < 2; ++n)
#pragma unroll
                    for (int j = 0; j < 4; ++j) { const float g = acc[ai][0][m][n][j], up = acc[ai][1][m][n][j]; o[n * 4 + j] = g / (1.0f + __expf(-g)) * up; }
                u32x4 w; w.x = cvt_pk_bf16(o[0], o[1]); w.y = cvt_pk_bf16(o[2], o[3]); w.z = cvt_pk_bf16(o[4], o[5]); w.w = cvt_pk_bf16(o[6], o[7]);
                *(u32x4*)rowp = w; }
    }
};
struct EpiDownY {
    static constexpr bool PERM = true;
    bf16_t* Y; const float* wlist;
    __device__ __forceinline__ void operator()(const f32x4 (&acc)[2][2][4][2], const Unit& u, int wr, int wc, int fr, int fq) const {
        const int rl0 = wr * 64 + fr, col0 = u.pn * BM + wc * 32 + 8 * fq;
#pragma unroll
        for (int ai = 0; ai < 2; ++ai)
#pragma unroll
            for (int m = 0; m < 4; ++m) { const int rl = rl0 + ai * HALF + m * 16; const float w8 = (rl < u.nv) ? wlist[u.e * NTOK + u.p0 + rl] : 0.f;
                bf16_t* rowp = Y + (size_t)(u.pm * BM + rl) * DM + col0;
#pragma unroll
                for (int bj = 0; bj < 2; ++bj) { const f32x4 v0 = acc[ai][bj][m][0] * w8, v1 = acc[ai][bj][m][1] * w8;
                    u32x4 w; w.x = cvt_pk_bf16(v0[0], v0[1]); w.y = cvt_pk_bf16(v0[2], v0[3]); w.z = cvt_pk_bf16(v1[0], v1[1]); w.w = cvt_pk_bf16(v1[2], v1[3]);
                    *(u32x4*)(rowp + bj * HALF) = w; } }
    }
};

template <class Epi, class Sched, bool ALIGN_EPI>
__device__ __forceinline__ void gemm_phase(PG8_LAS unsigned char* lds, const char* Abase, const int K, const Sched& S, const Epi& E) {
    int tid_ = threadIdx.x; asm volatile("" : "+v"(tid_));
    const int tid = tid_, wid = __builtin_amdgcn_readfirstlane(tid >> 6), lane = tid & 63, wr = wid >> 2, wc = wid & 3, fr = lane & 15, fq = lane >> 4;
    const int nt = K / BK;
    int RA[2]; unsigned CA2[2], voffB[2];
#pragma unroll
    for (int i = 0; i < 2; ++i) { int R, C; stage_rc(tid * 16 + i * 8192, R, C); const int Rb = Epi::PERM ? ((R & ~31) + perm32(R & 31)) : R;
        RA[i] = R; CA2[i] = (unsigned)C * 2u; voffB[i] = (unsigned)(Rb * K + C) * 2u; }
    const size_t kstep = (size_t)(BK * 2);
    const size_t hstep = (size_t)HALF * K * 2;
    const unsigned ldsw = (unsigned)wid * 1024u;
    const int aoff = lds_byte(wr * 64 + fr, fq * 8), boff = lds_byte(wc * 32 + fr, fq * 8);
#define PG8_SA(b, h) (((b) * 2 + (h)) * HTB)
#define PG8_SB(b, h) ((4 + (b) * 2 + (h)) * HTB)
#define PG8_STAGE(bufoff, gbase, voff) do { _Pragma("unroll") for (int _i = 0; _i < 2; ++_i) \
        __builtin_amdgcn_global_load_lds((const unsigned*)((const char*)(gbase) + (voff)[_i]), (PG8_LAS unsigned*)(lds + (bufoff) + ldsw + _i * 8192), 16, 0, 0); } while (0)
#define PG8_LDA(dst, b, h) do { _Pragma("unroll") for (int m = 0; m < 4; ++m) _Pragma("unroll") for (int k = 0; k < 2; ++k) dst[m][k] = *(const PG8_LAS bf16x8*)(lds + PG8_SA(b, h) + aoff + m * 2048 + k * 1024); } while (0)
#define PG8_LDB(dst, b, h) do { _Pragma("unroll") for (int n = 0; n < 2; ++n) _Pragma("unroll") for (int k = 0; k < 2; ++k) dst[n][k] = *(const PG8_LAS bf16x8*)(lds + PG8_SB(b, h) + boff + n * 2048 + k * 1024); } while (0)
#define PG8_MMA(ai, bj, At, Bt) do { __builtin_amdgcn_s_setprio(1); _Pragma("unroll") for (int m = 0; m < 4; ++m) _Pragma("unroll") for (int n = 0; n < 2; ++n) _Pragma("unroll") for (int k = 0; k < 2; ++k) \
        acc[ai][bj][m][n] = __builtin_amdgcn_mfma_f32_16x16x32_bf16(Bt[n][k], At[m][k], acc[ai][bj][m][n], 0, 0, 0); __builtin_amdgcn_s_setprio(0); } while (0)
#define PG8_WAIT_V(n) asm volatile("s_waitcnt vmcnt(" #n ")" ::: "memory")
#define PG8_WAIT_L(n) asm volatile("s_waitcnt lgkmcnt(" #n ")" ::: "memory")
#define PG8_BAR __builtin_amdgcn_s_barrier()
#define PG8_SCHED __builtin_amdgcn_sched_barrier(0)
    Unit cur, nxt; int ui = 0;
    if (!S.next(0, cur)) return;
    f32x4 acc[2][2][4][2];
#pragma unroll
    for (int a = 0; a < 2; ++a)
#pragma unroll
        for (int b = 0; b < 2; ++b)
#pragma unroll
            for (int m = 0; m < 4; ++m)
#pragma unroll
                for (int n = 0; n < 2; ++n) acc[a][b][m][n] = (f32x4){0.f, 0.f, 0.f, 0.f};
    bf16x8 At[4][2], B0[2][2], B1[2][2];
    unsigned voffA[2], ca0[2], ca1[2], na0[2], na1[2];
#pragma unroll
    for (int i = 0; i < 2; ++i) { voffA[i] = (unsigned)(RA[i] * K) * 2u + CA2[i]; ca0[i] = ca1[i] = na0[i] = na1[i] = 0u; }
    const char* cA = Abase; const char* cB = S.bbase(cur);
    if constexpr (Sched::GATHER) {
#pragma unroll
        for (int i = 0; i < 2; ++i) { ca0[i] = S.arow(cur, RA[i]) + CA2[i]; ca1[i] = S.arow(cur, HALF + RA[i]) + CA2[i]; }
    } else cA = Abase + S.aoff(cur);
#define PG8_STAGE_A(bufoff, p, h, g0, g1) do { if constexpr (Sched::GATHER) { if ((h) == 0) PG8_STAGE(bufoff, p, g0); else PG8_STAGE(bufoff, p, g1); } \
        else { PG8_STAGE(bufoff, (p) + (h) * hstep, voffA); } } while (0)
    PG8_STAGE(PG8_SB(0, 0), cB, voffB); PG8_STAGE(PG8_SB(0, 1), cB + hstep, voffB); PG8_STAGE_A(PG8_SA(0, 0), cA, 0, ca0, ca1); PG8_STAGE_A(PG8_SA(0, 1), cA, 1, ca0, ca1);
    if (wr == 1) PG8_BAR;
    PG8_WAIT_V(2); PG8_BAR;
    PG8_STAGE(PG8_SB(1, 0), cB + kstep, voffB); PG8_STAGE_A(PG8_SA(1, 0), cA + kstep, 0, ca0, ca1); PG8_STAGE(PG8_SB(1, 1), cB + hstep + kstep, voffB);
    PG8_WAIT_V(6); PG8_BAR;
    for (;;) {
        const bool has_next = S.next(ui + 1, nxt);
        const char* nA = cA; const char* nB = has_next ? S.bbase(nxt) : cB;
        if constexpr (Sched::GATHER) {
            if (has_next) {
#pragma unroll
                for (int i = 0; i < 2; ++i) { na0[i] = S.arow(nxt, RA[i]) + CA2[i]; na1[i] = S.arow(nxt, HALF + RA[i]) + CA2[i]; }
            } else {
#pragma unroll
                for (int i = 0; i < 2; ++i) { na0[i] = ca0[i]; na1[i] = ca1[i]; }
            }
        } else { if (has_next) nA = Abase + S.aoff(nxt); }
        for (int t = 0; t < nt; t += 2) {
            const bool last = (t == nt - 2);
            const char* a1 = cA + (size_t)(t + 1) * kstep;
            const char* a2 = last ? nA : cA + (size_t)(t + 2) * kstep; const char* b2 = last ? nB : cB + (size_t)(t + 2) * kstep;
            const char* a3 = a2 + kstep; const char* b3 = b2 + kstep;
            unsigned s0[2], s1[2];
#pragma unroll
            for (int i = 0; i < 2; ++i) { s0[i] = last ? na0[i] : ca0[i]; s1[i] = last ? na1[i] : ca1[i]; }
            PG8_LDB(B0, 0, 0); PG8_LDB(B1, 0, 1); PG8_SCHED; PG8_LDA(At, 0, 0); PG8_STAGE_A(PG8_SA(1, 1), a1, 1, ca0, ca1);
            PG8_WAIT_V(8); PG8_WAIT_L(0); PG8_BAR; PG8_MMA(0, 0, At, B0); PG8_MMA(0, 1, At, B1); PG8_BAR; PG8_SCHED;
            PG8_LDA(At, 0, 1); PG8_STAGE(PG8_SB(0, 0), b2, voffB); PG8_STAGE(PG8_SB(0, 1), b2 + hstep, voffB); PG8_STAGE_A(PG8_SA(0, 0), a2, 0, s0, s1);
            PG8_WAIT_V(8); PG8_WAIT_L(0); PG8_BAR; PG8_MMA(1, 0, At, B0); PG8_MMA(1, 1, At, B1); PG8_BAR; PG8_SCHED;
            PG8_LDB(B0, 1, 0); PG8_LDB(B1, 1, 1); PG8_SCHED; PG8_LDA(At, 1, 0); PG8_STAGE_A(PG8_SA(0, 1), a2, 1, s0, s1);
            PG8_WAIT_V(8); PG8_WAIT_L(0); PG8_BAR; PG8_MMA(0, 0, At, B0); PG8_MMA(0, 1, At, B1); PG8_BAR; PG8_SCHED;
            PG8_LDA(At, 1, 1); PG8_STAGE(PG8_SB(1, 0), b3, voffB); PG8_STAGE(PG8_SB(1, 1), b3 + hstep, voffB); PG8_STAGE_A(PG8_SA(1, 0), a3, 0, s0, s1);
            PG8_WAIT_V(8); PG8_WAIT_L(0); PG8_BAR; PG8_MMA(1, 0, At, B0); PG8_MMA(1, 1, At, B1); PG8_BAR; PG8_SCHED;
        }
        if constexpr (ALIGN_EPI) { if (wr == 0) PG8_BAR; }
        E(acc, cur, wr, wc, fr, fq);
        if (!has_next) break;
#pragma unroll
        for (int a = 0; a < 2; ++a)
#pragma unroll
            for (int b = 0; b < 2; ++b)
#pragma unroll
                for (int m = 0; m < 4; ++m)
#pragma unroll
                    for (int n = 0; n < 2; ++n) acc[a][b][m][n] = (f32x4){0.f, 0.f, 0.f, 0.f};
        cur = nxt; cA = nA; cB = nB; ++ui;
        if constexpr (Sched::GATHER) {
#pragma unroll
            for (int i = 0; i < 2; ++i) { ca0[i] = na0[i]; ca1[i] = na1[i]; }
        }
        if constexpr (ALIGN_EPI) { if (wr == 1) PG8_BAR; }
    }
    PG8_WAIT_V(0);
    if constexpr (!ALIGN_EPI) { if (wr == 0) PG8_BAR; }
    PG8_BAR;
#undef PG8_SA
#undef PG8_SB
#undef PG8_STAGE
#undef PG8_LDA
#undef PG8_LDB
#undef PG8_MMA
#undef PG8_WAIT_V
#undef PG8_WAIT_L
#undef PG8_BAR
#undef PG8_SCHED
#undef PG8_STAGE_A
}
}

#define XB_TMO      128
#define XB_XCNT(j)  (256  + 64 * (j))
#define XB_XSUB(j)  (1280 + 64 * (j))
#define XB_XGEN(j)  (2304 + 64 * (j))
#define XB_TOP      3328
#define XB_TOPGEN   3392
#define XCD_BAR_WORDS 3456
#define XB_SPIN_CAP (1u << 18)
__device__ __forceinline__ unsigned xb_ld(unsigned* p)              { return __hip_atomic_load(p, __ATOMIC_RELAXED, __HIP_MEMORY_SCOPE_AGENT); }
__device__ __forceinline__ unsigned xb_add(unsigned* p, unsigned v) { return __hip_atomic_fetch_add(p, v, __ATOMIC_RELAXED, __HIP_MEMORY_SCOPE_AGENT); }
__device__ __forceinline__ unsigned xb_xcc_id() { return (unsigned)__builtin_amdgcn_s_getreg((3 << 11) | 20) & 0xFu; }
#define XB_SPIN(cond, bar) do { unsigned _sp = 0; while (cond) { __builtin_amdgcn_s_sleep(1); \
    if ((++_sp & 255u) == 0u) { if (xb_ld(&(bar)[XB_TMO])) break; if (_sp > XB_SPIN_CAP) { atomicAdd(&(bar)[XB_TMO], 1u); break; } } } } while (0)
struct XcdBarrier { unsigned* bar; unsigned x; volatile LAS unsigned* st; };
__device__ __forceinline__ XcdBarrier xcd_barrier_post(unsigned* bar, volatile LAS unsigned* st) {
    XcdBarrier b; b.bar = bar; b.x = xb_xcc_id(); b.st = st;
    if (threadIdx.x == 0) (void)xb_add(&bar[XB_XCNT(b.x)], 1u);
    return b;
}
__device__ __forceinline__ void xcd_barrier_complete(unsigned* bar, unsigned x, unsigned& nloc, unsigned& nx) {
    const unsigned G = gridDim.x * gridDim.y * gridDim.z;
    unsigned sum, cnt, mine, sp = 0u;
    for (;;) {
        sum = 0u; cnt = 0u; mine = 0u;
#pragma unroll
        for (unsigned j = 0; j < 16; ++j) { const unsigned c = xb_ld(&bar[XB_XCNT(j)]); sum += c; cnt += (c > 0u) ? 1u : 0u; mine = (j == x) ? c : mine; }
        if (sum == G) break;
        __builtin_amdgcn_s_sleep(1);
        if ((++sp & 255u) == 0u) { if (xb_ld(&bar[XB_TMO])) break; if (sp > XB_SPIN_CAP) { atomicAdd(&bar[XB_TMO], 1u); break; } }
    }
    nloc = mine > 0u ? mine : 1u; nx = cnt > 0u ? cnt : 1u;
}
__device__ __forceinline__ void xcd_barrier(const XcdBarrier& b) {
    asm volatile("s_waitcnt vmcnt(0)" ::: "memory");
    __syncthreads();
    if (threadIdx.x == 0) {
        unsigned* bar = b.bar;
        __builtin_amdgcn_s_waitcnt(0);
        unsigned nloc = b.st[0], nx = b.st[1];
        if (nloc == 0u) { xcd_barrier_complete(bar, b.x, nloc, nx); b.st[0] = nloc; b.st[1] = nx; }
        const unsigned old = xb_add(&bar[XB_XSUB(b.x)], 1u);
        const unsigned gen = old / nloc;
        if (old + 1u == (gen + 1u) * nloc) {
            __builtin_amdgcn_fence(__ATOMIC_RELEASE, "agent");
            asm volatile("s_waitcnt vmcnt(0)" ::: "memory");
            const unsigned og = xb_add(&bar[XB_TOP], 1u);
            const unsigned tg = og / nx;
            if (og + 1u == (tg + 1u) * nx) xb_add(&bar[XB_TOPGEN], 1u);
            else XB_SPIN(xb_ld(&bar[XB_TOPGEN]) == tg, bar);
            __builtin_amdgcn_fence(__ATOMIC_ACQUIRE, "agent");
            xb_add(&bar[XB_XGEN(b.x)], 1u);
            asm volatile("s_waitcnt vmcnt(0)" ::: "memory");
        } else {
            XB_SPIN(xb_ld(&bar[XB_XGEN(b.x)]) == gen, bar);
            __builtin_amdgcn_fence(__ATOMIC_ACQUIRE, "agent");
            asm volatile("s_waitcnt vmcnt(0)" ::: "memory");
        }
    }
    __syncthreads();
}

struct Args { const float* in[25]; float* out; unsigned char* ws; int ph_lo, ph_hi, use_bar, pad; };
struct Frame {
    LAS unsigned char* lds; unsigned* ctl; int tid, lane, wave, vcu, G;
    const float* const* in_;
};

__device__ __forceinline__ void transpose_item(const float* W, int K, int N, bf16* WT, int mode, LAS float* scr, int item, int lane) {
    const int nblk = N / 32, kb = item / nblk, nb = item % nblk, k0 = 64 * kb, n0 = 32 * nb;
#pragma unroll 8
    for (int i = 0; i < 32; ++i) { const int kk = 2 * i + (lane >> 5); scr[kk * 33 + (lane & 31)] = W[(size_t)(k0 + kk) * N + n0 + (lane & 31)]; }
    LDS_WAIT(); asm volatile("" ::: "memory");
    const int r0 = mode ? ((n0 >> 7) * 256 + (n0 & 127) + (mode == 2 ? 128 : 0)) : n0;
    const int c = lane & 7;
#pragma unroll
    for (int j = 0; j < 4; ++j) { const int n = (lane >> 3) + 8 * j; const LAS float* s = scr + (8 * c) * 33 + n;
        u32x4 o; o.x = pk2(s[0 * 33], s[1 * 33]); o.y = pk2(s[2 * 33], s[3 * 33]); o.z = pk2(s[4 * 33], s[5 * 33]); o.w = pk2(s[6 * 33], s[7 * 33]);
        *(u32x4*)(WT + (size_t)(r0 + n) * K + k0 + 8 * c) = o; }
    LDS_WAIT(); asm volatile("" ::: "memory");
}
constexpr int IT_IN = (DM / 64) * (DIN / 32), IT_OUT = (DM / 64) * (DM / 32), IT_G = (DM / 64) * (DE / 32), IT_D = (DE / 64) * (DM / 32);
constexpr int IT_LAYER = IT_IN + IT_OUT + 65 * (2 * IT_G + IT_D);

__device__ __forceinline__ void ln_regs(f32x4 (&v)[8], const float* gain, const float* bias, int lane) {
    float s = 0.f;
#pragma unroll
    for (int j = 0; j < 8; ++j) s += (v[j].x + v[j].y) + (v[j].z + v[j].w);
    const float mean = wave_sum(s) * (1.f / DM); float s2 = 0.f;
#pragma unroll
    for (int j = 0; j < 8; ++j) { v[j] = v[j] - mean; s2 += (v[j].x * v[j].x + v[j].y * v[j].y) + (v[j].z * v[j].z + v[j].w * v[j].w); }
    const float rstd = 1.f / sqrtf(wave_sum(s2) * (1.f / DM) + LN_EPS);
#pragma unroll
    for (int j = 0; j < 8; ++j) { const f32x4 g = ((const f32x4*)gain)[j * 64 + lane], b = ((const f32x4*)bias)[j * 64 + lane]; v[j] = v[j] * rstd * g + b; }
}
__device__ __forceinline__ void store_row_f32(float* dst, const f32x4 (&v)[8], int lane) {
#pragma unroll
    for (int j = 0; j < 8; ++j) ((f32x4*)dst)[j * 64 + lane] = v[j];
}
__device__ __forceinline__ void store_row_bf16(bf16* dst, const f32x4 (&v)[8], int lane) {
#pragma unroll
    for (int j = 0; j < 8; ++j) { u32x2 w; w.x = pk2(v[j].x, v[j].y); w.y = pk2(v[j].z, v[j].w); ((u32x2*)dst)[j * 64 + lane] = w; }
}

#define KAS __attribute__((address_space(4)))
#define PHASE_PTRS const char KAS* kp_ = (const char KAS*)__builtin_amdgcn_kernarg_segment_ptr(); asm volatile("" : "+s"(kp_)); unsigned char* const ws = *(unsigned char* const KAS*)(kp_ + 26 * 8); (void)ws;
#define INP(k) (*(const float* const KAS*)(kp_ + (k) * 8))
#define x_in INP(0)
#define ln0_g INP(1)
#define ln0_b INP(2)
#define w_in INP(3)
#define b_in INP(4)
#define lb_logits INP(5)
#define sw_sinks INP(6)
#define sg_ln_g INP(7)
#define sg_ln_b INP(8)
#define sg_w_s INP(9)
#define sg_b_s INP(10)
#define mix_gain INP(11)
#define w_out INP(12)
#define ln1_g INP(13)
#define ln1_b INP(14)
#define router_w INP(15)
#define router_b INP(16)
#define ew_gate INP(17)
#define ew_up INP(18)
#define ew_down INP(19)
#define sh_gate INP(20)
#define sh_up INP(21)
#define sh_down INP(22)
#define ln2_g INP(23)
#define ln2_b INP(24)
#define OUTP (*(float* const KAS*)(kp_ + 25 * 8))
#define list ((int*)(ws + WS_LIST))
#define wlist ((float*)(ws + WS_WLIST))
#define slot ((int*)(ws + WS_SLOT))
#define dendG ((float*)(ws + WS_DEND))
#define stateG ((float*)(ws + WS_STATE))
#define Hf ((float*)(ws + WS_HF))
#define Hb ((bf16*)(ws + WS_HB))
#define proj ((bf16*)(ws + WS_PROJ))
#define mixed ((bf16*)(ws + WS_MIXED))
#define Hs ((bf16*)(ws + WS_HS))
#define Yb ((bf16*)(ws + WS_Y))
#define ctl ((unsigned*)(ws + WS_CTL))
#define WLp ((const char*)(ws + WS_W + (size_t)l * WL_BYTES))
#define cntG (ctl + CW_CNT + l * 64)
__global__ void __launch_bounds__(NTHR, 2) fwd_kernel(Args args) {
    extern __shared__ __attribute__((aligned(16))) unsigned char lds_raw[];
    LAS unsigned char* const lds = (LAS unsigned char*)lds_raw;
    const int tid = threadIdx.x, lane = tid & 63, wave = __builtin_amdgcn_readfirstlane(tid >> 6);
    const int G = gridDim.x, bx = blockIdx.x;
    const int vcu = (G % 8 == 0) ? (bx % 8) * (G / 8) + bx / 8 : bx;
    volatile LAS unsigned* MISC = (volatile LAS unsigned*)(lds + MISC_OFF);
    if (tid < 64) MISC[tid] = 0u;
    __syncthreads();
    XcdBarrier bar; bar.bar = (unsigned*)(args.ws + WS_CTL) + CW_BAR; bar.x = 0; bar.st = nullptr;
    if (args.use_bar) bar = xcd_barrier_post((unsigned*)(args.ws + WS_CTL) + CW_BAR, MISC + 8);
    const int lo = args.ph_lo, hi = args.ph_hi;
#define PHASE_TID int tid_o_ = threadIdx.x; asm volatile("" : "+v"(tid_o_)); const int tid = tid_o_, lane = tid & 63; (void)lane; (void)tid;
#ifndef BSEL
#define BSEL 7
#endif
#ifndef PHMASK
#define PHMASK 0x3ff
#endif
#define IN(k) (lo <= (k) && (k) < hi)
#define EN(i) ((PHMASK >> (i)) & 1)
#define SEAM(k) do { if (IN(k) && IN((k) + 1)) xcd_barrier(bar); } while (0)

    if (EN(0) && IN(0)) { PHASE_TID PHASE_PTRS
        LAS float* scr = (LAS float*)(lds + wave * 16384);
        const int gw = vcu * NWAVES + wave, NGW = G * NWAVES;
        for (int it = gw; it < 2 * IT_LAYER; it += NGW) {
            const int l = it / IT_LAYER; int r = it % IT_LAYER;
            bf16* const WL = (bf16*)(ws + WS_W + (size_t)l * WL_BYTES);
            if (r < IT_IN) { transpose_item(w_in + (size_t)l * DM * DIN, DM, DIN, (bf16*)((char*)WLp + WL_IN), 0, scr, r, lane); continue; } r -= IT_IN;
            if (r < IT_OUT) { transpose_item(w_out + (size_t)l * DM * DM, DM, DM, (bf16*)((char*)WLp + WL_OUT), 0, scr, r, lane); continue; } r -= IT_OUT;
            const int e = r / (2 * IT_G + IT_D); r = r % (2 * IT_G + IT_D);
            bf16* const gu = (bf16*)((char*)WLp + WL_GU + (size_t)e * W_GU_B); bf16* const dn = (bf16*)((char*)WLp + WL_D + (size_t)e * W_D_B);
            if (r < IT_G) { const float* src = (e < 64) ? ew_gate + ((size_t)l * 64 + e) * DM * DE : sh_gate + (size_t)l * DM * DE; transpose_item(src, DM, DE, gu, 1, scr, r, lane); continue; } r -= IT_G;
            if (r < IT_G) { const float* src = (e < 64) ? ew_up + ((size_t)l * 64 + e) * DM * DE : sh_up + (size_t)l * DM * DE; transpose_item(src, DM, DE, gu, 2, scr, r, lane); continue; } r -= IT_G;
            { const float* src = (e < 64) ? ew_down + ((size_t)l * 64 + e) * DE * DM : sh_down + (size_t)l * DE * DM; transpose_item(src, DE, DM, dn, 0, scr, r, lane); }
        }
        for (int m = gw; m < NTOK; m += NGW) {
            f32x4 v[8];
#pragma unroll
            for (int j = 0; j < 8; ++j) v[j] = ((const f32x4*)(x_in + (size_t)m * DM))[j * 64 + lane];
            ln_regs(v, ln0_g, ln0_b, lane);
            store_row_f32(Hf + (size_t)m * DM, v, lane); store_row_bf16(Hb + (size_t)m * DM, v, lane);
        }
    }
    SEAM(0);

    for (int l = 0; l < 2; ++l) {
        const int pb = 1 + l * 9;

        if (EN(1) && IN(pb + 0)) { PHASE_PTRS
            pg8::PlainSched S; S.init(NTOK, DIN, DM, G, bx, WLp + WL_IN);
            pg8::EpiBf16Bias E{proj, DIN, b_in + (size_t)l * DIN};
            pg8::gemm_phase<pg8::EpiBf16Bias, pg8::PlainSched, true>(lds, (const char*)Hb, DM, S, E);
        }
        SEAM(pb + 0);

        if (EN(2) && IN(pb + 1)) {
            if (BSEL & 1) { PHASE_TID PHASE_PTRS
            for (int unit = bx; unit < 512; unit += G) {
                const int bh = unit >> 5, c = unit & 31, b = bh >> 2, h = bh & 3, row0 = b * SEQ + c * 128;
                LAS float* bL = (LAS float*)lds;
                LAS bf16* kkb = (LAS bf16*)(lds + 65536);
                LAS bf16* vb = (LAS bf16*)(lds + 98304);
                LAS float* segtot = (LAS float*)(lds + 131072);
                LAS float* bendL = (LAS float*)(lds + 131072 + 2048);
                LAS float* lbs = (LAS float*)(lds + 131072 + 2560);
                if (tid < 128) { float lb = 0.f; if (l == 1) { const float a0 = lb_logits[h * 128 + tid], a1 = lb_logits[512 + h * 128 + tid]; lb = 1.0f / (1.0f + expf(a0 - a1)); } lbs[tid] = lb; }
                __syncthreads();
#pragma unroll
                for (int i = 0; i < 4; ++i) {
                    const int idx = tid + NTHR * i, t = idx >> 4, kg = idx & 15;
                    const bf16* rowp = proj + (size_t)(row0 + t) * DIN + h * 128 + kg * 8;
                    const u32x4 z8 = *(const u32x4*)(rowp + C_HF); const u32x4 v8 = *(const u32x4*)(rowp + C_HI);
                    const unsigned zw[4] = {z8.x, z8.y, z8.z, z8.w};
                    unsigned kw[4];
#pragma unroll
                    for (int j = 0; j < 4; ++j) {
                        float kk2[2];
#pragma unroll
                        for (int q = 0; q < 2; ++q) {
                            const float z = q ? bfhi(zw[j]) : bflo(zw[j]); const int k = kg * 8 + j * 2 + q; const float lb = lbs[k];
                            const float ls = fminf(z, 0.f) - log1pf(expf(-fabsf(z)));
                            const float lf = (lb == 0.f) ? ls : logf(lb + (1.f - lb) * expf(ls));
                            bL[t * 128 + k] = lf; kk2[q] = (1.f - lb) / (1.f + expf(z));
                        }
                        kw[j] = pk2(kk2[0], kk2[1]);
                    }
                    *(LAS u32x4*)(kkb + t * 128 + kg * 8) = (u32x4){kw[0], kw[1], kw[2], kw[3]};
                    *(LAS u32x4*)(vb + t * 128 + kg * 8) = v8;
                }
                __syncthreads();
                { const int k = tid & 127, seg = tid >> 7; float run = 0.f;
                    for (int tt = 0; tt < 32; ++tt) { const int t = seg * 32 + tt; run += bL[t * 128 + k]; bL[t * 128 + k] = run; }
                    segtot[seg * 128 + k] = run;
                    __syncthreads();
                    float off = 0.f, tot = 0.f;
#pragma unroll
                    for (int s = 0; s < 4; ++s) { const float v = segtot[s * 128 + k]; if (s < seg) off += v; tot += v; }
                    if (seg > 0) for (int tt = 0; tt < 32; ++tt) { const int t = seg * 32 + tt; bL[t * 128 + k] += off; }
                    if (seg == 0) { bendL[k] = tot; dendG[(size_t)(bh * 32 + c) * 128 + k] = expf(tot); }
                }
                __syncthreads();
                for (int i = 0; i < 32; ++i) { const int idx = tid + NTHR * i, t = idx >> 7, k = idx & 127; bL[idx] = bf2f(kkb[idx]) * expf(bendL[k] - bL[idx]); (void)t; }
                __syncthreads();
                { const int kq = tid >> 4, vq = tid & 15, k0 = 4 * kq, v0 = 8 * vq;
                    float acc[4][8];
#pragma unroll
                    for (int i = 0; i < 4; ++i)
#pragma unroll
                        for (int j = 0; j < 8; ++j) acc[i][j] = 0.f;
                    for (int t = 0; t < 128; ++t) {
                        const f32x4 a4 = *(const LAS f32x4*)(bL + t * 128 + k0); const u32x4 v8 = *(const LAS u32x4*)(vb + t * 128 + v0);
                        const float vf[8] = {bflo(v8.x), bfhi(v8.x), bflo(v8.y), bfhi(v8.y), bflo(v8.z), bfhi(v8.z), bflo(v8.w), bfhi(v8.w)};
#pragma unroll
                        for (int i = 0; i < 4; ++i)
#pragma unroll
                            for (int j = 0; j < 8; ++j) acc[i][j] += a4[i] * vf[j];
                    }
                    float* sp = stateG + ((size_t)(bh * 32 + c) * 128 + k0) * 128 + v0;
#pragma unroll
                    for (int i = 0; i < 4; ++i) { *(f32x4*)(sp + i * 128) = (f32x4){acc[i][0], acc[i][1], acc[i][2], acc[i][3]}; *(f32x4*)(sp + i * 128 + 4) = (f32x4){acc[i][4], acc[i][5], acc[i][6], acc[i][7]}; }
                }
                __syncthreads();
            }
            }
            if (BSEL & 2) { PHASE_TID PHASE_PTRS
            for (int unit = bx; unit < 256; unit += G) {
                const int b = unit >> 6, blk = (unit >> 1) & 31, half = unit & 1;
                const int kp0 = blk * 128 - 128 + 64 * half;
                const int qp0 = blk * 128 + 64 * half;
                LAS float* Kl = (LAS float*)lds;
                LAS float* Vl = (LAS float*)(lds + 49152);
                LAS float* ssq = (LAS float*)(lds + 98304);
                const int dh = lane & 1;
                for (int pi = 0; pi < 4; ++pi) {
                    const int combo = pi * 8 + wave, hd = combo >> 1, r = (combo & 1) * 32 + (lane >> 1), kvh = pi >> 1;
                    if ((pi & 1) == 0) {
                        __syncthreads();
                        for (int i = 0; i < 6; ++i) {
                            const int idx = tid + NTHR * i, arr = idx / 1536, rem = idx % 1536, s = rem >> 3, ch = rem & 7, kp = kp0 + s;
                            u32x4 w = (u32x4){0u, 0u, 0u, 0u};
                            if (kp >= 0) w = *(const u32x4*)(proj + (size_t)(b * SEQ + kp) * DIN + (arr ? C_AV : C_AK) + kvh * 64 + ch * 8);
                            LAS float* d = (arr ? Vl : Kl) + s * 64 + ch * 8;
                            *(LAS f32x4*)d = (f32x4){bflo(w.x), bfhi(w.x), bflo(w.y), bfhi(w.y)}; *(LAS f32x4*)(d + 4) = (f32x4){bflo(w.z), bfhi(w.z), bflo(w.w), bfhi(w.w)};
                        }
                        __syncthreads();
                    }
                    float q[32], acc[32];
                    { const bf16* qp = proj + (size_t)(b * SEQ + qp0 + r) * DIN + C_AQ + hd * 64 + dh * 32;
#pragma unroll
                        for (int c8 = 0; c8 < 4; ++c8) { const u32x4 w = *(const u32x4*)(qp + c8 * 8);
                            q[c8 * 8 + 0] = bflo(w.x) * 0.125f; q[c8 * 8 + 1] = bfhi(w.x) * 0.125f; q[c8 * 8 + 2] = bflo(w.y) * 0.125f; q[c8 * 8 + 3] = bfhi(w.y) * 0.125f;
                            q[c8 * 8 + 4] = bflo(w.z) * 0.125f; q[c8 * 8 + 5] = bfhi(w.z) * 0.125f; q[c8 * 8 + 6] = bflo(w.w) * 0.125f; q[c8 * 8 + 7] = bfhi(w.w) * 0.125f; } }
#pragma unroll
                    for (int d = 0; d < 32; ++d) acc[d] = 0.f;
                    float mrun = sw_sinks[l * 16 + hd], lsum = 1.0f;
                    for (int s = 1; s < 192; ++s) {
                        const bool valid = (s > r) && (s <= r + 128) && (kp0 + s >= 0);
                        float sc = 0.f;
#pragma unroll
                        for (int c4 = 0; c4 < 8; ++c4) { const f32x4 k4 = *(const LAS f32x4*)(Kl + s * 64 + dh * 32 + c4 * 4); sc += q[c4 * 4 + 0] * k4.x + q[c4 * 4 + 1] * k4.y + q[c4 * 4 + 2] * k4.z + q[c4 * 4 + 3] * k4.w; }
                        sc += __shfl_xor(sc, 1);
                        if (valid && sc > mrun) { const float corr = __expf(mrun - sc); lsum *= corr;
#pragma unroll
                            for (int d = 0; d < 32; ++d) acc[d] *= corr;
                            mrun = sc; }
                        const float p = valid ? __expf(sc - mrun) : 0.f;
                        lsum += p;
#pragma unroll
                        for (int c4 = 0; c4 < 8; ++c4) { const f32x4 v4 = *(const LAS f32x4*)(Vl + s * 64 + dh * 32 + c4 * 4); acc[c4 * 4 + 0] += p * v4.x; acc[c4 * 4 + 1] += p * v4.y; acc[c4 * 4 + 2] += p * v4.z; acc[c4 * 4 + 3] += p * v4.w; }
                    }
                    const float inv = 1.0f / lsum; float ss = 0.f;
                    bf16* op = mixed + (size_t)(b * SEQ + qp0 + r) * DM + 512 + hd * 64 + dh * 32;
#pragma unroll
                    for (int c8 = 0; c8 < 4; ++c8) { unsigned w[4];
#pragma unroll
                        for (int j = 0; j < 4; ++j) { const float o0 = acc[c8 * 8 + 2 * j] * inv, o1 = acc[c8 * 8 + 2 * j + 1] * inv; ss += o0 * o0 + o1 * o1; w[j] = pk2(o0, o1); }
                        *(u32x4*)(op + c8 * 8) = (u32x4){w[0], w[1], w[2], w[3]}; }
                    ss += __shfl_xor(ss, 1);
                    if (dh == 0) ssq[r * 16 + hd] = ss;
                }
                __syncthreads();
                for (int pi = 0; pi < 4; ++pi) {
                    const int combo = pi * 8 + wave, hd = combo >> 1, r = (combo & 1) * 32 + (lane >> 1);
                    float tot = 0.f;
#pragma unroll
                    for (int j = 0; j < 16; ++j) tot += ssq[r * 16 + j];
                    const float rr = 1.0f / sqrtf(tot * (1.0f / 1024.0f) + RMS_EPS);
                    const float* gp = mix_gain + (size_t)l * DM + 512 + hd * 64 + dh * 32;
                    bf16* op = mixed + (size_t)(b * SEQ + qp0 + r) * DM + 512 + hd * 64 + dh * 32;
#pragma unroll
                    for (int c8 = 0; c8 < 4; ++c8) { const u32x4 o = *(const u32x4*)(op + c8 * 8); const f32x4 g0 = *(const f32x4*)(gp + c8 * 8), g1 = *(const f32x4*)(gp + c8 * 8 + 4);
                        u32x4 w; w.x = pk2(bflo(o.x) * rr * g0.x, bfhi(o.x) * rr * g0.y); w.y = pk2(bflo(o.y) * rr * g0.z, bfhi(o.y) * rr * g0.w);
                        w.z = pk2(bflo(o.z) * rr * g1.x, bfhi(o.z) * rr * g1.y); w.w = pk2(bflo(o.w) * rr * g1.z, bfhi(o.w) * rr * g1.w);
                        *(u32x4*)(op + c8 * 8) = w; }
                }
                __syncthreads();
            }
            }
            if (BSEL & 4) { PHASE_TID PHASE_PTRS
            for (int unit = bx; unit < 128; unit += G) {
                const int row0 = unit * 128;
                LAS float* vn = (LAS float*)lds;
                LAS float* wT = (LAS float*)(lds + 65536);
                LAS f32x2* stats = (LAS f32x2*)(lds + 133120);
                __syncthreads();
#pragma unroll 1
                for (int i = 0; i < 16; ++i) { const int s = wave * 16 + i;
                    const u32x4 w = *(const u32x4*)(proj + (size_t)(row0 + s) * DIN + C_SV + lane * 8);
                    float g[8] = {geluf_(bflo(w.x)), geluf_(bfhi(w.x)), geluf_(bflo(w.y)), geluf_(bfhi(w.y)), geluf_(bflo(w.z)), geluf_(bfhi(w.z)), geluf_(bflo(w.w)), geluf_(bfhi(w.w))};
                    float sm = 0.f;
#pragma unroll
                    for (int j = 0; j < 8; ++j) sm += g[j];
                    const float mean = wave_sum(sm) * (1.0f / 512.0f); float s2 = 0.f;
#pragma unroll
                    for (int j = 0; j < 8; ++j) { const float d = g[j] - mean; s2 += d * d; }
                    const float rstd = 1.0f / sqrtf(wave_sum(s2) * (1.0f / 512.0f) + LN_EPS);
                    if (lane == 0) stats[s] = (f32x2){mean, rstd};
                }
                float ssr[4] = {0.f, 0.f, 0.f, 0.f};
                const int tq = tid >> 4, cq = tid & 15, t0 = 4 * tq, c0 = 8 * cq;
#pragma unroll 1
                for (int g = 0; g < 4; ++g) {
                    __syncthreads();
#pragma unroll 1
                    for (int i = 0; i < 4; ++i) { const int idx = tid + NTHR * i, s = idx >> 4, cg = idx & 15;
                        const u32x4 w = *(const u32x4*)(proj + (size_t)(row0 + s) * DIN + C_SV + g * 128 + cg * 8);
                        const f32x2 st = stats[s]; const float* lg = sg_ln_g + (size_t)l * 512 + g * 128 + cg * 8; const float* lbp = sg_ln_b + (size_t)l * 512 + g * 128 + cg * 8;
                        const float x8[8] = {bflo(w.x), bfhi(w.x), bflo(w.y), bfhi(w.y), bflo(w.z), bfhi(w.z), bflo(w.w), bfhi(w.w)};
#pragma unroll
                        for (int j = 0; j < 8; ++j) vn[s * 128 + cg * 8 + j] = (geluf_(x8[j]) - st.x) * st.y * lg[j] + lbp[j];
                    }
                    { const float* wsrc = sg_w_s + ((size_t)l * 4 + g) * 128 * 128;
#pragma unroll
                        for (int i = 0; i < 8; ++i) { const int idx = tid + NTHR * i, s4 = (idx >> 7) * 4, t = idx & 127;
                            const f32x4 w4 = *(const f32x4*)(wsrc + t * 128 + s4);
#pragma unroll
                            for (int j = 0; j < 4; ++j) wT[(s4 + j) * 132 + t] = (s4 + j <= t) ? w4[j] : 0.f; } }
                    __syncthreads();
                    float acc[4][8];
#pragma unroll
                    for (int i = 0; i < 4; ++i)
#pragma unroll
                        for (int j = 0; j < 8; ++j) acc[i][j] = 0.f;
                    for (int s = 0; s <= t0 + 3; ++s) {
                        const f32x4 w4 = *(const LAS f32x4*)(wT + s * 132 + t0); const f32x4 va = *(const LAS f32x4*)(vn + s * 128 + c0), vb2 = *(const LAS f32x4*)(vn + s * 128 + c0 + 4);
                        const float vf[8] = {va.x, va.y, va.z, va.w, vb2.x, vb2.y, vb2.z, vb2.w};
#pragma unroll
                        for (int i = 0; i < 4; ++i)
#pragma unroll
                            for (int j = 0; j < 8; ++j) acc[i][j] += w4[i] * vf[j];
                    }
#pragma unroll 1
                    for (int i = 0; i < 4; ++i) { const float bs = sg_b_s[((size_t)l * 4 + g) * 128 + t0 + i];
                        const u32x4 w = *(const u32x4*)(proj + (size_t)(row0 + t0 + i) * DIN + C_SU + g * 128 + c0);
                        const float u8[8] = {bflo(w.x), bfhi(w.x), bflo(w.y), bfhi(w.y), bflo(w.z), bfhi(w.z), bflo(w.w), bfhi(w.w)};
                        float o8[8];
#pragma unroll
                        for (int j = 0; j < 8; ++j) { o8[j] = geluf_(u8[j]) * (acc[i][j] + bs); ssr[i] += o8[j] * o8[j]; }
                        *(u32x4*)(mixed + (size_t)(row0 + t0 + i) * DM + 1536 + g * 128 + c0) = (u32x4){pk2(o8[0], o8[1]), pk2(o8[2], o8[3]), pk2(o8[4], o8[5]), pk2(o8[6], o8[7])}; }
                }
                __syncthreads();
#pragma unroll
                for (int i = 0; i < 4; ++i) { float ss = ssr[i];
                    ss += __shfl_xor(ss, 1); ss += __shfl_xor(ss, 2); ss += __shfl_xor(ss, 4); ss += __shfl_xor(ss, 8);
                    const float rr = 1.0f / sqrtf(ss * (1.0f / 512.0f) + RMS_EPS);
#pragma unroll
                    for (int g = 0; g < 4; ++g) { const float* gp = mix_gain + (size_t)l * DM + 1536 + g * 128 + c0; bf16* op = mixed + (size_t)(row0 + t0 + i) * DM + 1536 + g * 128 + c0;
                        const u32x4 o = *(const u32x4*)op; const f32x4 g0 = *(const f32x4*)gp, g1 = *(const f32x4*)(gp + 4);
                        u32x4 w; w.x = pk2(bflo(o.x) * rr * g0.x, bfhi(o.x) * rr * g0.y); w.y = pk2(bflo(o.y) * rr * g0.z, bfhi(o.y) * rr * g0.w);
                        w.z = pk2(bflo(o.z) * rr * g1.x, bfhi(o.z) * rr * g1.y); w.w = pk2(bflo(o.w) * rr * g1.z, bfhi(o.w) * rr * g1.w);
                        *(u32x4*)op = w; }
                }
                __syncthreads();
            }
            }
        }
        SEAM(pb + 1);

        if (EN(3) && IN(pb + 2)) { PHASE_TID PHASE_PTRS
            for (int gi = bx * NTHR + tid; gi < 16 * 8192; gi += G * NTHR) {
                const int bh = gi >> 13, rem = gi & 8191, k = rem >> 6;
                f32x2 carry = (f32x2){0.f, 0.f};
                for (int c = 0; c < 32; ++c) {
                    f32x2* p = (f32x2*)(stateG + (size_t)(bh * 32 + c) * 16384) + rem;
                    const f32x2 tmp = *p; *p = carry; const float d = dendG[(size_t)(bh * 32 + c) * 128 + k]; carry = carry * d + tmp;
                }
            }
        }
        SEAM(pb + 2);

        if (EN(4) && IN(pb + 3)) { PHASE_TID PHASE_PTRS
            for (int unit = bx; unit < 512; unit += G) {
                const int bh = unit >> 5, c = unit & 31, b = bh >> 2, h = bh & 3, row0 = b * SEQ + c * 128;
                LAS float* bT = (LAS float*)lds;
                LAS bf16* qT = (LAS bf16*)(lds + 67584);
                LAS bf16* kT = (LAS bf16*)(lds + 100352);
                LAS float* segtot = (LAS float*)(lds + 133120);
                LAS float* lbs = (LAS float*)(lds + 133120 + 2048);
                __syncthreads();
                if (tid < 128) { float lb = 0.f; if (l == 1) { const float a0 = lb_logits[h * 128 + tid], a1 = lb_logits[512 + h * 128 + tid]; lb = 1.0f / (1.0f + expf(a0 - a1)); } lbs[tid] = lb; }
                __syncthreads();
#pragma unroll
                for (int i = 0; i < 4; ++i) {
                    const int idx = tid + NTHR * i, t = idx >> 4, kg = idx & 15;
                    const bf16* rowp = proj + (size_t)(row0 + t) * DIN + h * 128 + kg * 8;
                    const u32x4 z8 = *(const u32x4*)(rowp + C_HF); const u32x4 q8 = *(const u32x4*)(rowp + C_HQ);
                    const unsigned zw[4] = {z8.x, z8.y, z8.z, z8.w}; const unsigned qw[4] = {q8.x, q8.y, q8.z, q8.w};
#pragma unroll
                    for (int j = 0; j < 4; ++j)
#pragma unroll
                        for (int q = 0; q < 2; ++q) {
                            const float z = q ? bfhi(zw[j]) : bflo(zw[j]); const float qv = q ? bfhi(qw[j]) : bflo(qw[j]); const int k = kg * 8 + j * 2 + q; const float lb = lbs[k];
                            const float ls = fminf(z, 0.f) - log1pf(expf(-fabsf(z)));
                            const float lf = (lb == 0.f) ? ls : logf(lb + (1.f - lb) * expf(ls));
                            bT[k * 132 + t] = lf * 1.4426950408889634f;
                            kT[k * 128 + t] = (bf16)f2bf((1.f - lb) / (1.f + expf(z)));
                            qT[k * 128 + t] = (bf16)f2bf(siluf_(qv));
                        }
                }
                __syncthreads();
                { const int k = tid & 127, seg = tid >> 7; float run = 0.f;
                    for (int tt = 0; tt < 32; ++tt) { const int t = seg * 32 + tt; run += bT[k * 132 + t]; bT[k * 132 + t] = run; }
                    segtot[seg * 128 + k] = run;
                    __syncthreads();
                    float off = 0.f;
#pragma unroll
                    for (int s = 0; s < 4; ++s) { const float v = segtot[s * 128 + k]; if (s < seg) off += v; }
                    if (seg > 0) for (int tt = 0; tt < 32; ++tt) { const int t = seg * 32 + tt; bT[k * 132 + t] += off; }
                }
                __syncthreads();
                const int tq = tid >> 4, sq = tid & 15, t0 = 4 * tq, s0 = 8 * sq;
                float sc[4][8];
#pragma unroll
                for (int i = 0; i < 4; ++i)
#pragma unroll
                    for (int j = 0; j < 8; ++j) sc[i][j] = 0.f;
                if (s0 <= t0 + 3) {
                    for (int k = 0; k < 128; ++k) {
                        const f32x4 bt = *(const LAS f32x4*)(bT + k * 132 + t0); const f32x4 bs0 = *(const LAS f32x4*)(bT + k * 132 + s0), bs1 = *(const LAS f32x4*)(bT + k * 132 + s0 + 4);
                        const u32x2 qw = *(const LAS u32x2*)(qT + k * 128 + t0); const u32x4 kw = *(const LAS u32x4*)(kT + k * 128 + s0);
                        const float qf[4] = {bflo(qw.x), bfhi(qw.x), bflo(qw.y), bfhi(qw.y)};
                        const float kf[8] = {bflo(kw.x), bfhi(kw.x), bflo(kw.y), bfhi(kw.y), bflo(kw.z), bfhi(kw.z), bflo(kw.w), bfhi(kw.w)};
                        const float bsf[8] = {bs0.x, bs0.y, bs0.z, bs0.w, bs1.x, bs1.y, bs1.z, bs1.w};
#pragma unroll
                        for (int i = 0; i < 4; ++i)
#pragma unroll
                            for (int j = 0; j < 8; ++j) sc[i][j] += qf[i] * kf[j] * __builtin_amdgcn_exp2f(fminf(bt[i] - bsf[j], 0.f));
                    }
                }
#pragma unroll
                for (int i = 0; i < 4; ++i)
#pragma unroll
                    for (int j = 0; j < 8; ++j) if (s0 + j > t0 + i) sc[i][j] = 0.f;
                __syncthreads();
                for (int i = 0; i < 32; ++i) { const int idx = tid + NTHR * i, k = idx >> 7, t = idx & 127; qT[idx] = (bf16)f2bf(bf2f(qT[idx]) * __builtin_amdgcn_exp2f(bT[k * 132 + t])); }
                __syncthreads();
#pragma unroll
                for (int j = 0; j < 8; ++j) *(LAS f32x4*)(bT + (s0 + j) * 132 + t0) = (f32x4){sc[0][j], sc[1][j], sc[2][j], sc[3][j]};
                LAS bf16* vb = kT;
#pragma unroll
                for (int i = 0; i < 4; ++i) { const int idx = tid + NTHR * i, t = idx >> 4, kg = idx & 15;
                    *(LAS u32x4*)(vb + t * 128 + kg * 8) = *(const u32x4*)(proj + (size_t)(row0 + t) * DIN + C_HI + h * 128 + kg * 8); }
                __syncthreads();
                { const int vq = sq, v0 = 8 * vq;
                    float acc[4][8];
#pragma unroll
                    for (int i = 0; i < 4; ++i)
#pragma unroll
                        for (int j = 0; j < 8; ++j) acc[i][j] = 0.f;
                    const float* stp = stateG + (size_t)(bh * 32 + c) * 16384 + v0;
                    for (int k = 0; k < 128; ++k) {
                        const u32x2 qw = *(const LAS u32x2*)(qT + k * 128 + t0); const f32x4 sa = *(const f32x4*)(stp + k * 128), sb = *(const f32x4*)(stp + k * 128 + 4);
                        const float qf[4] = {bflo(qw.x), bfhi(qw.x), bflo(qw.y), bfhi(qw.y)}; const float sf[8] = {sa.x, sa.y, sa.z, sa.w, sb.x, sb.y, sb.z, sb.w};
#pragma unroll
                        for (int i = 0; i < 4; ++i)
#pragma unroll
                            for (int j = 0; j < 8; ++j) acc[i][j] += qf[i] * sf[j];
                    }
                    for (int s = 0; s <= t0 + 3; ++s) {
                        const f32x4 s4 = *(const LAS f32x4*)(bT + s * 132 + t0); const u32x4 vw = *(const LAS u32x4*)(vb + s * 128 + v0);
                        const float vf[8] = {bflo(vw.x), bfhi(vw.x), bflo(vw.y), bfhi(vw.y), bflo(vw.z), bfhi(vw.z), bflo(vw.w), bfhi(vw.w)};
#pragma unroll
                        for (int i = 0; i < 4; ++i)
#pragma unroll
                            for (int j = 0; j < 8; ++j) acc[i][j] += s4[i] * vf[j];
                    }
                    const float* gp = mix_gain + (size_t)l * DM + h * 128 + v0;
#pragma unroll
                    for (int i = 0; i < 4; ++i) { float ss = 0.f;
#pragma unroll
                        for (int j = 0; j < 8; ++j) ss += acc[i][j] * acc[i][j];
                        ss += __shfl_xor(ss, 1); ss += __shfl_xor(ss, 2); ss += __shfl_xor(ss, 4); ss += __shfl_xor(ss, 8);
                        const float rr = 1.0f / sqrtf(ss * (1.0f / 128.0f) + RMS_EPS);
                        const u32x4 gw = *(const u32x4*)(proj + (size_t)(row0 + t0 + i) * DIN + C_HG + h * 128 + v0);
                        const float gf[8] = {bflo(gw.x), bfhi(gw.x), bflo(gw.y), bfhi(gw.y), bflo(gw.z), bfhi(gw.z), bflo(gw.w), bfhi(gw.w)};
                        unsigned w[4];
#pragma unroll
                        for (int j = 0; j < 4; ++j) w[j] = pk2(acc[i][2 * j] * rr * gp[2 * j] * siluf_(gf[2 * j]), acc[i][2 * j + 1] * rr * gp[2 * j + 1] * siluf_(gf[2 * j + 1]));
                        *(u32x4*)(mixed + (size_t)(row0 + t0 + i) * DM + h * 128 + v0) = (u32x4){w[0], w[1], w[2], w[3]}; }
                }
                __syncthreads();
            }
        }
        SEAM(pb + 3);

        if (EN(5) && IN(pb + 4)) { PHASE_PTRS
            pg8::PlainSched S; S.init(NTOK, DM, DM, G, bx, WLp + WL_OUT);
            pg8::EpiResF32 E{Hf, DM, ALPHA};
            pg8::gemm_phase<pg8::EpiResF32, pg8::PlainSched, true>(lds, (const char*)mixed, DM, S, E);
        }
        SEAM(pb + 4);

        if (EN(6) && IN(pb + 5)) { PHASE_TID PHASE_PTRS
            LAS float* xs = (LAS float*)lds;
            LAS int* selr = (LAS int*)(lds + 131072);
            LAS float* gatel = (LAS float*)(lds + 131072 + 4096);
            const float* rw = router_w + (size_t)l * DM * NE;
            for (int bi = bx; bi < NTOK / 16; bi += G) {
                const int tok0 = bi * 16;
                __syncthreads();
#pragma unroll
                for (int jt = 0; jt < 2; ++jt) { const int tl = wave * 2 + jt, tok = tok0 + tl;
                    f32x4 v[8];
#pragma unroll
                    for (int j = 0; j < 8; ++j) v[j] = ((const f32x4*)(Hf + (size_t)tok * DM))[j * 64 + lane];
                    ln_regs(v, ln1_g + (size_t)l * DM, ln1_b + (size_t)l * DM, lane);
                    store_row_f32(Hf + (size_t)tok * DM, v, lane); store_row_bf16(Hb + (size_t)tok * DM, v, lane);
#pragma unroll
                    for (int j = 0; j < 8; ++j) ((LAS f32x4*)(xs + tl * DM))[j * 64 + lane] = v[j];
                }
                __syncthreads();
                float acc[16];
#pragma unroll
                for (int t = 0; t < 16; ++t) acc[t] = 0.f;
                for (int k4 = 0; k4 < 64; ++k4) { const int k = wave * 256 + k4 * 4;
                    const float w0 = rw[(size_t)(k + 0) * NE + lane], w1 = rw[(size_t)(k + 1) * NE + lane], w2 = rw[(size_t)(k + 2) * NE + lane], w3 = rw[(size_t)(k + 3) * NE + lane];
#pragma unroll
                    for (int t = 0; t < 16; ++t) { const f32x4 x4 = *(const LAS f32x4*)(xs + t * DM + k); acc[t] += x4.x * w0 + x4.y * w1 + x4.z * w2 + x4.w * w3; }
                }
                __syncthreads();
#pragma unroll
                for (int t = 0; t < 16; ++t) xs[(wave * 16 + t) * 64 + lane] = acc[t];
                __syncthreads();
#pragma unroll
                for (int jt = 0; jt < 2; ++jt) { const int tl = wave * 2 + jt;
                    float logit = 0.f;
#pragma unroll
                    for (int w = 0; w < 8; ++w) logit += xs[(w * 16 + tl) * 64 + lane];
                    const float score = 1.0f / (1.0f + expf(-logit));
                    const float sel = score + router_b[l * NE + lane];
                    float m1 = sel; m1 = fmaxf(m1, __shfl_xor(m1, 1)); m1 = fmaxf(m1, __shfl_xor(m1, 2)); m1 = fmaxf(m1, __shfl_xor(m1, 4));
                    const unsigned long long bm = __ballot(sel == m1); const int grp = lane >> 3; const unsigned gbits = (unsigned)(bm >> (grp * 8)) & 0xffu; const int first = __builtin_ctz(gbits);
                    float s2 = ((lane & 7) == first) ? -INFINITY : sel; s2 = fmaxf(s2, __shfl_xor(s2, 1)); s2 = fmaxf(s2, __shfl_xor(s2, 2)); s2 = fmaxf(s2, __shfl_xor(s2, 4));
                    const float gs = m1 + s2;
                    int grank = 0;
#pragma unroll
                    for (int j = 0; j < 8; ++j) { const float gj = __shfl(gs, j * 8); grank += (gj > gs || (gj == gs && j < grp)) ? 1 : 0; }
                    const bool chosen = grank < 4;
                    const float msel = chosen ? sel : -INFINITY;
                    int rk = 0;
#pragma unroll 8
                    for (int j = 0; j < 64; ++j) { const float vj = __shfl(msel, j); rk += (vj > msel || (vj == msel && j < lane)) ? 1 : 0; }
                    const bool selected = chosen && rk < 8;
                    const float ssum = wave_sum(selected ? score : 0.f);
                    selr[tl * 64 + lane] = selected ? rk : -1; gatel[tl * 64 + lane] = score / ssum * ROUTED_SCALE;
                }
                __syncthreads();
                if (wave == 0) {
                    int cl = 0; int lp[16];
#pragma unroll
                    for (int t = 0; t < 16; ++t) { lp[t] = cl; cl += (selr[t * 64 + lane] >= 0) ? 1 : 0; }
                    int base = 0; if (cl > 0) base = (int)__hip_atomic_fetch_add(cntG + lane, (unsigned)cl, RLX_AGENT);
#pragma unroll
                    for (int t = 0; t < 16; ++t) { const int rk = selr[t * 64 + lane];
                        if (rk >= 0) { const int pos = base + lp[t]; list[lane * NTOK + pos] = tok0 + t; wlist[lane * NTOK + pos] = gatel[t * 64 + lane]; slot[(size_t)(tok0 + t) * 8 + rk] = (lane << 16) | pos; } }
                }
            }
        }
        SEAM(pb + 5);

        LAS int* const cnts = (LAS int*)(lds + TAB_OFF); LAS int* const tstart = cnts + 64; LAS int* const tile_e = cnts + 192;
        int ntiles = 0;
        if ((EN(7) && IN(pb + 6)) || (EN(8) && IN(pb + 7)) || (EN(9) && IN(pb + 8))) { PHASE_TID PHASE_PTRS
            __syncthreads();
            if (tid < 64) cnts[tid] = (int)__hip_atomic_load(cntG + tid, RLX_AGENT);
            __syncthreads();
            if (tid == 0) { int s = 0; for (int e = 0; e < 64; ++e) { tstart[e] = s; s += (cnts[e] + 255) >> 8; } tstart[64] = s; }
            __syncthreads();
            if (tid < 64) for (int t = tstart[tid]; t < tstart[tid + 1]; ++t) tile_e[t] = tid;
            __syncthreads();
            ntiles = __builtin_amdgcn_readfirstlane(tstart[64]); if (ntiles > MAXTILES) ntiles = MAXTILES;
        }

        if (EN(7) && IN(pb + 6)) { PHASE_PTRS
            { pg8::MoeSched<true> S{cnts, tstart, tile_e, ntiles, 4, G, vcu, DM, list, WLp + WL_GU, W_GU_B};
              pg8::EpiSwiGLU E{Hs};
              pg8::gemm_phase<pg8::EpiSwiGLU, pg8::MoeSched<true>, true>(lds, (const char*)Hb, DM, S, E); }
            { pg8::PlainSched S; S.init(NTOK, 1024, DM, G, bx, WLp + WL_GU + 64 * W_GU_B);
              pg8::EpiSwiGLU E{Hs + (size_t)SH_ROW0 * DE};
              pg8::gemm_phase<pg8::EpiSwiGLU, pg8::PlainSched, true>(lds, (const char*)Hb, DM, S, E); }
        }
        SEAM(pb + 6);

        if (EN(8) && IN(pb + 7)) { PHASE_PTRS
#if !defined(HSEL) || HSEL == 1
            { pg8::MoeSched<false> S{cnts, tstart, tile_e, ntiles, 8, G, vcu, DE, nullptr, WLp + WL_D, W_D_B};
              pg8::EpiDownY E{Yb, wlist};
              pg8::gemm_phase<pg8::EpiDownY, pg8::MoeSched<false>, true>(lds, (const char*)Hs, DE, S, E); }
#endif
#if !defined(HSEL) || HSEL == 2
            { pg8::PlainSched S; S.init(NTOK, DM, DE, G, bx, WLp + WL_D + 64 * W_D_B);
              pg8::EpiResF32 E{Hf, DM, ALPHA};
              pg8::gemm_phase<pg8::EpiResF32, pg8::PlainSched, true>(lds, (const char*)(Hs + (size_t)SH_ROW0 * DE), DE, S, E); }
#endif
        }
        SEAM(pb + 7);

        if (EN(9) && IN(pb + 8)) { PHASE_TID PHASE_PTRS
            const int gw = vcu * NWAVES + wave, NGW = G * NWAVES;
            for (int tok = gw; tok < NTOK; tok += NGW) {
                f32x4 v[8];
#pragma unroll
                for (int j = 0; j < 8; ++j) v[j] = ((const f32x4*)(Hf + (size_t)tok * DM))[j * 64 + lane];
                const int myslot = slot[(size_t)tok * 8 + (lane & 7)];
#pragma unroll
                for (int k = 0; k < 8; ++k) { const int sl = __shfl(myslot, k); const int e = sl >> 16, pos = sl & 0xffff; const size_t row = (size_t)tstart[e] * 256 + pos;
                    const u32x2* yp = (const u32x2*)(Yb + row * DM);
#pragma unroll
                    for (int j = 0; j < 8; ++j) { const u32x2 w = yp[j * 64 + lane]; v[j].x += bflo(w.x); v[j].y += bfhi(w.x); v[j].z += bflo(w.y); v[j].w += bfhi(w.y); } }
                ln_regs(v, ln2_g + (size_t)l * DM, ln2_b + (size_t)l * DM, lane);
                if (l == 0) { store_row_f32(Hf + (size_t)tok * DM, v, lane); store_row_bf16(Hb + (size_t)tok * DM, v, lane); }
                else store_row_f32(OUTP + (size_t)tok * DM, v, lane);
            }
        }
        SEAM(pb + 8);
    }
#undef IN
#undef SEAM
}

constexpr int NPHASES = 19;
#ifndef ONE_LAUNCH
#define ONE_LAUNCH 1
#endif

extern "C" void kernel_launch(void* const* d_in, const int* in_sizes, int n_in, void* d_out, int out_size, void* d_ws, size_t ws_size, hipStream_t stream) {
    static int grid = 0;
    if (grid == 0) {
        if (n_in != 25 || out_size != NTOK * DM || ws_size < WS_END) { fprintf(stderr, "kernel_launch: unexpected shapes: n_in %d out %d ws %zu (need %zu)\n", n_in, out_size, ws_size, (size_t)WS_END); grid = -1; return; }
        int dev = 0, cus = 0, per_cu = 0;
        if (hipGetDevice(&dev) != hipSuccess || hipDeviceGetAttribute(&cus, hipDeviceAttributeMultiprocessorCount, dev) != hipSuccess) { grid = -1; return; }
        if (hipFuncSetAttribute((const void*)fwd_kernel, hipFuncAttributeMaxDynamicSharedMemorySize, LDS_BYTES) != hipSuccess) { fprintf(stderr, "kernel_launch: hipFuncSetAttribute failed\n"); grid = -1; return; }
        if (hipOccupancyMaxActiveBlocksPerMultiprocessor(&per_cu, (const void*)fwd_kernel, NTHR, LDS_BYTES) != hipSuccess || per_cu < 1) fprintf(stderr, "kernel_launch: occupancy query reports %d\n", per_cu);
        (void)hipGetLastError();
        grid = cus;
    }
    if (grid < 0) return;
    if (hipMemsetAsync((char*)d_ws + WS_CTL, 0, CTL_ZERO_BYTES, stream) != hipSuccess) return;
    Args a{};
    for (int i = 0; i < 25; ++i) a.in[i] = (const float*)d_in[i];
    a.out = (float*)d_out; a.ws = (unsigned char*)d_ws; a.pad = 0;
#if ONE_LAUNCH
    a.ph_lo = 0; a.ph_hi = NPHASES; a.use_bar = 1;
    hipLaunchKernelGGL(fwd_kernel, dim3(grid), dim3(NTHR), LDS_BYTES, stream, a);
#else
    for (int p = 0; p < NPHASES; ++p) { a.ph_lo = p; a.ph_hi = p + 1; a.use_bar = 0; hipLaunchKernelGGL(fwd_kernel, dim3(grid), dim3(NTHR), LDS_BYTES, stream, a); }
#endif
}
```

```cpp
#include <hip/hip_runtime.h>
#include <cstdio>
#include <cstdint>

#define GAS __attribute__((address_space(1)))
#define LAS __attribute__((address_space(3)))
typedef unsigned short bf16;
typedef unsigned short bf16_t;
typedef short bf16x8 __attribute__((ext_vector_type(8)));
typedef float f32x4 __attribute__((ext_vector_type(4)));
typedef float f32x2 __attribute__((ext_vector_type(2)));
typedef unsigned u32x4 __attribute__((ext_vector_type(4)));
typedef unsigned u32x2 __attribute__((ext_vector_type(2)));

constexpr int NTOK = 16384, DM = 2048, DIN = 4352, SEQ = 4096, NBATCH = 4;
constexpr int NE = 64, TOPK = 8, DE = 512;
constexpr float ALPHA = 1.4142135623730951f, LN_EPS = 1e-5f, RMS_EPS = 1e-6f, ROUTED_SCALE = 2.5f;
constexpr int C_HQ = 0, C_HF = 512, C_HI = 1024, C_HG = 1536, C_AQ = 2048, C_AK = 3072, C_AV = 3200, C_SU = 3328, C_SV = 3840;
constexpr int MAXTILES = 576;
constexpr int SH_ROW0 = MAXTILES * 256;
constexpr int HS_ROWS = SH_ROW0 + NTOK;

constexpr size_t MiB = 1u << 20;
constexpr size_t WS_CTL = 0, CTL_ZERO_BYTES = 1 * MiB;
constexpr size_t WS_LIST = 1 * MiB;
constexpr size_t WS_WLIST = 5 * MiB;
constexpr size_t WS_SLOT = 9 * MiB;
constexpr size_t WS_DEND = 10 * MiB;
constexpr size_t WS_STATE = 16 * MiB;
constexpr size_t WS_HF = 64 * MiB;
constexpr size_t WS_HB = 192 * MiB;
constexpr size_t WS_PROJ = 256 * MiB;
constexpr size_t WS_MIXED = 392 * MiB;
constexpr size_t WS_HS = 456 * MiB;
constexpr size_t WS_Y = 616 * MiB;
constexpr size_t WS_W = 1192 * MiB;
constexpr size_t W_IN_B = (size_t)DIN * DM * 2, W_OUT_B = (size_t)DM * DM * 2, W_GU_B = (size_t)1024 * DM * 2, W_D_B = (size_t)DM * DE * 2;
constexpr size_t WL_IN = 0, WL_OUT = W_IN_B, WL_GU = WL_OUT + W_OUT_B, WL_D = WL_GU + 65 * W_GU_B, WL_BYTES = WL_D + 65 * W_D_B;
constexpr size_t WS_END = WS_W + 2 * WL_BYTES;
static_assert(WS_HS + (size_t)HS_ROWS * 512 * 2 <= WS_Y && WS_Y + (size_t)MAXTILES * 256 * DM * 2 <= WS_W && WS_END <= 2048 * MiB, "d_ws map");
constexpr int CW_CNT = 64;
constexpr int CW_BAR = 4096;

constexpr int LDS_BYTES = 147456;
constexpr int MISC_OFF = LDS_BYTES - 256;
constexpr int TAB_OFF = 131072;
constexpr int NWAVES = 8, NTHR = 512;

#define LDS_WAIT() asm volatile("s_waitcnt lgkmcnt(0)" ::: "memory")
#define VM_WAIT() asm volatile("s_waitcnt vmcnt(0)" ::: "memory")
#define RLX_AGENT __ATOMIC_RELAXED, __HIP_MEMORY_SCOPE_AGENT

__device__ __forceinline__ unsigned f2bf(float f) { unsigned u = __builtin_bit_cast(unsigned, f); return (u + 0x7fffu + ((u >> 16) & 1u)) >> 16; }
__device__ __forceinline__ unsigned pk2(float lo, float hi) { return f2bf(lo) | (f2bf(hi) << 16); }
__device__ __forceinline__ float bflo(unsigned w) { return __uint_as_float(w << 16); }
__device__ __forceinline__ float bfhi(unsigned w) { return __uint_as_float(w & 0xffff0000u); }
__device__ __forceinline__ float bf2f(bf16 v) { return __uint_as_float((unsigned)v << 16); }
__device__ __forceinline__ float wave_sum(float v) {
#pragma unroll
    for (int o = 1; o < 64; o <<= 1) v += __shfl_xor(v, o);
    return v;
}
__device__ __forceinline__ float sigmoidf_(float x) { return 1.0f / (1.0f + __expf(-x)); }
__device__ __forceinline__ float siluf_(float x) { return x / (1.0f + __expf(-x)); }
__device__ __forceinline__ float geluf_(float x) { return 0.5f * x * (1.0f + erff(x * 0.70710678118654752f)); }

namespace pg8 {
#define PG8_LAS __attribute__((address_space(3)))
constexpr int BM = 256, BK = 64, HALF = 128, HTB = HALF * BK * 2, STAGE_BYTES = 8 * HTB, NXCD = 8, WGM = 8;
__host__ __device__ __forceinline__ int lds_byte(int r, int c) { const int st = (r >> 4) * 2 + (c >> 5), rr = r & 15, cc = c & 31, ob = rr * 64 + cc * 2; return st * 1024 + (ob ^ (((ob >> 9) & 1) << 5)); }
__host__ __device__ __forceinline__ void stage_rc(int b, int& R, int& C) { const int st = b / 1024, sb = b % 1024, swz = sb ^ (((sb >> 9) & 1) << 5); R = (st >> 1) * 16 + swz / 64; C = (st & 1) * 32 + (swz % 64) / 2; }
__host__ __device__ __forceinline__ int perm32(int rho) { const int n = rho >> 4, i = rho & 15; return 8 * (i >> 2) + 4 * n + (i & 3); }

struct Unit { int pm, pn, e, p0, nv; };

__device__ __forceinline__ unsigned cvt_pk_bf16(float lo, float hi) { unsigned r; asm volatile("v_cvt_pk_bf16_f32 %0, %1, %2" : "=v"(r) : "v"(lo), "v"(hi)); return r; }

struct PlainSched {
    static constexpr bool GATHER = false;
    int nM, nN, nwg, G, c, K; const char* Bt;
    __device__ void init(int M, int N, int K_, int G_, int c_, const void* Bt_) { nM = M / BM; nN = N / BM; nwg = nM * nN; G = G_; c = c_; K = K_; Bt = (const char*)Bt_; }
    __device__ __forceinline__ bool next(int i, Unit& u) const {
        const long L = (long)i * G + c; if (L >= nwg) return false;
        int wgid = (int)L; { const int q = nwg / NXCD, r = nwg % NXCD, xcd = wgid % NXCD, off = wgid / NXCD; wgid = (xcd < r ? xcd * (q + 1) : r * (q + 1) + (xcd - r) * q) + off; }
        const int nig = WGM * nN, gid = wgid / nig, fm = gid * WGM, gsz = (nM - fm) < WGM ? (nM - fm) : WGM;
        u.pm = fm + ((wgid % nig) % gsz); u.pn = (wgid % nig) / gsz; u.e = 0; u.p0 = 0; u.nv = 256; return true;
    }
    __device__ __forceinline__ unsigned arow(const Unit& u, int r) const { return 0u; }
    __device__ __forceinline__ size_t aoff(const Unit& u) const { return (size_t)u.pm * BM * K * 2; }
    __device__ __forceinline__ const char* bbase(const Unit& u) const { return Bt + (size_t)u.pn * BM * K * 2; }
};
template <bool GATHER_> struct MoeSched {
    static constexpr bool GATHER = GATHER_;
    const PG8_LAS int* cnts; const PG8_LAS int* tstart; const PG8_LAS int* tile_e;
    int ntiles, npn, G, vcu, K; const int* list; const char* Bt; size_t estride;
    __device__ __forceinline__ bool next(int i, Unit& u) const {
        const int U = i * G + vcu; if (U >= ntiles * npn) return false;
        u.pm = U / npn; u.pn = U % npn; u.e = __builtin_amdgcn_readfirstlane(tile_e[u.pm]); u.p0 = (u.pm - __builtin_amdgcn_readfirstlane(tstart[u.e])) * BM; const int rem = __builtin_amdgcn_readfirstlane(cnts[u.e]) - u.p0; u.nv = rem < BM ? rem : BM; return true;
    }
    __device__ __forceinline__ unsigned arow(const Unit& u, int r) const { const int tok = (r < u.nv) ? list[u.e * NTOK + u.p0 + r] : 0; return (unsigned)tok * (unsigned)(K * 2); }
    __device__ __forceinline__ size_t aoff(const Unit& u) const { return (size_t)u.pm * BM * K * 2; }
    __device__ __forceinline__ const char* bbase(const Unit& u) const { return Bt + (size_t)u.e * estride + (size_t)u.pn * BM * K * 2; }
};

struct EpiBf16Bias {
    static constexpr bool PERM = true;
    bf16_t* O; int ldc; const float* bias;
    __device__ __forceinline__ void operator()(const f32x4 (&acc)[2][2][4][2], const Unit& u, int wr, int wc, int fr, int fq) const {
        const int row0 = u.pm * BM + wr * 64 + fr, col0 = u.pn * BM + wc * 32 + 8 * fq;
        f32x4 bv[2][2];
#pragma unroll
        for (int bj = 0; bj < 2; ++bj)
#pragma unroll
            for (int n = 0; n < 2; ++n) bv[bj][n] = *(const f32x4*)(bias + col0 + bj * HALF + 4 * n);
#pragma unroll
        for (int ai = 0; ai < 2; ++ai)
#pragma unroll
            for (int m = 0; m < 4; ++m) { bf16_t* rowp = O + (size_t)(row0 + ai * HALF + m * 16) * ldc + col0;
#pragma unroll
                for (int bj = 0; bj < 2; ++bj) { const f32x4 v0 = acc[ai][bj][m][0] + bv[bj][0], v1 = acc[ai][bj][m][1] + bv[bj][1];
                    u32x4 w; w.x = cvt_pk_bf16(v0[0], v0[1]); w.y = cvt_pk_bf16(v0[2], v0[3]); w.z = cvt_pk_bf16(v1[0], v1[1]); w.w = cvt_pk_bf16(v1[2], v1[3]);
                    *(u32x4*)(rowp + bj * HALF) = w; } }
    }
};
struct EpiResF32 {
    static constexpr bool PERM = false;
    float* C; int ldc; float alpha;
    __device__ __forceinline__ void operator()(const f32x4 (&acc)[2][2][4][2], const Unit& u, int wr, int wc, int fr, int fq) const {
        const int row0 = u.pm * BM + wr * 64 + fr, col0 = u.pn * BM + wc * 32 + 4 * fq;
#pragma unroll
        for (int ai = 0; ai < 2; ++ai)
#pragma unroll
            for (int m = 0; m < 4; ++m) { float* rowp = C + (size_t)(row0 + ai * HALF + m * 16) * ldc + col0;
#pragma unroll
                for (int bj = 0; bj < 2; ++bj)
#pragma unroll
                    for (int n = 0; n < 2; ++n) { f32x4* p = (f32x4*)(rowp + bj * HALF + n * 16); const f32x4 o = *p; *p = o * alpha + acc[ai][bj][m][n]; } }
    }
};
struct EpiSwiGLU {
    static constexpr bool PERM = true;
    bf16_t* O;
    __device__ __forceinline__ void operator()(const f32x4 (&acc)[2][2][4][2], const Unit& u, int wr, int wc, int fr, int fq) const {
        const int row0 = u.pm * BM + wr * 64 + fr, col0 = u.pn * HALF + wc * 32 + 8 * fq;
#pragma unroll
        for (int ai = 0; ai < 2; ++ai)
#pragma unroll
            for (int m = 0; m < 4; ++m) { bf16_t* rowp = O + (size_t)(row0 + ai * HALF + m * 16) * DE + col0;
                float o[8];
#pragma unroll
                for (int n = 0; n < 2; ++n)
#pragma unroll
                    for (int j = 0; j < 4; ++j) { const float g = acc[ai][0][m][n][j], up = acc[ai][1][m][n][j]; o[n * 4 + j] = g / (1.0f + __expf(-g)) * up; }
                u32x4 w; w.x = cvt_pk_bf16(o[0], o[1]); w.y = cvt_pk_bf16(o[2], o[3]); w.z = cvt_pk_bf16(o[4], o[5]); w.w = cvt_pk_bf16(o[6], o[7]);
                *(u32x4*)rowp = w; }
    }
};
struct EpiDownY {
    static constexpr bool PERM = true;
    bf16_t* Y; const float* wlist;
    __device__ __forceinline__ void operator()(const f32x4 (&acc)[2][2][4][2], const Unit& u, int wr, int wc, int fr, int fq) const {
        const int rl0 = wr * 64 + fr, col0 = u.pn * BM + wc * 32 + 8 * fq;
#pragma unroll
        for (int ai = 0; ai < 2; ++ai)
#pragma unroll
            for (int m = 0; m < 4; ++m) { const int rl = rl0 + ai * HALF + m * 16; const float w8 = (rl < u.nv) ? wlist[u.e * NTOK + u.p0 + rl] : 0.f;
                bf16_t* rowp = Y + (size_t)(u.pm * BM + rl) * DM + col0;
#pragma unroll
                for (int bj = 0; bj < 2; ++bj) { const f32x4 v0 = acc[ai][bj][m][0] * w8, v1 = acc[ai][bj][m][1] * w8;
                    u32x4 w; w.x = cvt_pk_bf16(v0[0], v0[1]); w.y = cvt_pk_bf16(v0[2], v0[3]); w.z = cvt_pk_bf16(v1[0], v1[1]); w.w = cvt_pk_bf16(v1[2], v1[3]);
                    *(u32x4*)(rowp + bj * HALF) = w; } }
    }
};

template <class Epi, class Sched, bool ALIGN_EPI>
__device__ __forceinline__ void gemm_phase(PG8_LAS unsigned char* lds, const char* Abase, const int K, const Sched& S, const Epi& E) {
    int tid_ = threadIdx.x; asm volatile("" : "+v"(tid_));
    const int tid = tid_, wid = __builtin_amdgcn_readfirstlane(tid >> 6), lane = tid & 63, wr = wid >> 2, wc = wid & 3, fr = lane & 15, fq = lane >> 4;
    const int nt = K / BK;
    int RA[2]; unsigned CA2[2], voffB[2];
#pragma unroll
    for (int i = 0; i < 2; ++i) { int R, C; stage_rc(tid * 16 + i * 8192, R, C); const int Rb = Epi::PERM ? ((R & ~31) + perm32(R & 31)) : R;
        RA[i] = R; CA2[i] = (unsigned)C * 2u; voffB[i] = (unsigned)(Rb * K + C) * 2u; }
    const size_t kstep = (size_t)(BK * 2);
    const size_t hstep = (size_t)HALF * K * 2;
    const unsigned ldsw = (unsigned)wid * 1024u;
    const int aoff = lds_byte(wr * 64 + fr, fq * 8), boff = lds_byte(wc * 32 + fr, fq * 8);
#define PG8_SA(b, h) (((b) * 2 + (h)) * HTB)
#define PG8_SB(b, h) ((4 + (b) * 2 + (h)) * HTB)
#define PG8_STAGE(bufoff, gbase, voff) do { _Pragma("unroll") for (int _i = 0; _i < 2; ++_i) \
        __builtin_amdgcn_global_load_lds((const unsigned*)((const char*)(gbase) + (voff)[_i]), (PG8_LAS unsigned*)(lds + (bufoff) + ldsw + _i * 8192), 16, 0, 0); } while (0)
#define PG8_LDA(dst, b, h) do { _Pragma("unroll") for (int m = 0; m < 4; ++m) _Pragma("unroll") for (int k = 0; k < 2; ++k) dst[m][k] = *(const PG8_LAS bf16x8*)(lds + PG8_SA(b, h) + aoff + m * 2048 + k * 1024); } while (0)
#define PG8_LDB(dst, b, h) do { _Pragma("unroll") for (int n = 0; n < 2; ++n) _Pragma("unroll") for (int k = 0; k < 2; ++k) dst[n][k] = *(const PG8_LAS bf16x8*)(lds + PG8_SB(b, h) + boff + n * 2048 + k * 1024); } while (0)
#define PG8_MMA(ai, bj, At, Bt) do { __builtin_amdgcn_s_setprio(1); _Pragma("unroll") for (int m = 0; m < 4; ++m) _Pragma("unroll") for (int n = 0; n < 2; ++n) _Pragma("unroll") for (int k = 0; k < 2; ++k) \
        acc[ai][bj][m][n] = __builtin_amdgcn_mfma_f32_16x16x32_bf16(Bt[n][k], At[m][k], acc[ai][bj][m][n], 0, 0, 0); __builtin_amdgcn_s_setprio(0); } while (0)
#define PG8_WAIT_V(n) asm volatile("s_waitcnt vmcnt(" #n ")" ::: "memory")
#define PG8_WAIT_L(n) asm volatile("s_waitcnt lgkmcnt(" #n ")" ::: "memory")
#define PG8_BAR __builtin_amdgcn_s_barrier()
#define PG8_SCHED __builtin_amdgcn_sched_barrier(0)
    Unit cur, nxt; int ui = 0;
    if (!S.next(0, cur)) return;
    f32x4 acc[2][2][4][2];
#pragma unroll
    for (int a = 0; a < 2; ++a)
#pragma unroll
        for (int b = 0; b < 2; ++b)
#pragma unroll
            for (int m = 0; m < 4; ++m)
#pragma unroll
                for (int n = 0; n < 2; ++n) acc[a][b][m][n] = (f32x4){0.f, 0.f, 0.f, 0.f};
    bf16x8 At[4][2], B0[2][2], B1[2][2];
    unsigned voffA[2], ca0[2], ca1[2], na0[2], na1[2];
#pragma unroll
    for (int i = 0; i < 2; ++i) { voffA[i] = (unsigned)(RA[i] * K) * 2u + CA2[i]; ca0[i] = ca1[i] = na0[i] = na1[i] = 0u; }
    const char* cA = Abase; const char* cB = S.bbase(cur);
    if constexpr (Sched::GATHER) {
#pragma unroll
        for (int i = 0; i < 2; ++i) { ca0[i] = S.arow(cur, RA[i]) + CA2[i]; ca1[i] = S.arow(cur, HALF + RA[i]) + CA2[i]; }
    } else cA = Abase + S.aoff(cur);
#define PG8_STAGE_A(bufoff, p, h, g0, g1) do { if constexpr (Sched::GATHER) { if ((h) == 0) PG8_STAGE(bufoff, p, g0); else PG8_STAGE(bufoff, p, g1); } \
        else { PG8_STAGE(bufoff, (p) + (h) * hstep, voffA); } } while (0)
    PG8_STAGE(PG8_SB(0, 0), cB, voffB); PG8_STAGE(PG8_SB(0, 1), cB + hstep, voffB); PG8_STAGE_A(PG8_SA(0, 0), cA, 0, ca0, ca1); PG8_STAGE_A(PG8_SA(0, 1), cA, 1, ca0, ca1);
    if (wr == 1) PG8_BAR;
    PG8_WAIT_V(2); PG8_BAR;
    PG8_STAGE(PG8_SB(1, 0), cB + kstep, voffB); PG8_STAGE_A(PG8_SA(1, 0), cA + kstep, 0, ca0, ca1); PG8_STAGE(PG8_SB(1, 1), cB + hstep + kstep, voffB);
    PG8_WAIT_V(6); PG8_BAR;
    for (;;) {
        const bool has_next = S.next(ui + 1, nxt);
        const char* nA = cA; const char* nB = has_next ? S.bbase(nxt) : cB;
        if constexpr (Sched::GATHER) {
            if (has_next) {
#pragma unroll
                for (int i = 0; i < 2; ++i) { na0[i] = S.arow(nxt, RA[i]) + CA2[i]; na1[i] = S.arow(nxt, HALF + RA[i]) + CA2[i]; }
            } else {
#pragma unroll
                for (int i = 0; i < 2; ++i) { na0[i] = ca0[i]; na1[i] = ca1[i]; }
            }
        } else { if (has_next) nA = Abase + S.aoff(nxt); }
        for (int t = 0; t < nt; t += 2) {
            const bool last = (t == nt - 2);
            const char* a1 = cA + (size_t)(t + 1) * kstep;
            const char* a2 = last ? nA : cA + (size_t)(t + 2) * kstep; const char* b2 = last ? nB : cB + (size_t)(t + 2) * kstep;
            const char* a3 = a2 + kstep; const char* b3 = b2 + kstep;
            unsigned s0[2], s1[2];
#pragma unroll
            for (int i = 0; i < 2; ++i) { s0[i] = last ? na0[i] : ca0[i]; s1[i] = last ? na1[i] : ca1[i]; }
            PG8_LDB(B0, 0, 0); PG8_LDB(B1, 0, 1); PG8_SCHED; PG8_LDA(At, 0, 0); PG8_STAGE_A(PG8_SA(1, 1), a1, 1, ca0, ca1);
            PG8_WAIT_V(8); PG8_WAIT_L(0); PG8_BAR; PG8_MMA(0, 0, At, B0); PG8_MMA(0, 1, At, B1); PG8_BAR; PG8_SCHED;
            PG8_LDA(At, 0, 1); PG8_STAGE(PG8_SB(0, 0), b2, voffB); PG8_STAGE(PG8_SB(0, 1), b2 + hstep, voffB); PG8_STAGE_A(PG8_SA(0, 0), a2, 0, s0, s1);
            PG8_WAIT_V(8); PG8_WAIT_L(0); PG8_BAR; PG8_MMA(1, 0, At, B0); PG8_MMA(1, 1, At, B1); PG8_BAR; PG8_SCHED;
            PG8_LDB(B0, 1, 0); PG8_LDB(B1, 1, 1); PG8_SCHED; PG8_LDA(At, 1, 0); PG8_STAGE_A(PG8_SA(0, 1), a2, 1, s0, s1);
            PG8_WAIT_V(8); PG8_WAIT_L(0); PG8_BAR; PG8_MMA(0, 0, At, B0); PG8_MMA(0, 1, At, B1); PG8_BAR; PG8_SCHED;
            PG8_LDA(At, 1, 1); PG8_STAGE(PG8_SB(1, 0), b3, voffB); PG8_STAGE(PG8_SB(1, 1), b3 + hstep, voffB); PG8_STAGE_A(PG8_SA(1, 0), a3, 0, s0, s1);
            PG8_WAIT_V(8); PG8_WAIT_L(0); PG8_BAR; PG8_MMA(1, 0, At, B0); PG8_MMA(1, 1, At, B1); PG8_BAR; PG8_SCHED;
        }
        if constexpr (ALIGN_EPI) { if (wr == 0) PG8_BAR; }
        E(acc, cur, wr, wc, fr, fq);
        if (!has_next) break;
#pragma unroll
        for (int a = 0; a < 2; ++a)
#pragma unroll
            for (int b = 0; b < 2; ++b)
#pragma unroll
                for (int m = 0; m < 4; ++m)
#pragma unroll
                    for (int n = 0; n < 2; ++n) acc[a][b][m][n] = (f32x4){0.f, 0.f, 0.f, 0.f};
        cur = nxt; cA = nA; cB = nB; ++ui;
        if constexpr (Sched::GATHER) {
#pragma unroll
            for (int i = 0; i < 2; ++i) { ca0[i] = na0[i]; ca1[i] = na1[i]; }
        }
        if constexpr (ALIGN_EPI) { if (wr == 1) PG8_BAR; }
    }
    PG8_WAIT_V(0);
    if constexpr (!ALIGN_EPI) { if (wr == 0) PG8_BAR; }
    PG8_BAR;
#undef PG8_SA
#undef PG8_SB
#undef PG8_STAGE
#undef PG8_LDA
#undef PG8_LDB
#undef PG8_MMA
#undef PG8_WAIT_V
#undef PG8_WAIT_L
#undef PG8_BAR
#undef PG8_SCHED
#undef PG8_STAGE_A
}
}

#define XB_TMO      128
#define XB_XCNT(j)  (256  + 64 * (j))
#define XB_XSUB(j)  (1280 + 64 * (j))
#define XB_XGEN(j)  (2304 + 64 * (j))
#define XB_TOP      3328
#define XB_TOPGEN   3392
#define XCD_BAR_WORDS 3456
#define XB_SPIN_CAP (1u << 18)
__device__ __forceinline__ unsigned xb_ld(unsigned* p)              { return __hip_atomic_load(p, __ATOMIC_RELAXED, __HIP_MEMORY_SCOPE_AGENT); }
__device__ __forceinline__ unsigned xb_add(unsigned* p, unsigned v) { return __hip_atomic_fetch_add(p, v, __ATOMIC_RELAXED, __HIP_MEMORY_SCOPE_AGENT); }
__device__ __forceinline__ unsigned xb_xcc_id() { return (unsigned)__builtin_amdgcn_s_getreg((3 << 11) | 20) & 0xFu; }
#define XB_SPIN(cond, bar) do { unsigned _sp = 0; while (cond) { __builtin_amdgcn_s_sleep(1); \
    if ((++_sp & 255u) == 0u) { if (xb_ld(&(bar)[XB_TMO])) break; if (_sp > XB_SPIN_CAP) { atomicAdd(&(bar)[XB_TMO], 1u); break; } } } } while (0)
struct XcdBarrier { unsigned* bar; unsigned x; volatile LAS unsigned* st; };
__device__ __forceinline__ XcdBarrier xcd_barrier_post(unsigned* bar, volatile LAS unsigned* st) {
    XcdBarrier b; b.bar = bar; b.x = xb_xcc_id(); b.st = st;
    if (threadIdx.x == 0) (void)xb_add(&bar[XB_XCNT(b.x)], 1u);
    return b;
}
__device__ __forceinline__ void xcd_barrier_complete(unsigned* bar, unsigned x, unsigned& nloc, unsigned& nx) {
    const unsigned G = gridDim.x * gridDim.y * gridDim.z;
    unsigned sum, cnt, mine, sp = 0u;
    for (;;) {
        sum = 0u; cnt = 0u; mine = 0u;
#pragma unroll
        for (unsigned j = 0; j < 16; ++j) { const unsigned c = xb_ld(&bar[XB_XCNT(j)]); sum += c; cnt += (c > 0u) ? 1u : 0u; mine = (j == x) ? c : mine; }
        if (sum == G) break;
        __builtin_amdgcn_s_sleep(1);
        if ((++sp & 255u) == 0u) { if (xb_ld(&bar[XB_TMO])) break; if (sp > XB_SPIN_CAP) { atomicAdd(&bar[XB_TMO], 1u); break; } }
    }
    nloc = mine > 0u ? mine : 1u; nx = cnt > 0u ? cnt : 1u;
}
__device__ __forceinline__ void xcd_barrier(const XcdBarrier& b) {
    asm volatile("s_waitcnt vmcnt(0)" ::: "memory");
    __syncthreads();
    if (threadIdx.x == 0) {
        unsigned* bar = b.bar;
        __builtin_amdgcn_s_waitcnt(0);
        unsigned nloc = b.st[0], nx = b.st[1];
        if (nloc == 0u) { xcd_barrier_complete(bar, b.x, nloc, nx); b.st[0] = nloc; b.st[1] = nx; }
        const unsigned old = xb_add(&bar[XB_XSUB(b.x)], 1u);
        const unsigned gen = old / nloc;
        if (old + 1u == (gen + 1u) * nloc) {
            __builtin_amdgcn_fence(__ATOMIC_RELEASE, "agent");
            asm volatile("s_waitcnt vmcnt(0)" ::: "memory");
            const unsigned og = xb_add(&bar[XB_TOP], 1u);
            const unsigned tg = og / nx;
            if (og + 1u == (tg + 1u) * nx) xb_add(&bar[XB_TOPGEN], 1u);
            else XB_SPIN(xb_ld(&bar[XB_TOPGEN]) == tg, bar);
            __builtin_amdgcn_fence(__ATOMIC_ACQUIRE, "agent");
            xb_add(&bar[XB_XGEN(b.x)], 1u);
            asm volatile("s_waitcnt vmcnt(0)" ::: "memory");
        } else {
            XB_SPIN(xb_ld(&bar[XB_XGEN(b.x)]) == gen, bar);
            __builtin_amdgcn_fence(__ATOMIC_ACQUIRE, "agent");
            asm volatile("s_waitcnt vmcnt(0)" ::: "memory");
        }
    }
    __syncthreads();
}

struct Args { const float* in[25]; float* out; unsigned char* ws; int ph_lo, ph_hi, use_bar, pad; };
struct Frame {
    LAS unsigned char* lds; unsigned* ctl; int tid, lane, wave, vcu, G;
    const float* const* in_;
};

__device__ __forceinline__ void transpose_item(const float* W, int K, int N, bf16* WT, int mode, LAS float* scr, int item, int lane) {
    const int nblk = N / 32, kb = item / nblk, nb = item % nblk, k0 = 64 * kb, n0 = 32 * nb;
#pragma unroll 8
    for (int i = 0; i < 32; ++i) { const int kk = 2 * i + (lane >> 5); scr[kk * 33 + (lane & 31)] = W[(size_t)(k0 + kk) * N + n0 + (lane & 31)]; }
    LDS_WAIT(); asm volatile("" ::: "memory");
    const int r0 = mode ? ((n0 >> 7) * 256 + (n0 & 127) + (mode == 2 ? 128 : 0)) : n0;
    const int c = lane & 7;
#pragma unroll
    for (int j = 0; j < 4; ++j) { const int n = (lane >> 3) + 8 * j; const LAS float* s = scr + (8 * c) * 33 + n;
        u32x4 o; o.x = pk2(s[0 * 33], s[1 * 33]); o.y = pk2(s[2 * 33], s[3 * 33]); o.z = pk2(s[4 * 33], s[5 * 33]); o.w = pk2(s[6 * 33], s[7 * 33]);
        *(u32x4*)(WT + (size_t)(r0 + n) * K + k0 + 8 * c) = o; }
    LDS_WAIT(); asm volatile("" ::: "memory");
}
constexpr int IT_IN = (DM / 64) * (DIN / 32), IT_OUT = (DM / 64) * (DM / 32), IT_G = (DM / 64) * (DE / 32), IT_D = (DE / 64) * (DM / 32);
constexpr int IT_LAYER = IT_IN + IT_OUT + 65 * (2 * IT_G + IT_D);

__device__ __forceinline__ void ln_regs(f32x4 (&v)[8], const float* gain, const float* bias, int lane) {
    float s = 0.f;
#pragma unroll
    for (int j = 0; j < 8; ++j) s += (v[j].x + v[j].y) + (v[j].z + v[j].w);
    const float mean = wave_sum(s) * (1.f / DM); float s2 = 0.f;
#pragma unroll
    for (int j = 0; j < 8; ++j) { v[j] = v[j] - mean; s2 += (v[j].x * v[j].x + v[j].y * v[j].y) + (v[j].z * v[j].z + v[j].w * v[j].w); }
    const float rstd = 1.f / sqrtf(wave_sum(s2) * (1.f / DM) + LN_EPS);
#pragma unroll
    for (int j = 0; j < 8; ++j) { const f32x4 g = ((const f32x4*)gain)[j * 64 + lane], b = ((const f32x4*)bias)[j * 64 + lane]; v[j] = v[j] * rstd * g + b; }
}
__device__ __forceinline__ void store_row_f32(float* dst, const f32x4 (&v)[8], int lane) {
#pragma unroll
    for (int j = 0; j < 8; ++j) ((f32x4*)dst)[j * 64 + lane] = v[j];
}
__device__ __forceinline__ void store_row_bf16(bf16* dst, const f32x4 (&v)[8], int lane) {
#pragma unroll
    for (int j = 0; j < 8; ++j) { u32x2 w; w.x = pk2(v[j].x, v[j].y); w.y = pk2(v[j].z, v[j].w); ((u32x2*)dst)[j * 64 + lane] = w; }
}


typedef float f32x16 __attribute__((ext_vector_type(16)));
#define MFMA32(a, b, c) __builtin_amdgcn_mfma_f32_32x32x16_bf16((a), (b), (c), 0, 0, 0)
__device__ __forceinline__ int krow16(int r, int h) { return (r & 3) + 8 * (r >> 2) + 4 * h; }
__device__ __forceinline__ bf16x8 pack8(const f32x16& x, int s) {
    u32x4 p; p.x = pk2(x[8 * s], x[8 * s + 1]); p.y = pk2(x[8 * s + 2], x[8 * s + 3]); p.z = pk2(x[8 * s + 4], x[8 * s + 5]); p.w = pk2(x[8 * s + 6], x[8 * s + 7]);
    return __builtin_bit_cast(bf16x8, p);
}
constexpr int SWA_KS_BYTES = 192 * 128, SWA_VT_STRIDE = 196, SWA_VT_BYTES = 64 * SWA_VT_STRIDE * 2;
__device__ __forceinline__ void swa_unit(LAS unsigned char* lds, const bf16* projp, bf16* mixedp, const float* sinks, const float* gain, int unit, int tid, int lane, int wave) {
    const int b = unit >> 6, blk = (unit >> 1) & 31, half = unit & 1;
    const int kp0 = blk * 128 - 128 + 64 * half, qp0 = blk * 128 + 64 * half;
    LAS unsigned char* Ks = lds;
    LAS bf16* Vt = (LAS bf16*)(lds + 2 * SWA_KS_BYTES);
    LAS float* ssq = (LAS float*)(lds + 2 * SWA_KS_BYTES + 2 * SWA_VT_BYTES);
    __syncthreads();
    for (int i = 0; i < 6; ++i) {
        const int idx = tid + NTHR * i, kvh = idx / 1536, rem = idx % 1536, s = rem >> 3, ch = rem & 7, kp = kp0 + s;
        u32x4 kw = (u32x4){0u, 0u, 0u, 0u}, vw = (u32x4){0u, 0u, 0u, 0u};
        if (kp >= 0) { const bf16* rp = projp + (size_t)(b * SEQ + kp) * DIN + kvh * 64 + ch * 8; kw = *(const u32x4*)(rp + C_AK); vw = *(const u32x4*)(rp + C_AV); }
        *(LAS u32x4*)(Ks + kvh * SWA_KS_BYTES + s * 128 + ((ch ^ (s & 7)) << 4)) = kw;
        LAS bf16* vd = Vt + kvh * (64 * SWA_VT_STRIDE) + (ch * 8) * SWA_VT_STRIDE + s;
        vd[0 * SWA_VT_STRIDE] = (bf16)(vw.x & 0xffffu); vd[1 * SWA_VT_STRIDE] = (bf16)(vw.x >> 16); vd[2 * SWA_VT_STRIDE] = (bf16)(vw.y & 0xffffu); vd[3 * SWA_VT_STRIDE] = (bf16)(vw.y >> 16);
        vd[4 * SWA_VT_STRIDE] = (bf16)(vw.z & 0xffffu); vd[5 * SWA_VT_STRIDE] = (bf16)(vw.z >> 16); vd[6 * SWA_VT_STRIDE] = (bf16)(vw.w & 0xffffu); vd[7 * SWA_VT_STRIDE] = (bf16)(vw.w >> 16);
    }
    __syncthreads();
    const int c32 = lane & 31, h = lane >> 5, kvh = wave >> 2;
    const LAS unsigned char* Kw = Ks + kvh * SWA_KS_BYTES; const LAS bf16* Vw = Vt + kvh * (64 * SWA_VT_STRIDE);
#pragma unroll 1
    for (int item = 0; item < 4; ++item) {
        const int hd = wave * 2 + (item >> 1), qi = item & 1, rho = 32 * qi + c32;
        const bf16* qp = projp + (size_t)(b * SEQ + qp0 + rho) * DIN + C_AQ + hd * 64 + 8 * h;
        bf16x8 qf[4];
#pragma unroll
        for (int ks = 0; ks < 4; ++ks) qf[ks] = __builtin_bit_cast(bf16x8, *(const u32x4*)(qp + 16 * ks));
        f32x16 X[5];
#pragma unroll
        for (int kt = 0; kt < 5; ++kt) {
            const int key = 32 * (qi + kt) + c32;
#pragma unroll
            for (int r = 0; r < 16; ++r) X[kt][r] = 0.f;
#pragma unroll
            for (int ks = 0; ks < 4; ++ks) { const bf16x8 kf = *(const LAS bf16x8*)(Kw + key * 128 + (((2 * ks + h) ^ (key & 7)) << 4)); X[kt] = MFMA32(kf, qf[ks], X[kt]); }
        }
        const float sink = sinks[hd];
        float m = sink;
#pragma unroll
        for (int kt = 0; kt < 5; ++kt)
#pragma unroll
            for (int r = 0; r < 16; ++r) { const int s = 32 * (qi + kt) + krow16(r, h); const bool valid = (s > rho) && (s <= rho + 128) && (kp0 + s >= 0);
                const float sc = valid ? X[kt][r] * 0.125f : -INFINITY; X[kt][r] = sc; m = fmaxf(m, sc); }
        m = fmaxf(m, __shfl_xor(m, 32));
        float lsum = 0.f;
#pragma unroll
        for (int kt = 0; kt < 5; ++kt)
#pragma unroll
            for (int r = 0; r < 16; ++r) { const float p = __expf(X[kt][r] - m); X[kt][r] = p; lsum += p; }
        lsum += __shfl_xor(lsum, 32); lsum += __expf(sink - m);
        f32x16 O[2];
#pragma unroll
        for (int dt = 0; dt < 2; ++dt)
#pragma unroll
            for (int r = 0; r < 16; ++r) O[dt][r] = 0.f;
#pragma unroll
        for (int kt = 0; kt < 5; ++kt)
#pragma unroll
            for (int s2 = 0; s2 < 2; ++s2) { const bf16x8 pf = pack8(X[kt], s2); const int kb = 32 * (qi + kt) + 16 * s2 + 4 * h;
#pragma unroll
                for (int dt = 0; dt < 2; ++dt) { const LAS bf16* vp = Vw + (32 * dt + c32) * SWA_VT_STRIDE + kb;
                    const u32x2 v0 = *(const LAS u32x2*)vp, v1 = *(const LAS u32x2*)(vp + 8);
                    const bf16x8 vf = __builtin_bit_cast(bf16x8, (u32x4){v0.x, v0.y, v1.x, v1.y}); O[dt] = MFMA32(vf, pf, O[dt]); } }
        const float inv = 1.0f / lsum; float ss = 0.f;
        bf16* op = mixedp + (size_t)(b * SEQ + qp0 + rho) * DM + 512 + hd * 64 + 4 * h;
#pragma unroll
        for (int dt = 0; dt < 2; ++dt)
#pragma unroll
            for (int g4 = 0; g4 < 4; ++g4) { const float o0 = O[dt][4 * g4] * inv, o1 = O[dt][4 * g4 + 1] * inv, o2 = O[dt][4 * g4 + 2] * inv, o3 = O[dt][4 * g4 + 3] * inv;
                ss += (o0 * o0 + o1 * o1) + (o2 * o2 + o3 * o3); *(u32x2*)(op + 32 * dt + 8 * g4) = (u32x2){pk2(o0, o1), pk2(o2, o3)}; }
        ss += __shfl_xor(ss, 32);
        if (h == 0) ssq[rho * 16 + hd] = ss;
    }
    __syncthreads();
#pragma unroll 1
    for (int item = 0; item < 4; ++item) {
        const int hd = wave * 2 + (item >> 1), qi = item & 1, rho = 32 * qi + c32;
        float tot = 0.f;
#pragma unroll
        for (int j = 0; j < 16; ++j) tot += ssq[rho * 16 + j];
        const float rr = 1.0f / sqrtf(tot * (1.0f / 1024.0f) + RMS_EPS);
        const float* gp = gain + 512 + hd * 64 + 4 * h;
        bf16* op = mixedp + (size_t)(b * SEQ + qp0 + rho) * DM + 512 + hd * 64 + 4 * h;
#pragma unroll
        for (int dt = 0; dt < 2; ++dt)
#pragma unroll
            for (int g4 = 0; g4 < 4; ++g4) { const u32x2 o = *(const u32x2*)(op + 32 * dt + 8 * g4); const f32x4 g = *(const f32x4*)(gp + 32 * dt + 8 * g4);
                *(u32x2*)(op + 32 * dt + 8 * g4) = (u32x2){pk2(bflo(o.x) * rr * g.x, bfhi(o.x) * rr * g.y), pk2(bflo(o.y) * rr * g.z, bfhi(o.y) * rr * g.w)}; }
    }
    __syncthreads();
}

#define KAS __attribute__((address_space(4)))
#define PHASE_PTRS const char KAS* kp_ = (const char KAS*)__builtin_amdgcn_kernarg_segment_ptr(); asm volatile("" : "+s"(kp_)); unsigned char* const ws = *(unsigned char* const KAS*)(kp_ + 26 * 8); (void)ws;
#define INP(k) (*(const float* const KAS*)(kp_ + (k) * 8))
#define x_in INP(0)
#define ln0_g INP(1)
#define ln0_b INP(2)
#define w_in INP(3)
#define b_in INP(4)
#define lb_logits INP(5)
#define sw_sinks INP(6)
#define sg_ln_g INP(7)
#define sg_ln_b INP(8)
#define sg_w_s INP(9)
#define sg_b_s INP(10)
#define mix_gain INP(11)
#define w_out INP(12)
#define ln1_g INP(13)
#define ln1_b INP(14)
#define router_w INP(15)
#define router_b INP(16)
#define ew_gate INP(17)
#define ew_up INP(18)
#define ew_down INP(19)
#define sh_gate INP(20)
#define sh_up INP(21)
#define sh_down INP(22)
#define ln2_g INP(23)
#define ln2_b INP(24)
#define OUTP (*(float* const KAS*)(kp_ + 25 * 8))
#define list ((int*)(ws + WS_LIST))
#define wlist ((float*)(ws + WS_WLIST))
#define slot ((int*)(ws + WS_SLOT))
#define dendG ((float*)(ws + WS_DEND))
#define stateG ((float*)(ws + WS_STATE))
#define Hf ((float*)(ws + WS_HF))
#define Hb ((bf16*)(ws + WS_HB))
#define proj ((bf16*)(ws + WS_PROJ))
#define mixed ((bf16*)(ws + WS_MIXED))
#define Hs ((bf16*)(ws + WS_HS))
#define Yb ((bf16*)(ws + WS_Y))
#define ctl ((unsigned*)(ws + WS_CTL))
#define WLp ((const char*)(ws + WS_W + (size_t)l * WL_BYTES))
#define cntG (ctl + CW_CNT + l * 64)
__global__ void __launch_bounds__(NTHR, 2) fwd_kernel(Args args) {
    extern __shared__ __attribute__((aligned(16))) unsigned char lds_raw[];
    LAS unsigned char* const lds = (LAS unsigned char*)lds_raw;
    const int tid = threadIdx.x, lane = tid & 63, wave = __builtin_amdgcn_readfirstlane(tid >> 6);
    const int G = gridDim.x, bx = blockIdx.x;
    const int vcu = (G % 8 == 0) ? (bx % 8) * (G / 8) + bx / 8 : bx;
    volatile LAS unsigned* MISC = (volatile LAS unsigned*)(lds + MISC_OFF);
    if (tid < 64) MISC[tid] = 0u;
    __syncthreads();
    XcdBarrier bar; bar.bar = (unsigned*)(args.ws + WS_CTL) + CW_BAR; bar.x = 0; bar.st = nullptr;
    if (args.use_bar) bar = xcd_barrier_post((unsigned*)(args.ws + WS_CTL) + CW_BAR, MISC + 8);
    const int lo = args.ph_lo, hi = args.ph_hi;
#define PHASE_TID int tid_o_ = threadIdx.x; asm volatile("" : "+v"(tid_o_)); const int tid = tid_o_, lane = tid & 63; (void)lane; (void)tid;
#ifndef BSEL
#define BSEL 7
#endif
#ifndef DBLMASK
#define DBLMASK 0
#endif
#define REP(i) (((DBLMASK >> (i)) & 1) ? 2 : 1)
#ifndef PHMASK
#define PHMASK 0x3ff
#endif
#define IN(k) (lo <= (k) && (k) < hi)
#define EN(i) ((PHMASK >> (i)) & 1)
#define SEAM(k) do { if (IN(k) && IN((k) + 1)) xcd_barrier(bar); } while (0)

    for (int rep_ = 0; rep_ < REP(0); ++rep_)
    if (EN(0) && IN(0)) { PHASE_TID PHASE_PTRS
        LAS float* scr = (LAS float*)(lds + wave * 16384);
        const int gw = vcu * NWAVES + wave, NGW = G * NWAVES;
        for (int it = gw; it < 2 * IT_LAYER; it += NGW) {
            const int l = it / IT_LAYER; int r = it % IT_LAYER;
            bf16* const WL = (bf16*)(ws + WS_W + (size_t)l * WL_BYTES);
            if (r < IT_IN) { transpose_item(w_in + (size_t)l * DM * DIN, DM, DIN, (bf16*)((char*)WLp + WL_IN), 0, scr, r, lane); continue; } r -= IT_IN;
            if (r < IT_OUT) { transpose_item(w_out + (size_t)l * DM * DM, DM, DM, (bf16*)((char*)WLp + WL_OUT), 0, scr, r, lane); continue; } r -= IT_OUT;
            const int e = r / (2 * IT_G + IT_D); r = r % (2 * IT_G + IT_D);
            bf16* const gu = (bf16*)((char*)WLp + WL_GU + (size_t)e * W_GU_B); bf16* const dn = (bf16*)((char*)WLp + WL_D + (size_t)e * W_D_B);
            if (r < IT_G) { const float* src = (e < 64) ? ew_gate + ((size_t)l * 64 + e) * DM * DE : sh_gate + (size_t)l * DM * DE; transpose_item(src, DM, DE, gu, 1, scr, r, lane); continue; } r -= IT_G;
            if (r < IT_G) { const float* src = (e < 64) ? ew_up + ((size_t)l * 64 + e) * DM * DE : sh_up + (size_t)l * DM * DE; transpose_item(src, DM, DE, gu, 2, scr, r, lane); continue; } r -= IT_G;
            { const float* src = (e < 64) ? ew_down + ((size_t)l * 64 + e) * DE * DM : sh_down + (size_t)l * DE * DM; transpose_item(src, DE, DM, dn, 0, scr, r, lane); }
        }
        for (int m = gw; m < NTOK; m += NGW) {
            f32x4 v[8];
#pragma unroll
            for (int j = 0; j < 8; ++j) v[j] = ((const f32x4*)(x_in + (size_t)m * DM))[j * 64 + lane];
            ln_regs(v, ln0_g, ln0_b, lane);
            store_row_f32(Hf + (size_t)m * DM, v, lane); store_row_bf16(Hb + (size_t)m * DM, v, lane);
        }
    }
    SEAM(0);

    for (int l = 0; l < 2; ++l) {
        const int pb = 1 + l * 9;

        for (int rep_ = 0; rep_ < REP(1); ++rep_)
        if (EN(1) && IN(pb + 0)) { PHASE_PTRS
            pg8::PlainSched S; S.init(NTOK, DIN, DM, G, bx, WLp + WL_IN);
            pg8::EpiBf16Bias E{proj, DIN, b_in + (size_t)l * DIN};
            pg8::gemm_phase<pg8::EpiBf16Bias, pg8::PlainSched, true>(lds, (const char*)Hb, DM, S, E);
        }
        SEAM(pb + 0);

        for (int rep_ = 0; rep_ < REP(2); ++rep_)
        if (EN(2) && IN(pb + 1)) {
            if (BSEL & 1) { PHASE_TID PHASE_PTRS
            for (int unit = bx; unit < 512; unit += G) {
                const int bh = unit >> 5, c = unit & 31, b = bh >> 2, h = bh & 3, row0 = b * SEQ + c * 128;
                LAS float* bL = (LAS float*)lds;
                LAS bf16* kkb = (LAS bf16*)(lds + 65536);
                LAS bf16* vb = (LAS bf16*)(lds + 98304);
                LAS float* segtot = (LAS float*)(lds + 131072);
                LAS float* bendL = (LAS float*)(lds + 131072 + 2048);
                LAS float* lbs = (LAS float*)(lds + 131072 + 2560);
                if (tid < 128) { float lb = 0.f; if (l == 1) { const float a0 = lb_logits[h * 128 + tid], a1 = lb_logits[512 + h * 128 + tid]; lb = 1.0f / (1.0f + expf(a0 - a1)); } lbs[tid] = lb; }
                __syncthreads();
#pragma unroll
                for (int i = 0; i < 4; ++i) {
                    const int idx = tid + NTHR * i, t = idx >> 4, kg = idx & 15;
                    const bf16* rowp = proj + (size_t)(row0 + t) * DIN + h * 128 + kg * 8;
                    const u32x4 z8 = *(const u32x4*)(rowp + C_HF); const u32x4 v8 = *(const u32x4*)(rowp + C_HI);
                    const unsigned zw[4] = {z8.x, z8.y, z8.z, z8.w};
                    unsigned kw[4];
#pragma unroll
                    for (int j = 0; j < 4; ++j) {
                        float kk2[2];
#pragma unroll
                        for (int q = 0; q < 2; ++q) {
                            const float z = q ? bfhi(zw[j]) : bflo(zw[j]); const int k = kg * 8 + j * 2 + q; const float lb = lbs[k];
                            const float ls = fminf(z, 0.f) - log1pf(expf(-fabsf(z)));
                            const float lf = (lb == 0.f) ? ls : logf(lb + (1.f - lb) * expf(ls));
                            bL[t * 128 + k] = lf; kk2[q] = (1.f - lb) / (1.f + expf(z));
                        }
                        kw[j] = pk2(kk2[0], kk2[1]);
                    }
                    *(LAS u32x4*)(kkb + t * 128 + kg * 8) = (u32x4){kw[0], kw[1], kw[2], kw[3]};
                    *(LAS u32x4*)(vb + t * 128 + kg * 8) = v8;
                }
                __syncthreads();
                { const int k = tid & 127, seg = tid >> 7; float run = 0.f;
                    for (int tt = 0; tt < 32; ++tt) { const int t = seg * 32 + tt; run += bL[t * 128 + k]; bL[t * 128 + k] = run; }
                    segtot[seg * 128 + k] = run;
                    __syncthreads();
                    float off = 0.f, tot = 0.f;
#pragma unroll
                    for (int s = 0; s < 4; ++s) { const float v = segtot[s * 128 + k]; if (s < seg) off += v; tot += v; }
                    if (seg > 0) for (int tt = 0; tt < 32; ++tt) { const int t = seg * 32 + tt; bL[t * 128 + k] += off; }
                    if (seg == 0) { bendL[k] = tot; dendG[(size_t)(bh * 32 + c) * 128 + k] = expf(tot); }
                }
                __syncthreads();
                for (int i = 0; i < 32; ++i) { const int idx = tid + NTHR * i, t = idx >> 7, k = idx & 127; bL[idx] = bf2f(kkb[idx]) * expf(bendL[k] - bL[idx]); (void)t; }
                __syncthreads();
                { const int kq = tid >> 4, vq = tid & 15, k0 = 4 * kq, v0 = 8 * vq;
                    float acc[4][8];
#pragma unroll
                    for (int i = 0; i < 4; ++i)
#pragma unroll
                        for (int j = 0; j < 8; ++j) acc[i][j] = 0.f;
                    for (int t = 0; t < 128; ++t) {
                        const f32x4 a4 = *(const LAS f32x4*)(bL + t * 128 + k0); const u32x4 v8 = *(const LAS u32x4*)(vb + t * 128 + v0);
                        const float vf[8] = {bflo(v8.x), bfhi(v8.x), bflo(v8.y), bfhi(v8.y), bflo(v8.z), bfhi(v8.z), bflo(v8.w), bfhi(v8.w)};
#pragma unroll
                        for (int i = 0; i < 4; ++i)
#pragma unroll
                            for (int j = 0; j < 8; ++j) acc[i][j] += a4[i] * vf[j];
                    }
                    float* sp = stateG + ((size_t)(bh * 32 + c) * 128 + k0) * 128 + v0;
#pragma unroll
                    for (int i = 0; i < 4; ++i) { *(f32x4*)(sp + i * 128) = (f32x4){acc[i][0], acc[i][1], acc[i][2], acc[i][3]}; *(f32x4*)(sp + i * 128 + 4) = (f32x4){acc[i][4], acc[i][5], acc[i][6], acc[i][7]}; }
                }
                __syncthreads();
            }
            }
            if (BSEL & 2) { PHASE_TID PHASE_PTRS
            for (int unit = bx; unit < 256; unit += G) swa_unit(lds, proj, mixed, sw_sinks + l * 16, mix_gain + (size_t)l * DM, unit, tid, lane, wave);
            }
            if (BSEL & 4) { PHASE_TID PHASE_PTRS
            for (int unit = bx; unit < 128; unit += G) {
                const int row0 = unit * 128;
                LAS float* vn = (LAS float*)lds;
                LAS float* wT = (LAS float*)(lds + 65536);
                LAS f32x2* stats = (LAS f32x2*)(lds + 133120);
                __syncthreads();
#pragma unroll 1
                for (int i = 0; i < 16; ++i) { const int s = wave * 16 + i;
                    const u32x4 w = *(const u32x4*)(proj + (size_t)(row0 + s) * DIN + C_SV + lane * 8);
                    float g[8] = {geluf_(bflo(w.x)), geluf_(bfhi(w.x)), geluf_(bflo(w.y)), geluf_(bfhi(w.y)), geluf_(bflo(w.z)), geluf_(bfhi(w.z)), geluf_(bflo(w.w)), geluf_(bfhi(w.w))};
                    float sm = 0.f;
#pragma unroll
                    for (int j = 0; j < 8; ++j) sm += g[j];
                    const float mean = wave_sum(sm) * (1.0f / 512.0f); float s2 = 0.f;
#pragma unroll
                    for (int j = 0; j < 8; ++j) { const float d = g[j] - mean; s2 += d * d; }
                    const float rstd = 1.0f / sqrtf(wave_sum(s2) * (1.0f / 512.0f) + LN_EPS);
                    if (lane == 0) stats[s] = (f32x2){mean, rstd};
                }
                float ssr[4] = {0.f, 0.f, 0.f, 0.f};
                const int tq = tid >> 4, cq = tid & 15, t0 = 4 * tq, c0 = 8 * cq;
#pragma unroll 1
                for (int g = 0; g < 4; ++g) {
                    __syncthreads();
#pragma unroll 1
                    for (int i = 0; i < 4; ++i) { const int idx = tid + NTHR * i, s = idx >> 4, cg = idx & 15;
                        const u32x4 w = *(const u32x4*)(proj + (size_t)(row0 + s) * DIN + C_SV + g * 128 + cg * 8);
                        const f32x2 st = stats[s]; const float* lg = sg_ln_g + (size_t)l * 512 + g * 128 + cg * 8; const float* lbp = sg_ln_b + (size_t)l * 512 + g * 128 + cg * 8;
                        const float x8[8] = {bflo(w.x), bfhi(w.x), bflo(w.y), bfhi(w.y), bflo(w.z), bfhi(w.z), bflo(w.w), bfhi(w.w)};
#pragma unroll
                        for (int j = 0; j < 8; ++j) vn[s * 128 + cg * 8 + j] = (geluf_(x8[j]) - st.x) * st.y * lg[j] + lbp[j];
                    }
                    { const float* wsrc = sg_w_s + ((size_t)l * 4 + g) * 128 * 128;
#pragma unroll
                        for (int i = 0; i < 8; ++i) { const int idx = tid + NTHR * i, s4 = (idx >> 7) * 4, t = idx & 127;
                            const f32x4 w4 = *(const f32x4*)(wsrc + t * 128 + s4);
#pragma unroll
                            for (int j = 0; j < 4; ++j) wT[(s4 + j) * 132 + t] = (s4 + j <= t) ? w4[j] : 0.f; } }
                    __syncthreads();
                    float acc[4][8];
#pragma unroll
                    for (int i = 0; i < 4; ++i)
#pragma unroll
                        for (int j = 0; j < 8; ++j) acc[i][j] = 0.f;
                    for (int s = 0; s <= t0 + 3; ++s) {
                        const f32x4 w4 = *(const LAS f32x4*)(wT + s * 132 + t0); const f32x4 va = *(const LAS f32x4*)(vn + s * 128 + c0), vb2 = *(const LAS f32x4*)(vn + s * 128 + c0 + 4);
                        const float vf[8] = {va.x, va.y, va.z, va.w, vb2.x, vb2.y, vb2.z, vb2.w};
#pragma unroll
                        for (int i = 0; i < 4; ++i)
#pragma unroll
                            for (int j = 0; j < 8; ++j) acc[i][j] += w4[i] * vf[j];
                    }
#pragma unroll 1
                    for (int i = 0; i < 4; ++i) { const float bs = sg_b_s[((size_t)l * 4 + g) * 128 + t0 + i];
                        const u32x4 w = *(const u32x4*)(proj + (size_t)(row0 + t0 + i) * DIN + C_SU + g * 128 + c0);
                        const float u8[8] = {bflo(w.x), bfhi(w.x), bflo(w.y), bfhi(w.y), bflo(w.z), bfhi(w.z), bflo(w.w), bfhi(w.w)};
                        float o8[8];
#pragma unroll
                        for (int j = 0; j < 8; ++j) { o8[j] = geluf_(u8[j]) * (acc[i][j] + bs); ssr[i] += o8[j] * o8[j]; }
                        *(u32x4*)(mixed + (size_t)(row0 + t0 + i) * DM + 1536 + g * 128 + c0) = (u32x4){pk2(o8[0], o8[1]), pk2(o8[2], o8[3]), pk2(o8[4], o8[5]), pk2(o8[6], o8[7])}; }
                }
                __syncthreads();
#pragma unroll
                for (int i = 0; i < 4; ++i) { float ss = ssr[i];
                    ss += __shfl_xor(ss, 1); ss += __shfl_xor(ss, 2); ss += __shfl_xor(ss, 4); ss += __shfl_xor(ss, 8);
                    const float rr = 1.0f / sqrtf(ss * (1.0f / 512.0f) + RMS_EPS);
#pragma unroll
                    for (int g = 0; g < 4; ++g) { const float* gp = mix_gain + (size_t)l * DM + 1536 + g * 128 + c0; bf16* op = mixed + (size_t)(row0 + t0 + i) * DM + 1536 + g * 128 + c0;
                        const u32x4 o = *(const u32x4*)op; const f32x4 g0 = *(const f32x4*)gp, g1 = *(const f32x4*)(gp + 4);
                        u32x4 w; w.x = pk2(bflo(o.x) * rr * g0.x, bfhi(o.x) * rr * g0.y); w.y = pk2(bflo(o.y) * rr * g0.z, bfhi(o.y) * rr * g0.w);
                        w.z = pk2(bflo(o.z) * rr * g1.x, bfhi(o.z) * rr * g1.y); w.w = pk2(bflo(o.w) * rr * g1.z, bfhi(o.w) * rr * g1.w);
                        *(u32x4*)op = w; }
                }
                __syncthreads();
            }
            }
        }
        SEAM(pb + 1);

        if (EN(3) && IN(pb + 2)) { PHASE_TID PHASE_PTRS
            for (int gi = bx * NTHR + tid; gi < 16 * 8192; gi += G * NTHR) {
                const int bh = gi >> 13, rem = gi & 8191, k = rem >> 6;
                f32x2 carry = (f32x2){0.f, 0.f};
                for (int c = 0; c < 32; ++c) {
                    f32x2* p = (f32x2*)(stateG + (size_t)(bh * 32 + c) * 16384) + rem;
                    const f32x2 tmp = *p; *p = carry; const float d = dendG[(size_t)(bh * 32 + c) * 128 + k]; carry = carry * d + tmp;
                }
            }
        }
        SEAM(pb + 2);

        for (int rep_ = 0; rep_ < REP(4); ++rep_)
        if (EN(4) && IN(pb + 3)) { PHASE_TID PHASE_PTRS
            for (int unit = bx; unit < 512; unit += G) {
                const int bh = unit >> 5, c = unit & 31, b = bh >> 2, h = bh & 3, row0 = b * SEQ + c * 128;
                LAS float* bT = (LAS float*)lds;
                LAS bf16* qT = (LAS bf16*)(lds + 67584);
                LAS bf16* kT = (LAS bf16*)(lds + 100352);
                LAS float* segtot = (LAS float*)(lds + 133120);
                LAS float* lbs = (LAS float*)(lds + 133120 + 2048);
                __syncthreads();
                if (tid < 128) { float lb = 0.f; if (l == 1) { const float a0 = lb_logits[h * 128 + tid], a1 = lb_logits[512 + h * 128 + tid]; lb = 1.0f / (1.0f + expf(a0 - a1)); } lbs[tid] = lb; }
                __syncthreads();
#pragma unroll
                for (int i = 0; i < 4; ++i) {
                    const int idx = tid + NTHR * i, t = idx >> 4, kg = idx & 15;
                    const bf16* rowp = proj + (size_t)(row0 + t) * DIN + h * 128 + kg * 8;
                    const u32x4 z8 = *(const u32x4*)(rowp + C_HF); const u32x4 q8 = *(const u32x4*)(rowp + C_HQ);
                    const unsigned zw[4] = {z8.x, z8.y, z8.z, z8.w}; const unsigned qw[4] = {q8.x, q8.y, q8.z, q8.w};
#pragma unroll
                    for (int j = 0; j < 4; ++j)
#pragma unroll
                        for (int q = 0; q < 2; ++q) {
                            const float z = q ? bfhi(zw[j]) : bflo(zw[j]); const float qv = q ? bfhi(qw[j]) : bflo(qw[j]); const int k = kg * 8 + j * 2 + q; const float lb = lbs[k];
                            const float ls = fminf(z, 0.f) - log1pf(expf(-fabsf(z)));
                            const float lf = (lb == 0.f) ? ls : logf(lb + (1.f - lb) * expf(ls));
                            bT[k * 132 + t] = lf * 1.4426950408889634f;
                            kT[k * 128 + t] = (bf16)f2bf((1.f - lb) / (1.f + expf(z)));
                            qT[k * 128 + t] = (bf16)f2bf(siluf_(qv));
                        }
                }
                __syncthreads();
                { const int k = tid & 127, seg = tid >> 7; float run = 0.f;
                    for (int tt = 0; tt < 32; ++tt) { const int t = seg * 32 + tt; run += bT[k * 132 + t]; bT[k * 132 + t] = run; }
                    segtot[seg * 128 + k] = run;
                    __syncthreads();
                    float off = 0.f;
#pragma unroll
                    for (int s = 0; s < 4; ++s) { const float v = segtot[s * 128 + k]; if (s < seg) off += v; }
                    if (seg > 0) for (int tt = 0; tt < 32; ++tt) { const int t = seg * 32 + tt; bT[k * 132 + t] += off; }
                }
                __syncthreads();
                const int tq = tid >> 4, sq = tid & 15, t0 = 4 * tq, s0 = 8 * sq;
                float sc[4][8];
#pragma unroll
                for (int i = 0; i < 4; ++i)
#pragma unroll
                    for (int j = 0; j < 8; ++j) sc[i][j] = 0.f;
                if (s0 <= t0 + 3) {
                    for (int k = 0; k < 128; ++k) {
                        const f32x4 bt = *(const LAS f32x4*)(bT + k * 132 + t0); const f32x4 bs0 = *(const LAS f32x4*)(bT + k * 132 + s0), bs1 = *(const LAS f32x4*)(bT + k * 132 + s0 + 4);
                        const u32x2 qw = *(const LAS u32x2*)(qT + k * 128 + t0); const u32x4 kw = *(const LAS u32x4*)(kT + k * 128 + s0);
                        const float qf[4] = {bflo(qw.x), bfhi(qw.x), bflo(qw.y), bfhi(qw.y)};
                        const float kf[8] = {bflo(kw.x), bfhi(kw.x), bflo(kw.y), bfhi(kw.y), bflo(kw.z), bfhi(kw.z), bflo(kw.w), bfhi(kw.w)};
                        const float bsf[8] = {bs0.x, bs0.y, bs0.z, bs0.w, bs1.x, bs1.y, bs1.z, bs1.w};
#pragma unroll
                        for (int i = 0; i < 4; ++i)
#pragma unroll
                            for (int j = 0; j < 8; ++j) sc[i][j] += qf[i] * kf[j] * __builtin_amdgcn_exp2f(fminf(bt[i] - bsf[j], 0.f));
                    }
                }
#pragma unroll
                for (int i = 0; i < 4; ++i)
#pragma unroll
                    for (int j = 0; j < 8; ++j) if (s0 + j > t0 + i) sc[i][j] = 0.f;
                __syncthreads();
                for (int i = 0; i < 32; ++i) { const int idx = tid + NTHR * i, k = idx >> 7, t = idx & 127; qT[idx] = (bf16)f2bf(bf2f(qT[idx]) * __builtin_amdgcn_exp2f(bT[k * 132 + t])); }
                __syncthreads();
#pragma unroll
                for (int j = 0; j < 8; ++j) *(LAS f32x4*)(bT + (s0 + j) * 132 + t0) = (f32x4){sc[0][j], sc[1][j], sc[2][j], sc[3][j]};
                LAS bf16* vb = kT;
#pragma unroll
                for (int i = 0; i < 4; ++i) { const int idx = tid + NTHR * i, t = idx >> 4, kg = idx & 15;
                    *(LAS u32x4*)(vb + t * 128 + kg * 8) = *(const u32x4*)(proj + (size_t)(row0 + t) * DIN + C_HI + h * 128 + kg * 8); }
                __syncthreads();
                { const int vq = sq, v0 = 8 * vq;
                    float acc[4][8];
#pragma unroll
                    for (int i = 0; i < 4; ++i)
#pragma unroll
                        for (int j = 0; j < 8; ++j) acc[i][j] = 0.f;
                    const float* stp = stateG + (size_t)(bh * 32 + c) * 16384 + v0;
                    for (int k = 0; k < 128; ++k) {
                        const u32x2 qw = *(const LAS u32x2*)(qT + k * 128 + t0); const f32x4 sa = *(const f32x4*)(stp + k * 128), sb = *(const f32x4*)(stp + k * 128 + 4);
                        const float qf[4] = {bflo(qw.x), bfhi(qw.x), bflo(qw.y), bfhi(qw.y)}; const float sf[8] = {sa.x, sa.y, sa.z, sa.w, sb.x, sb.y, sb.z, sb.w};
#pragma unroll
                        for (int i = 0; i < 4; ++i)
#pragma unroll
                            for (int j = 0; j < 8; ++j) acc[i][j] += qf[i] * sf[j];
                    }
                    for (int s = 0; s <= t0 + 3; ++s) {
                        const f32x4 s4 = *(const LAS f32x4*)(bT + s * 132 + t0); const u32x4 vw = *(const LAS u32x4*)(vb + s * 128 + v0);
                        const float vf[8] = {bflo(vw.x), bfhi(vw.x), bflo(vw.y), bfhi(vw.y), bflo(vw.z), bfhi(vw.z), bflo(vw.w), bfhi(vw.w)};
#pragma unroll
                        for (int i = 0; i < 4; ++i)
#pragma unroll
                            for (int j = 0; j < 8; ++j) acc[i][j] += s4[i] * vf[j];
                    }
                    const float* gp = mix_gain + (size_t)l * DM + h * 128 + v0;
#pragma unroll
                    for (int i = 0; i < 4; ++i) { float ss = 0.f;
#pragma unroll
                        for (int j = 0; j < 8; ++j) ss += acc[i][j] * acc[i][j];
                        ss += __shfl_xor(ss, 1); ss += __shfl_xor(ss, 2); ss += __shfl_xor(ss, 4); ss += __shfl_xor(ss, 8);
                        const float rr = 1.0f / sqrtf(ss * (1.0f / 128.0f) + RMS_EPS);
                        const u32x4 gw = *(const u32x4*)(proj + (size_t)(row0 + t0 + i) * DIN + C_HG + h * 128 + v0);
                        const float gf[8] = {bflo(gw.x), bfhi(gw.x), bflo(gw.y), bfhi(gw.y), bflo(gw.z), bfhi(gw.z), bflo(gw.w), bfhi(gw.w)};
                        unsigned w[4];
#pragma unroll
                        for (int j = 0; j < 4; ++j) w[j] = pk2(acc[i][2 * j] * rr * gp[2 * j] * siluf_(gf[2 * j]), acc[i][2 * j + 1] * rr * gp[2 * j + 1] * siluf_(gf[2 * j + 1]));
                        *(u32x4*)(mixed + (size_t)(row0 + t0 + i) * DM + h * 128 + v0) = (u32x4){w[0], w[1], w[2], w[3]}; }
                }
                __syncthreads();
            }
        }
        SEAM(pb + 3);

        if (EN(5) && IN(pb + 4)) { PHASE_PTRS
            pg8::PlainSched S; S.init(NTOK, DM, DM, G, bx, WLp + WL_OUT);
            pg8::EpiResF32 E{Hf, DM, ALPHA};
            pg8::gemm_phase<pg8::EpiResF32, pg8::PlainSched, true>(lds, (const char*)mixed, DM, S, E);
        }
        SEAM(pb + 4);

        if (EN(6) && IN(pb + 5)) { PHASE_TID PHASE_PTRS
            LAS float* xs = (LAS float*)lds;
            LAS int* selr = (LAS int*)(lds + 131072);
            LAS float* gatel = (LAS float*)(lds + 131072 + 4096);
            const float* rw = router_w + (size_t)l * DM * NE;
            for (int bi = bx; bi < NTOK / 16; bi += G) {
                const int tok0 = bi * 16;
                __syncthreads();
#pragma unroll
                for (int jt = 0; jt < 2; ++jt) { const int tl = wave * 2 + jt, tok = tok0 + tl;
                    f32x4 v[8];
#pragma unroll
                    for (int j = 0; j < 8; ++j) v[j] = ((const f32x4*)(Hf + (size_t)tok * DM))[j * 64 + lane];
                    ln_regs(v, ln1_g + (size_t)l * DM, ln1_b + (size_t)l * DM, lane);
                    store_row_f32(Hf + (size_t)tok * DM, v, lane); store_row_bf16(Hb + (size_t)tok * DM, v, lane);
#pragma unroll
                    for (int j = 0; j < 8; ++j) ((LAS f32x4*)(xs + tl * DM))[j * 64 + lane] = v[j];
                }
                __syncthreads();
                float acc[16];
#pragma unroll
                for (int t = 0; t < 16; ++t) acc[t] = 0.f;
                for (int k4 = 0; k4 < 64; ++k4) { const int k = wave * 256 + k4 * 4;
                    const float w0 = rw[(size_t)(k + 0) * NE + lane], w1 = rw[(size_t)(k + 1) * NE + lane], w2 = rw[(size_t)(k + 2) * NE + lane], w3 = rw[(size_t)(k + 3) * NE + lane];
#pragma unroll
                    for (int t = 0; t < 16; ++t) { const f32x4 x4 = *(const LAS f32x4*)(xs + t * DM + k); acc[t] += x4.x * w0 + x4.y * w1 + x4.z * w2 + x4.w * w3; }
                }
                __syncthreads();
#pragma unroll
                for (int t = 0; t < 16; ++t) xs[(wave * 16 + t) * 64 + lane] = acc[t];
                __syncthreads();
#pragma unroll
                for (int jt = 0; jt < 2; ++jt) { const int tl = wave * 2 + jt;
                    float logit = 0.f;
#pragma unroll
                    for (int w = 0; w < 8; ++w) logit += xs[(w * 16 + tl) * 64 + lane];
                    const float score = 1.0f / (1.0f + expf(-logit));
                    const float sel = score + router_b[l * NE + lane];
                    float m1 = sel; m1 = fmaxf(m1, __shfl_xor(m1, 1)); m1 = fmaxf(m1, __shfl_xor(m1, 2)); m1 = fmaxf(m1, __shfl_xor(m1, 4));
                    const unsigned long long bm = __ballot(sel == m1); const int grp = lane >> 3; const unsigned gbits = (unsigned)(bm >> (grp * 8)) & 0xffu; const int first = __builtin_ctz(gbits);
                    float s2 = ((lane & 7) == first) ? -INFINITY : sel; s2 = fmaxf(s2, __shfl_xor(s2, 1)); s2 = fmaxf(s2, __shfl_xor(s2, 2)); s2 = fmaxf(s2, __shfl_xor(s2, 4));
                    const float gs = m1 + s2;
                    int grank = 0;
#pragma unroll
                    for (int j = 0; j < 8; ++j) { const float gj = __shfl(gs, j * 8); grank += (gj > gs || (gj == gs && j < grp)) ? 1 : 0; }
                    const bool chosen = grank < 4;
                    const float msel = chosen ? sel : -INFINITY;
                    int rk = 0;
#pragma unroll 8
                    for (int j = 0; j < 64; ++j) { const float vj = __shfl(msel, j); rk += (vj > msel || (vj == msel && j < lane)) ? 1 : 0; }
                    const bool selected = chosen && rk < 8;
                    const float ssum = wave_sum(selected ? score : 0.f);
                    selr[tl * 64 + lane] = selected ? rk : -1; gatel[tl * 64 + lane] = score / ssum * ROUTED_SCALE;
                }
                __syncthreads();
                if (wave == 0) {
                    int cl = 0; int lp[16];
#pragma unroll
                    for (int t = 0; t < 16; ++t) { lp[t] = cl; cl += (selr[t * 64 + lane] >= 0) ? 1 : 0; }
                    int base = 0; if (cl > 0) base = (int)__hip_atomic_fetch_add(cntG + lane, (unsigned)cl, RLX_AGENT);
#pragma unroll
                    for (int t = 0; t < 16; ++t) { const int rk = selr[t * 64 + lane];
                        if (rk >= 0) { const int pos = base + lp[t]; list[lane * NTOK + pos] = tok0 + t; wlist[lane * NTOK + pos] = gatel[t * 64 + lane]; slot[(size_t)(tok0 + t) * 8 + rk] = (lane << 16) | pos; } }
                }
            }
        }
        SEAM(pb + 5);

        LAS int* const cnts = (LAS int*)(lds + TAB_OFF); LAS int* const tstart = cnts + 64; LAS int* const tile_e = cnts + 192;
        int ntiles = 0;
        if ((EN(7) && IN(pb + 6)) || (EN(8) && IN(pb + 7)) || (EN(9) && IN(pb + 8))) { PHASE_TID PHASE_PTRS
            __syncthreads();
            if (tid < 64) cnts[tid] = (int)__hip_atomic_load(cntG + tid, RLX_AGENT);
            __syncthreads();
            if (tid == 0) { int s = 0; for (int e = 0; e < 64; ++e) { tstart[e] = s; s += (cnts[e] + 255) >> 8; } tstart[64] = s; }
            __syncthreads();
            if (tid < 64) for (int t = tstart[tid]; t < tstart[tid + 1]; ++t) tile_e[t] = tid;
            __syncthreads();
            ntiles = __builtin_amdgcn_readfirstlane(tstart[64]); if (ntiles > MAXTILES) ntiles = MAXTILES;
        }

        for (int rep_ = 0; rep_ < REP(7); ++rep_)
        if (EN(7) && IN(pb + 6)) { PHASE_PTRS
            { pg8::MoeSched<true> S{cnts, tstart, tile_e, ntiles, 4, G, vcu, DM, list, WLp + WL_GU, W_GU_B};
              pg8::EpiSwiGLU E{Hs};
              pg8::gemm_phase<pg8::EpiSwiGLU, pg8::MoeSched<true>, true>(lds, (const char*)Hb, DM, S, E); }
            { pg8::PlainSched S; S.init(NTOK, 1024, DM, G, bx, WLp + WL_GU + 64 * W_GU_B);
              pg8::EpiSwiGLU E{Hs + (size_t)SH_ROW0 * DE};
              pg8::gemm_phase<pg8::EpiSwiGLU, pg8::PlainSched, true>(lds, (const char*)Hb, DM, S, E); }
        }
        SEAM(pb + 6);

        if (EN(8) && IN(pb + 7)) { PHASE_PTRS
#if !defined(HSEL) || HSEL == 1
            for (int rep_ = 0; rep_ < REP(8); ++rep_)
            { pg8::MoeSched<false> S{cnts, tstart, tile_e, ntiles, 8, G, vcu, DE, nullptr, WLp + WL_D, W_D_B};
              pg8::EpiDownY E{Yb, wlist};
              pg8::gemm_phase<pg8::EpiDownY, pg8::MoeSched<false>, true>(lds, (const char*)Hs, DE, S, E); }
#endif
#if !defined(HSEL) || HSEL == 2
            { pg8::PlainSched S; S.init(NTOK, DM, DE, G, bx, WLp + WL_D + 64 * W_D_B);
              pg8::EpiResF32 E{Hf, DM, ALPHA};
              pg8::gemm_phase<pg8::EpiResF32, pg8::PlainSched, true>(lds, (const char*)(Hs + (size_t)SH_ROW0 * DE), DE, S, E); }
#endif
        }
        SEAM(pb + 7);

        if (EN(9) && IN(pb + 8)) { PHASE_TID PHASE_PTRS
            const int gw = vcu * NWAVES + wave, NGW = G * NWAVES;
            for (int tok = gw; tok < NTOK; tok += NGW) {
                f32x4 v[8];
#pragma unroll
                for (int j = 0; j < 8; ++j) v[j] = ((const f32x4*)(Hf + (size_t)tok * DM))[j * 64 + lane];
                const int myslot = slot[(size_t)tok * 8 + (lane & 7)];
#pragma unroll
                for (int k = 0; k < 8; ++k) { const int sl = __shfl(myslot, k); const int e = sl >> 16, pos = sl & 0xffff; const size_t row = (size_t)tstart[e] * 256 + pos;
                    const u32x2* yp = (const u32x2*)(Yb + row * DM);
#pragma unroll
                    for (int j = 0; j < 8; ++j) { const u32x2 w = yp[j * 64 + lane]; v[j].x += bflo(w.x); v[j].y += bfhi(w.x); v[j].z += bflo(w.y); v[j].w += bfhi(w.y); } }
                ln_regs(v, ln2_g + (size_t)l * DM, ln2_b + (size_t)l * DM, lane);
                if (l == 0) { store_row_f32(Hf + (size_t)tok * DM, v, lane); store_row_bf16(Hb + (size_t)tok * DM, v, lane); }
                else store_row_f32(OUTP + (size_t)tok * DM, v, lane);
            }
        }
        SEAM(pb + 8);
    }
#undef IN
#undef SEAM
}

constexpr int NPHASES = 19;
#ifndef ONE_LAUNCH
#define ONE_LAUNCH 1
#endif

extern "C" void kernel_launch(void* const* d_in, const int* in_sizes, int n_in, void* d_out, int out_size, void* d_ws, size_t ws_size, hipStream_t stream) {
    static int grid = 0;
    if (grid == 0) {
        if (n_in != 25 || out_size != NTOK * DM || ws_size < WS_END) { fprintf(stderr, "kernel_launch: unexpected shapes: n_in %d out %d ws %zu (need %zu)\n", n_in, out_size, ws_size, (size_t)WS_END); grid = -1; return; }
        int dev = 0, cus = 0, per_cu = 0;
        if (hipGetDevice(&dev) != hipSuccess || hipDeviceGetAttribute(&cus, hipDeviceAttributeMultiprocessorCount, dev) != hipSuccess) { grid = -1; return; }
        if (hipFuncSetAttribute((const void*)fwd_kernel, hipFuncAttributeMaxDynamicSharedMemorySize, LDS_BYTES) != hipSuccess) { fprintf(stderr, "kernel_launch: hipFuncSetAttribute failed\n"); grid = -1; return; }
        if (hipOccupancyMaxActiveBlocksPerMultiprocessor(&per_cu, (const void*)fwd_kernel, NTHR, LDS_BYTES) != hipSuccess || per_cu < 1) fprintf(stderr, "kernel_launch: occupancy query reports %d\n", per_cu);
        (void)hipGetLastError();
        grid = cus;
    }
    if (grid < 0) return;
    if (hipMemsetAsync((char*)d_ws + WS_CTL, 0, CTL_ZERO_BYTES, stream) != hipSuccess) return;
    Args a{};
    for (int i = 0; i < 25; ++i) a.in[i] = (const float*)d_in[i];
    a.out = (float*)d_out; a.ws = (unsigned char*)d_ws; a.pad = 0;
#if ONE_LAUNCH
    a.ph_lo = 0; a.ph_hi = NPHASES; a.use_bar = 1;
    hipLaunchKernelGGL(fwd_kernel, dim3(grid), dim3(NTHR), LDS_BYTES, stream, a);
#else
    for (int p = 0; p < NPHASES; ++p) { a.ph_lo = p; a.ph_hi = p + 1; a.use_bar = 0; hipLaunchKernelGGL(fwd_kernel, dim3(grid), dim3(NTHR), LDS_BYTES, stream, a); }
#endif
}
```

```cpp
#include <hip/hip_runtime.h>
#include <cstdio>
#include <cstdint>

#define GAS __attribute__((address_space(1)))
#define LAS __attribute__((address_space(3)))
typedef unsigned short bf16;
typedef unsigned short bf16_t;
typedef short bf16x8 __attribute__((ext_vector_type(8)));
typedef float f32x4 __attribute__((ext_vector_type(4)));
typedef float f32x2 __attribute__((ext_vector_type(2)));
typedef unsigned u32x4 __attribute__((ext_vector_type(4)));
typedef unsigned u32x2 __attribute__((ext_vector_type(2)));

constexpr int NTOK = 16384, DM = 2048, DIN = 4352, SEQ = 4096, NBATCH = 4;
constexpr int NE = 64, TOPK = 8, DE = 512;
constexpr float ALPHA = 1.4142135623730951f, LN_EPS = 1e-5f, RMS_EPS = 1e-6f, ROUTED_SCALE = 2.5f;
constexpr int C_HQ = 0, C_HF = 512, C_HI = 1024, C_HG = 1536, C_AQ = 2048, C_AK = 3072, C_AV = 3200, C_SU = 3328, C_SV = 3840;
constexpr int MAXTILES = 576;
constexpr int SH_ROW0 = MAXTILES * 256;
constexpr int HS_ROWS = SH_ROW0 + NTOK;

constexpr size_t MiB = 1u << 20;
constexpr size_t WS_CTL = 0, CTL_ZERO_BYTES = 1 * MiB;
constexpr size_t WS_LIST = 1 * MiB;
constexpr size_t WS_WLIST = 5 * MiB;
constexpr size_t WS_SLOT = 9 * MiB;
constexpr size_t WS_DEND = 10 * MiB;
constexpr size_t WS_STATE = 16 * MiB;
constexpr size_t WS_HF = 64 * MiB;
constexpr size_t WS_HB = 192 * MiB;
constexpr size_t WS_PROJ = 256 * MiB;
constexpr size_t WS_MIXED = 392 * MiB;
constexpr size_t WS_HS = 456 * MiB;
constexpr size_t WS_Y = 616 * MiB;
constexpr size_t WS_W = 1192 * MiB;
constexpr size_t W_IN_B = (size_t)DIN * DM * 2, W_OUT_B = (size_t)DM * DM * 2, W_GU_B = (size_t)1024 * DM * 2, W_D_B = (size_t)DM * DE * 2;
constexpr size_t WL_IN = 0, WL_OUT = W_IN_B, WL_GU = WL_OUT + W_OUT_B, WL_D = WL_GU + 65 * W_GU_B, WL_BYTES = WL_D + 65 * W_D_B;
constexpr size_t WS_END = WS_W + 2 * WL_BYTES;
static_assert(WS_HS + (size_t)HS_ROWS * 512 * 2 <= WS_Y && WS_Y + (size_t)MAXTILES * 256 * DM * 2 <= WS_W && WS_END <= 2048 * MiB, "d_ws map");
constexpr int CW_CNT = 64;
constexpr int CW_BAR = 4096;

constexpr int LDS_BYTES = 147456;
constexpr int MISC_OFF = LDS_BYTES - 256;
constexpr int TAB_OFF = 131072;
constexpr int NWAVES = 8, NTHR = 512;

#define LDS_WAIT() asm volatile("s_waitcnt lgkmcnt(0)" ::: "memory")
#define VM_WAIT() asm volatile("s_waitcnt vmcnt(0)" ::: "memory")
#define RLX_AGENT __ATOMIC_RELAXED, __HIP_MEMORY_SCOPE_AGENT

__device__ __forceinline__ unsigned f2bf(float f) { unsigned u = __builtin_bit_cast(unsigned, f); return (u + 0x7fffu + ((u >> 16) & 1u)) >> 16; }
__device__ __forceinline__ unsigned pk2(float lo, float hi) { return f2bf(lo) | (f2bf(hi) << 16); }
__device__ __forceinline__ float bflo(unsigned w) { return __uint_as_float(w << 16); }
__device__ __forceinline__ float bfhi(unsigned w) { return __uint_as_float(w & 0xffff0000u); }
__device__ __forceinline__ float bf2f(bf16 v) { return __uint_as_float((unsigned)v << 16); }
__device__ __forceinline__ float wave_sum(float v) {
#pragma unroll
    for (int o = 1; o < 64; o <<= 1) v += __shfl_xor(v, o);
    return v;
}
__device__ __forceinline__ int tid_of_wave(int wave) {
    int l; asm volatile("v_mbcnt_lo_u32_b32 %0, -1, 0\n\tv_mbcnt_hi_u32_b32 %0, -1, %0" : "=v"(l)); return wave * 64 + l; }
__device__ __forceinline__ float sigmoidf_(float x) { return 1.0f / (1.0f + __expf(-x)); }
__device__ __forceinline__ float siluf_(float x) { return x / (1.0f + __expf(-x)); }
__device__ __forceinline__ float geluf_(float x) { return 0.5f * x * (1.0f + erff(x * 0.70710678118654752f)); }

namespace pg8 {
#define PG8_LAS __attribute__((address_space(3)))
constexpr int BM = 256, BK = 64, HALF = 128, HTB = HALF * BK * 2, STAGE_BYTES = 8 * HTB, NXCD = 8, WGM = 8;
__host__ __device__ __forceinline__ int lds_byte(int r, int c) { const int st = (r >> 4) * 2 + (c >> 5), rr = r & 15, cc = c & 31, ob = rr * 64 + cc * 2; return st * 1024 + (ob ^ (((ob >> 9) & 1) << 5)); }
__host__ __device__ __forceinline__ void stage_rc(int b, int& R, int& C) { const int st = b / 1024, sb = b % 1024, swz = sb ^ (((sb >> 9) & 1) << 5); R = (st >> 1) * 16 + swz / 64; C = (st & 1) * 32 + (swz % 64) / 2; }
__host__ __device__ __forceinline__ int perm32(int rho) { const int n = rho >> 4, i = rho & 15; return 8 * (i >> 2) + 4 * n + (i & 3); }

struct Unit { int pm, pn, e, p0, nv; };

__device__ __forceinline__ unsigned cvt_pk_bf16(float lo, float hi) { unsigned r; asm volatile("v_cvt_pk_bf16_f32 %0, %1, %2" : "=v"(r) : "v"(lo), "v"(hi)); return r; }

struct PlainSched {
    static constexpr bool GATHER = false;
    int nM, nN, nwg, G, c, K; const char* Bt;
    __device__ void init(int M, int N, int K_, int G_, int c_, const void* Bt_) { nM = M / BM; nN = N / BM; nwg = nM * nN; G = G_; c = c_; K = K_; Bt = (const char*)Bt_; }
    __device__ __forceinline__ bool next(int i, Unit& u) const {
        const long L = (long)i * G + c; if (L >= nwg) return false;
        int wgid = (int)L; { const int q = nwg / NXCD, r = nwg % NXCD, xcd = wgid % NXCD, off = wgid / NXCD; wgid = (xcd < r ? xcd * (q + 1) : r * (q + 1) + (xcd - r) * q) + off; }
        const int nig = WGM * nN, gid = wgid / nig, fm = gid * WGM, gsz = (nM - fm) < WGM ? (nM - fm) : WGM;
        u.pm = fm + ((wgid % nig) % gsz); u.pn = (wgid % nig) / gsz; u.e = 0; u.p0 = 0; u.nv = 256; return true;
    }
    __device__ __forceinline__ unsigned arow(const Unit& u, int r) const { return 0u; }
    __device__ __forceinline__ size_t aoff(const Unit& u) const { return (size_t)u.pm * BM * K * 2; }
    __device__ __forceinline__ const char* bbase(const Unit& u) const { return Bt + (size_t)u.pn * BM * K * 2; }
};
template <bool GATHER_> struct MoeSched {
    static constexpr bool GATHER = GATHER_;
    const PG8_LAS int* cnts; const PG8_LAS int* tstart; const PG8_LAS int* tile_e;
    int ntiles, npn, G, vcu, K; const int* list; const char* Bt; size_t estride;
    __device__ __forceinline__ bool next(int i, Unit& u) const {
        const int U = i * G + vcu; if (U >= ntiles * npn) return false;
        u.pm = U / npn; u.pn = U % npn; u.e = __builtin_amdgcn_readfirstlane(tile_e[u.pm]); u.p0 = (u.pm - __builtin_amdgcn_readfirstlane(tstart[u.e])) * BM; const int rem = __builtin_amdgcn_readfirstlane(cnts[u.e]) - u.p0; u.nv = rem < BM ? rem : BM; return true;
    }
    __device__ __forceinline__ unsigned arow(const Unit& u, int r) const { const int tok = (r < u.nv) ? list[u.e * NTOK + u.p0 + r] : 0; return (unsigned)tok * (unsigned)(K * 2); }
    __device__ __forceinline__ size_t aoff(const Unit& u) const { return (size_t)u.pm * BM * K * 2; }
    __device__ __forceinline__ const char* bbase(const Unit& u) const { return Bt + (size_t)u.e * estride + (size_t)u.pn * BM * K * 2; }
};

struct EpiBf16Bias {
    static constexpr bool PERM = true;
    bf16_t* O; int ldc; const float* bias;
    __device__ __forceinline__ void operator()(const f32x4 (&acc)[2][2][4][2], const Unit& u, int wr, int wc, int fr, int fq) const {
        const int row0 = u.pm * BM + wr * 64 + fr, col0 = u.pn * BM + wc * 32 + 8 * fq;
        f32x4 bv[2][2];
#pragma unroll
        for (int bj = 0; bj < 2; ++bj)
#pragma unroll
            for (int n = 0; n < 2; ++n) bv[bj][n] = *(const f32x4*)(bias + col0 + bj * HALF + 4 * n);
#pragma unroll
        for (int ai = 0; ai < 2; ++ai)
#pragma unroll
            for (int m = 0; m < 4; ++m) { bf16_t* rowp = O + (size_t)(row0 + ai * HALF + m * 16) * ldc + col0;
#pragma unroll
                for (int bj = 0; bj < 2; ++bj) { const f32x4 v0 = acc[ai][bj][m][0] + bv[bj][0], v1 = acc[ai][bj][m][1] + bv[bj][1];
                    u32x4 w; w.x = cvt_pk_bf16(v0[0], v0[1]); w.y = cvt_pk_bf16(v0[2], v0[3]); w.z = cvt_pk_bf16(v1[0], v1[1]); w.w = cvt_pk_bf16(v1[2], v1[3]);
                    *(u32x4*)(rowp + bj * HALF) = w; } }
    }
};
struct EpiResF32 {
    static constexpr bool PERM = false;
    float* C; int ldc; float alpha;
    __device__ __forceinline__ void operator()(const f32x4 (&acc)[2][2][4][2], const Unit& u, int wr, int wc, int fr, int fq) const {
        const int row0 = u.pm * BM + wr * 64 + fr, col0 = u.pn * BM + wc * 32 + 4 * fq;
#pragma unroll
        for (int ai = 0; ai < 2; ++ai)
#pragma unroll
            for (int m = 0; m < 4; ++m) { float* rowp = C + (size_t)(row0 + ai * HALF + m * 16) * ldc + col0;
#pragma unroll
                for (int bj = 0; bj < 2; ++bj)
#pragma unroll
                    for (int n = 0; n < 2; ++n) { f32x4* p = (f32x4*)(rowp + bj * HALF + n * 16); const f32x4 o = *p; *p = o * alpha + acc[ai][bj][m][n]; } }
    }
};
struct EpiSwiGLU {
    static constexpr bool PERM = true;
    bf16_t* O;
    __device__ __forceinline__ void operator()(const f32x4 (&acc)[2][2][4][2], const Unit& u, int wr, int wc, int fr, int fq) const {
        const int row0 = u.pm * BM + wr * 64 + fr, col0 = u.pn * HALF + wc * 32 + 8 * fq;
#pragma unroll
        for (int ai = 0; ai < 2; ++ai)
#pragma unroll
            for (int m = 0; m < 4; ++m) { bf16_t* rowp = O + (size_t)(row0 + ai * HALF + m * 16) * DE + col0;
                float o[8];
#pragma unroll
                for (int n = 0; n < 2; ++n)
#pragma unroll
                    for (int j = 0; j < 4; ++j) { const float g = acc[ai][0][m][n][j], up = acc[ai][1][m][n][j]; o[n * 4 + j] = g / (1.0f + __expf(-g)) * up; }
                u32x4 w; w.x = cvt_pk_bf16(o[0], o[1]); w.y = cvt_pk_bf16(o[2], o[3]); w.z = cvt_pk_bf16(o[4], o[5]); w.w = cvt_pk_bf16(o[6], o[7]);
                *(u32x4*)rowp = w; }
    }
};
struct EpiDownY {
    static constexpr bool PERM = true;
    bf16_t* Y; const float* wlist;
    __device__ __forceinline__ void operator()(const f32x4 (&acc)[2][2][4][2], const Unit& u, int wr, int wc, int fr, int fq) const {
        const int rl0 = wr * 64 + fr, col0 = u.pn * BM + wc * 32 + 8 * fq;
#pragma unroll
        for (int ai = 0; ai < 2; ++ai)
#pragma unroll
            for (int m = 0; m < 4; ++m) { const int rl = rl0 + ai * HALF + m * 16; const float w8 = (rl < u.nv) ? wlist[u.e * NTOK + u.p0 + rl] : 0.f;
                bf16_t* rowp = Y + (size_t)(u.pm * BM + rl) * DM + col0;
#pragma unroll
                for (int bj = 0; bj < 2; ++bj) { const f32x4 v0 = acc[ai][bj][m][0] * w8, v1 = acc[ai][bj][m][1] * w8;
                    u32x4 w; w.x = cvt_pk_bf16(v0[0], v0[1]); w.y = cvt_pk_bf16(v0[2], v0[3]); w.z = cvt_pk_bf16(v1[0], v1[1]); w.w = cvt_pk_bf16(v1[2], v1[3]);
                    *(u32x4*)(rowp + bj * HALF) = w; } }
    }
};

template <class Epi, class Sched, bool ALIGN_EPI>
__device__ __forceinline__ void gemm_phase(PG8_LAS unsigned char* lds, const char* Abase, const int K, const Sched& S, const Epi& E, const int wave_s) {
    int tid_ = tid_of_wave(wave_s); asm volatile("" : "+v"(tid_));
    const int tid = tid_, wid = __builtin_amdgcn_readfirstlane(tid >> 6), lane = tid & 63, wr = wid >> 2, wc = wid & 3, fr = lane & 15, fq = lane >> 4;
    const int nt = K / BK;
    int RA[2]; unsigned CA2[2], voffB[2];
#pragma unroll
    for (int i = 0; i < 2; ++i) { int R, C; stage_rc(tid * 16 + i * 8192, R, C); const int Rb = Epi::PERM ? ((R & ~31) + perm32(R & 31)) : R;
        RA[i] = R; CA2[i] = (unsigned)C * 2u; voffB[i] = (unsigned)(Rb * K + C) * 2u; }
    const size_t kstep = (size_t)(BK * 2);
    const size_t hstep = (size_t)HALF * K * 2;
    const unsigned ldsw = (unsigned)wid * 1024u;
    const int aoff = lds_byte(wr * 64 + fr, fq * 8), boff = lds_byte(wc * 32 + fr, fq * 8);
#define PG8_SA(b, h) (((b) * 2 + (h)) * HTB)
#define PG8_SB(b, h) ((4 + (b) * 2 + (h)) * HTB)
#define PG8_STAGE(bufoff, gbase, voff) do { _Pragma("unroll") for (int _i = 0; _i < 2; ++_i) \
        __builtin_amdgcn_global_load_lds((const unsigned*)((const char*)(gbase) + (voff)[_i]), (PG8_LAS unsigned*)(lds + (bufoff) + ldsw + _i * 8192), 16, 0, 0); } while (0)
#define PG8_LDA(dst, b, h) do { _Pragma("unroll") for (int m = 0; m < 4; ++m) _Pragma("unroll") for (int k = 0; k < 2; ++k) dst[m][k] = *(const PG8_LAS bf16x8*)(lds + PG8_SA(b, h) + aoff + m * 2048 + k * 1024); } while (0)
#define PG8_LDB(dst, b, h) do { _Pragma("unroll") for (int n = 0; n < 2; ++n) _Pragma("unroll") for (int k = 0; k < 2; ++k) dst[n][k] = *(const PG8_LAS bf16x8*)(lds + PG8_SB(b, h) + boff + n * 2048 + k * 1024); } while (0)
#define PG8_MMA(ai, bj, At, Bt) do { __builtin_amdgcn_s_setprio(1); _Pragma("unroll") for (int m = 0; m < 4; ++m) _Pragma("unroll") for (int n = 0; n < 2; ++n) _Pragma("unroll") for (int k = 0; k < 2; ++k) \
        acc[ai][bj][m][n] = __builtin_amdgcn_mfma_f32_16x16x32_bf16(Bt[n][k], At[m][k], acc[ai][bj][m][n], 0, 0, 0); __builtin_amdgcn_s_setprio(0); } while (0)
#define PG8_WAIT_V(n) asm volatile("s_waitcnt vmcnt(" #n ")" ::: "memory")
#define PG8_WAIT_L(n) asm volatile("s_waitcnt lgkmcnt(" #n ")" ::: "memory")
#define PG8_BAR __builtin_amdgcn_s_barrier()
#define PG8_SCHED __builtin_amdgcn_sched_barrier(0)
    Unit cur, nxt; int ui = 0;
    if (!S.next(0, cur)) return;
    f32x4 acc[2][2][4][2];
#pragma unroll
    for (int a = 0; a < 2; ++a)
#pragma unroll
        for (int b = 0; b < 2; ++b)
#pragma unroll
            for (int m = 0; m < 4; ++m)
#pragma unroll
                for (int n = 0; n < 2; ++n) acc[a][b][m][n] = (f32x4){0.f, 0.f, 0.f, 0.f};
    bf16x8 At[4][2], B0[2][2], B1[2][2];
    unsigned voffA[2], ca0[2], ca1[2], na0[2], na1[2];
#pragma unroll
    for (int i = 0; i < 2; ++i) { voffA[i] = (unsigned)(RA[i] * K) * 2u + CA2[i]; ca0[i] = ca1[i] = na0[i] = na1[i] = 0u; }
    const char* cA = Abase; const char* cB = S.bbase(cur);
    if constexpr (Sched::GATHER) {
#pragma unroll
        for (int i = 0; i < 2; ++i) { ca0[i] = S.arow(cur, RA[i]) + CA2[i]; ca1[i] = S.arow(cur, HALF + RA[i]) + CA2[i]; }
    } else cA = Abase + S.aoff(cur);
#define PG8_STAGE_A(bufoff, p, h, g0, g1) do { if constexpr (Sched::GATHER) { if ((h) == 0) PG8_STAGE(bufoff, p, g0); else PG8_STAGE(bufoff, p, g1); } \
        else { PG8_STAGE(bufoff, (p) + (h) * hstep, voffA); } } while (0)
    PG8_STAGE(PG8_SB(0, 0), cB, voffB); PG8_STAGE(PG8_SB(0, 1), cB + hstep, voffB); PG8_STAGE_A(PG8_SA(0, 0), cA, 0, ca0, ca1); PG8_STAGE_A(PG8_SA(0, 1), cA, 1, ca0, ca1);
    if (wr == 1) PG8_BAR;
    PG8_WAIT_V(2); PG8_BAR;
    PG8_STAGE(PG8_SB(1, 0), cB + kstep, voffB); PG8_STAGE_A(PG8_SA(1, 0), cA + kstep, 0, ca0, ca1); PG8_STAGE(PG8_SB(1, 1), cB + hstep + kstep, voffB);
    PG8_WAIT_V(6); PG8_BAR;
    for (;;) {
        const bool has_next = S.next(ui + 1, nxt);
        const char* nA = cA; const char* nB = has_next ? S.bbase(nxt) : cB;
        if constexpr (Sched::GATHER) {
            if (has_next) {
#pragma unroll
                for (int i = 0; i < 2; ++i) { na0[i] = S.arow(nxt, RA[i]) + CA2[i]; na1[i] = S.arow(nxt, HALF + RA[i]) + CA2[i]; }
            } else {
#pragma unroll
                for (int i = 0; i < 2; ++i) { na0[i] = ca0[i]; na1[i] = ca1[i]; }
            }
        } else { if (has_next) nA = Abase + S.aoff(nxt); }
        for (int t = 0; t < nt; t += 2) {
            const bool last = (t == nt - 2);
            const char* a1 = cA + (size_t)(t + 1) * kstep;
            const char* a2 = last ? nA : cA + (size_t)(t + 2) * kstep; const char* b2 = last ? nB : cB + (size_t)(t + 2) * kstep;
            const char* a3 = a2 + kstep; const char* b3 = b2 + kstep;
            unsigned s0[2], s1[2];
#pragma unroll
            for (int i = 0; i < 2; ++i) { s0[i] = last ? na0[i] : ca0[i]; s1[i] = last ? na1[i] : ca1[i]; }
            PG8_LDB(B0, 0, 0); PG8_LDB(B1, 0, 1); PG8_SCHED; PG8_LDA(At, 0, 0); PG8_STAGE_A(PG8_SA(1, 1), a1, 1, ca0, ca1);
            PG8_WAIT_V(8); PG8_WAIT_L(0); PG8_BAR; PG8_MMA(0, 0, At, B0); PG8_MMA(0, 1, At, B1); PG8_BAR; PG8_SCHED;
            PG8_LDA(At, 0, 1); PG8_STAGE(PG8_SB(0, 0), b2, voffB); PG8_STAGE(PG8_SB(0, 1), b2 + hstep, voffB); PG8_STAGE_A(PG8_SA(0, 0), a2, 0, s0, s1);
            PG8_WAIT_V(8); PG8_WAIT_L(0); PG8_BAR; PG8_MMA(1, 0, At, B0); PG8_MMA(1, 1, At, B1); PG8_BAR; PG8_SCHED;
            PG8_LDB(B0, 1, 0); PG8_LDB(B1, 1, 1); PG8_SCHED; PG8_LDA(At, 1, 0); PG8_STAGE_A(PG8_SA(0, 1), a2, 1, s0, s1);
            PG8_WAIT_V(8); PG8_WAIT_L(0); PG8_BAR; PG8_MMA(0, 0, At, B0); PG8_MMA(0, 1, At, B1); PG8_BAR; PG8_SCHED;
            PG8_LDA(At, 1, 1); PG8_STAGE(PG8_SB(1, 0), b3, voffB); PG8_STAGE(PG8_SB(1, 1), b3 + hstep, voffB); PG8_STAGE_A(PG8_SA(1, 0), a3, 0, s0, s1);
            PG8_WAIT_V(8); PG8_WAIT_L(0); PG8_BAR; PG8_MMA(1, 0, At, B0); PG8_MMA(1, 1, At, B1); PG8_BAR; PG8_SCHED;
        }
        if constexpr (ALIGN_EPI) { if (wr == 0) PG8_BAR; }
        E(acc, cur, wr, wc, fr, fq);
        if (!has_next) break;
#pragma unroll
        for (int a = 0; a < 2; ++a)
#pragma unroll
            for (int b = 0; b < 2; ++b)
#pragma unroll
                for (int m = 0; m < 4; ++m)
#pragma unroll
                    for (int n = 0; n < 2; ++n) acc[a][b][m][n] = (f32x4){0.f, 0.f, 0.f, 0.f};
        cur = nxt; cA = nA; cB = nB; ++ui;
        if constexpr (Sched::GATHER) {
#pragma unroll
            for (int i = 0; i < 2; ++i) { ca0[i] = na0[i]; ca1[i] = na1[i]; }
        }
        if constexpr (ALIGN_EPI) { if (wr == 1) PG8_BAR; }
    }
    PG8_WAIT_V(0);
    if constexpr (!ALIGN_EPI) { if (wr == 0) PG8_BAR; }
    PG8_BAR;
#undef PG8_SA
#undef PG8_SB
#undef PG8_STAGE
#undef PG8_LDA
#undef PG8_LDB
#undef PG8_MMA
#undef PG8_WAIT_V
#undef PG8_WAIT_L
#undef PG8_BAR
#undef PG8_SCHED
#undef PG8_STAGE_A
}
}

#define XB_TMO      128
#define XB_XCNT(j)  (256  + 64 * (j))
#define XB_XSUB(j)  (1280 + 64 * (j))
#define XB_XGEN(j)  (2304 + 64 * (j))
#define XB_TOP      3328
#define XB_TOPGEN   3392
#define XCD_BAR_WORDS 3456
#define XB_SPIN_CAP (1u << 18)
__device__ __forceinline__ unsigned xb_ld(unsigned* p)              { return __hip_atomic_load(p, __ATOMIC_RELAXED, __HIP_MEMORY_SCOPE_AGENT); }
__device__ __forceinline__ unsigned xb_add(unsigned* p, unsigned v) { return __hip_atomic_fetch_add(p, v, __ATOMIC_RELAXED, __HIP_MEMORY_SCOPE_AGENT); }
__device__ __forceinline__ unsigned xb_xcc_id() { return (unsigned)__builtin_amdgcn_s_getreg((3 << 11) | 20) & 0xFu; }
#define XB_SPIN(cond, bar) do { unsigned _sp = 0; while (cond) { __builtin_amdgcn_s_sleep(1); \
    if ((++_sp & 255u) == 0u) { if (xb_ld(&(bar)[XB_TMO])) break; if (_sp > XB_SPIN_CAP) { atomicAdd(&(bar)[XB_TMO], 1u); break; } } } } while (0)
struct XcdBarrier { unsigned* bar; unsigned x; volatile LAS unsigned* st; };
__device__ __forceinline__ XcdBarrier xcd_barrier_post(unsigned* bar, volatile LAS unsigned* st) {
    XcdBarrier b; b.bar = bar; b.x = xb_xcc_id(); b.st = st;
    if (threadIdx.x == 0) (void)xb_add(&bar[XB_XCNT(b.x)], 1u);
    return b;
}
__device__ __forceinline__ void xcd_barrier_complete(unsigned* bar, unsigned x, unsigned& nloc, unsigned& nx) {
    const unsigned G = gridDim.x * gridDim.y * gridDim.z;
    unsigned sum, cnt, mine, sp = 0u;
    for (;;) {
        sum = 0u; cnt = 0u; mine = 0u;
#pragma unroll
        for (unsigned j = 0; j < 16; ++j) { const unsigned c = xb_ld(&bar[XB_XCNT(j)]); sum += c; cnt += (c > 0u) ? 1u : 0u; mine = (j == x) ? c : mine; }
        if (sum == G) break;
        __builtin_amdgcn_s_sleep(1);
        if ((++sp & 255u) == 0u) { if (xb_ld(&bar[XB_TMO])) break; if (sp > XB_SPIN_CAP) { atomicAdd(&bar[XB_TMO], 1u); break; } }
    }
    nloc = mine > 0u ? mine : 1u; nx = cnt > 0u ? cnt : 1u;
}
__device__ __forceinline__ void xcd_barrier(const XcdBarrier& b, const int wave_s) {
    asm volatile("s_waitcnt vmcnt(0)" ::: "memory");
    __syncthreads();
    if (tid_of_wave(wave_s) == 0) {
        unsigned* bar = b.bar;
        __builtin_amdgcn_s_waitcnt(0);
        unsigned nloc = b.st[0], nx = b.st[1];
        if (nloc == 0u) { xcd_barrier_complete(bar, b.x, nloc, nx); b.st[0] = nloc; b.st[1] = nx; }
        const unsigned old = xb_add(&bar[XB_XSUB(b.x)], 1u);
        const unsigned gen = old / nloc;
        if (old + 1u == (gen + 1u) * nloc) {
            __builtin_amdgcn_fence(__ATOMIC_RELEASE, "agent");
            asm volatile("s_waitcnt vmcnt(0)" ::: "memory");
            const unsigned og = xb_add(&bar[XB_TOP], 1u);
            const unsigned tg = og / nx;
            if (og + 1u == (tg + 1u) * nx) xb_add(&bar[XB_TOPGEN], 1u);
            else XB_SPIN(xb_ld(&bar[XB_TOPGEN]) == tg, bar);
            __builtin_amdgcn_fence(__ATOMIC_ACQUIRE, "agent");
            xb_add(&bar[XB_XGEN(b.x)], 1u);
            asm volatile("s_waitcnt vmcnt(0)" ::: "memory");
        } else {
            XB_SPIN(xb_ld(&bar[XB_XGEN(b.x)]) == gen, bar);
            __builtin_amdgcn_fence(__ATOMIC_ACQUIRE, "agent");
            asm volatile("s_waitcnt vmcnt(0)" ::: "memory");
        }
    }
    __syncthreads();
}

struct Args { const float* in[25]; float* out; unsigned char* ws; int ph_lo, ph_hi, use_bar, pad; };
struct Frame {
    LAS unsigned char* lds; unsigned* ctl; int tid, lane, wave, vcu, G;
    const float* const* in_;
};

__device__ __forceinline__ void transpose_item(const float* W, int K, int N, bf16* WT, int mode, LAS float* scr, int item, int lane) {
    const int nblk = N / 32, kb = item / nblk, nb = item % nblk, k0 = 64 * kb, n0 = 32 * nb;
#pragma unroll 8
    for (int i = 0; i < 32; ++i) { const int kk = 2 * i + (lane >> 5); scr[kk * 33 + (lane & 31)] = W[(size_t)(k0 + kk) * N + n0 + (lane & 31)]; }
    LDS_WAIT(); asm volatile("" ::: "memory");
    const int r0 = mode ? ((n0 >> 7) * 256 + (n0 & 127) + (mode == 2 ? 128 : 0)) : n0;
    const int c = lane & 7;
#pragma unroll
    for (int j = 0; j < 4; ++j) { const int n = (lane >> 3) + 8 * j; const LAS float* s = scr + (8 * c) * 33 + n;
        u32x4 o; o.x = pk2(s[0 * 33], s[1 * 33]); o.y = pk2(s[2 * 33], s[3 * 33]); o.z = pk2(s[4 * 33], s[5 * 33]); o.w = pk2(s[6 * 33], s[7 * 33]);
        *(u32x4*)(WT + (size_t)(r0 + n) * K + k0 + 8 * c) = o; }
    LDS_WAIT(); asm volatile("" ::: "memory");
}
constexpr int IT_IN = (DM / 64) * (DIN / 32), IT_OUT = (DM / 64) * (DM / 32), IT_G = (DM / 64) * (DE / 32), IT_D = (DE / 64) * (DM / 32);
constexpr int IT_LAYER = IT_IN + IT_OUT + 65 * (2 * IT_G + IT_D);

__device__ __forceinline__ void ln_regs(f32x4 (&v)[8], const float* gain, const float* bias, int lane) {
    float s = 0.f;
#pragma unroll
    for (int j = 0; j < 8; ++j) s += (v[j].x + v[j].y) + (v[j].z + v[j].w);
    const float mean = wave_sum(s) * (1.f / DM); float s2 = 0.f;
#pragma unroll
    for (int j = 0; j < 8; ++j) { v[j] = v[j] - mean; s2 += (v[j].x * v[j].x + v[j].y * v[j].y) + (v[j].z * v[j].z + v[j].w * v[j].w); }
    const float rstd = 1.f / sqrtf(wave_sum(s2) * (1.f / DM) + LN_EPS);
#pragma unroll
    for (int j = 0; j < 8; ++j) { const f32x4 g = ((const f32x4*)gain)[j * 64 + lane], b = ((const f32x4*)bias)[j * 64 + lane]; v[j] = v[j] * rstd * g + b; }
}
__device__ __forceinline__ void store_row_f32(float* dst, const f32x4 (&v)[8], int lane) {
#pragma unroll
    for (int j = 0; j < 8; ++j) ((f32x4*)dst)[j * 64 + lane] = v[j];
}
__device__ __forceinline__ void store_row_bf16(bf16* dst, const f32x4 (&v)[8], int lane) {
#pragma unroll
    for (int j = 0; j < 8; ++j) { u32x2 w; w.x = pk2(v[j].x, v[j].y); w.y = pk2(v[j].z, v[j].w); ((u32x2*)dst)[j * 64 + lane] = w; }
}


typedef float f32x16 __attribute__((ext_vector_type(16)));
#define MFMA32(a, b, c) __builtin_amdgcn_mfma_f32_32x32x16_bf16((a), (b), (c), 0, 0, 0)
__device__ __forceinline__ int krow16(int r, int h) { return (r & 3) + 8 * (r >> 2) + 4 * h; }
__device__ __forceinline__ bf16x8 pack8(const f32x16& x, int s) {
    u32x4 p; p.x = pk2(x[8 * s], x[8 * s + 1]); p.y = pk2(x[8 * s + 2], x[8 * s + 3]); p.z = pk2(x[8 * s + 4], x[8 * s + 5]); p.w = pk2(x[8 * s + 6], x[8 * s + 7]);
    return __builtin_bit_cast(bf16x8, p);
}
constexpr int SWA_KS_BYTES = 192 * 128, SWA_VT_STRIDE = 196, SWA_VT_BYTES = 64 * SWA_VT_STRIDE * 2;
__device__ __forceinline__ void swa_unit(LAS unsigned char* lds, const bf16* projp, bf16* mixedp, const float* sinks, const float* gain, int unit, int tid, int lane, int wave) {
    const int b = unit >> 6, blk = (unit >> 1) & 31, half = unit & 1;
    const int kp0 = blk * 128 - 128 + 64 * half, qp0 = blk * 128 + 64 * half;
    LAS unsigned char* Ks = lds;
    LAS bf16* Vt = (LAS bf16*)(lds + 2 * SWA_KS_BYTES);
    LAS float* ssq = (LAS float*)(lds + 2 * SWA_KS_BYTES + 2 * SWA_VT_BYTES);
    __syncthreads();
    for (int i = 0; i < 6; ++i) {
        const int idx = tid + NTHR * i, kvh = idx / 1536, rem = idx % 1536, s = rem >> 3, ch = rem & 7, kp = kp0 + s;
        u32x4 kw = (u32x4){0u, 0u, 0u, 0u}, vw = (u32x4){0u, 0u, 0u, 0u};
        if (kp >= 0) { const bf16* rp = projp + (size_t)(b * SEQ + kp) * DIN + kvh * 64 + ch * 8; kw = *(const u32x4*)(rp + C_AK); vw = *(const u32x4*)(rp + C_AV); }
        *(LAS u32x4*)(Ks + kvh * SWA_KS_BYTES + s * 128 + ((ch ^ (s & 7)) << 4)) = kw;
        LAS bf16* vd = Vt + kvh * (64 * SWA_VT_STRIDE) + (ch * 8) * SWA_VT_STRIDE + s;
        vd[0 * SWA_VT_STRIDE] = (bf16)(vw.x & 0xffffu); vd[1 * SWA_VT_STRIDE] = (bf16)(vw.x >> 16); vd[2 * SWA_VT_STRIDE] = (bf16)(vw.y & 0xffffu); vd[3 * SWA_VT_STRIDE] = (bf16)(vw.y >> 16);
        vd[4 * SWA_VT_STRIDE] = (bf16)(vw.z & 0xffffu); vd[5 * SWA_VT_STRIDE] = (bf16)(vw.z >> 16); vd[6 * SWA_VT_STRIDE] = (bf16)(vw.w & 0xffffu); vd[7 * SWA_VT_STRIDE] = (bf16)(vw.w >> 16);
    }
    __syncthreads();
    const int c32 = lane & 31, h = lane >> 5, kvh = wave >> 2;
    const LAS unsigned char* Kw = Ks + kvh * SWA_KS_BYTES; const LAS bf16* Vw = Vt + kvh * (64 * SWA_VT_STRIDE);
#pragma unroll 1
    for (int item = 0; item < 4; ++item) {
        const int hd = wave * 2 + (item >> 1), qi = item & 1, rho = 32 * qi + c32;
        const bf16* qp = projp + (size_t)(b * SEQ + qp0 + rho) * DIN + C_AQ + hd * 64 + 8 * h;
        bf16x8 qf[4];
#pragma unroll
        for (int ks = 0; ks < 4; ++ks) qf[ks] = __builtin_bit_cast(bf16x8, *(const u32x4*)(qp + 16 * ks));
        f32x16 X[5];
#pragma unroll
        for (int kt = 0; kt < 5; ++kt) {
            const int key = 32 * (qi + kt) + c32;
#pragma unroll
            for (int r = 0; r < 16; ++r) X[kt][r] = 0.f;
#pragma unroll
            for (int ks = 0; ks < 4; ++ks) { const bf16x8 kf = *(const LAS bf16x8*)(Kw + key * 128 + (((2 * ks + h) ^ (key & 7)) << 4)); X[kt] = MFMA32(kf, qf[ks], X[kt]); }
        }
        const float sink = sinks[hd];
        float m = sink;
#pragma unroll
        for (int kt = 0; kt < 5; ++kt)
#pragma unroll
            for (int r = 0; r < 16; ++r) { const int s = 32 * (qi + kt) + krow16(r, h); const bool valid = (s > rho) && (s <= rho + 128) && (kp0 + s >= 0);
                const float sc = valid ? X[kt][r] * 0.125f : -INFINITY; X[kt][r] = sc; m = fmaxf(m, sc); }
        m = fmaxf(m, __shfl_xor(m, 32));
        float lsum = 0.f;
#pragma unroll
        for (int kt = 0; kt < 5; ++kt)
#pragma unroll
            for (int r = 0; r < 16; ++r) { const float p = __expf(X[kt][r] - m); X[kt][r] = p; lsum += p; }
        lsum += __shfl_xor(lsum, 32); lsum += __expf(sink - m);
        f32x16 O[2];
#pragma unroll
        for (int dt = 0; dt < 2; ++dt)
#pragma unroll
            for (int r = 0; r < 16; ++r) O[dt][r] = 0.f;
#pragma unroll
        for (int kt = 0; kt < 5; ++kt)
#pragma unroll
            for (int s2 = 0; s2 < 2; ++s2) { const bf16x8 pf = pack8(X[kt], s2); const int kb = 32 * (qi + kt) + 16 * s2 + 4 * h;
#pragma unroll
                for (int dt = 0; dt < 2; ++dt) { const LAS bf16* vp = Vw + (32 * dt + c32) * SWA_VT_STRIDE + kb;
                    const u32x2 v0 = *(const LAS u32x2*)vp, v1 = *(const LAS u32x2*)(vp + 8);
                    const bf16x8 vf = __builtin_bit_cast(bf16x8, (u32x4){v0.x, v0.y, v1.x, v1.y}); O[dt] = MFMA32(vf, pf, O[dt]); } }
        const float inv = 1.0f / lsum; float ss = 0.f;
        bf16* op = mixedp + (size_t)(b * SEQ + qp0 + rho) * DM + 512 + hd * 64 + 4 * h;
#pragma unroll
        for (int dt = 0; dt < 2; ++dt)
#pragma unroll
            for (int g4 = 0; g4 < 4; ++g4) { const float o0 = O[dt][4 * g4] * inv, o1 = O[dt][4 * g4 + 1] * inv, o2 = O[dt][4 * g4 + 2] * inv, o3 = O[dt][4 * g4 + 3] * inv;
                ss += (o0 * o0 + o1 * o1) + (o2 * o2 + o3 * o3); *(u32x2*)(op + 32 * dt + 8 * g4) = (u32x2){pk2(o0, o1), pk2(o2, o3)}; }
        ss += __shfl_xor(ss, 32);
        if (h == 0) ssq[rho * 16 + hd] = ss;
    }
    __syncthreads();
#pragma unroll 1
    for (int item = 0; item < 4; ++item) {
        const int hd = wave * 2 + (item >> 1), qi = item & 1, rho = 32 * qi + c32;
        float tot = 0.f;
#pragma unroll
        for (int j = 0; j < 16; ++j) tot += ssq[rho * 16 + j];
        const float rr = 1.0f / sqrtf(tot * (1.0f / 1024.0f) + RMS_EPS);
        const float* gp = gain + 512 + hd * 64 + 4 * h;
        bf16* op = mixedp + (size_t)(b * SEQ + qp0 + rho) * DM + 512 + hd * 64 + 4 * h;
#pragma unroll
        for (int dt = 0; dt < 2; ++dt)
#pragma unroll
            for (int g4 = 0; g4 < 4; ++g4) { const u32x2 o = *(const u32x2*)(op + 32 * dt + 8 * g4); const f32x4 g = *(const f32x4*)(gp + 32 * dt + 8 * g4);
                *(u32x2*)(op + 32 * dt + 8 * g4) = (u32x2){pk2(bflo(o.x) * rr * g.x, bfhi(o.x) * rr * g.y), pk2(bflo(o.y) * rr * g.z, bfhi(o.y) * rr * g.w)}; }
    }
    __syncthreads();
}


constexpr int HG_BSTR = 132, HG_HSTR = 136;
constexpr int HG_B_BYTES = 128 * HG_BSTR * 4, HG_H_BYTES = 128 * HG_HSTR * 2;
__device__ __forceinline__ float hg_lb(const float* lb_logits, int l, int hk) { if (l == 0) return 0.f; const float a0 = lb_logits[hk], a1 = lb_logits[512 + hk]; return 1.0f / (1.0f + expf(a0 - a1)); }
__device__ __forceinline__ float hg_logf2(float z, float lb) {
    const float ls = fminf(z, 0.f) - log1pf(expf(-fabsf(z))); const float lf = (lb == 0.f) ? ls : logf(lb + (1.f - lb) * expf(ls)); return lf * 1.4426950408889634f; }
__device__ __forceinline__ void hg_cumsum(LAS float* bL, LAS float* segtot, LAS float* lbs, const bf16* projp, int row0, int h, int tid) {
#pragma unroll 1
    for (int i = 0; i < 4; ++i) { const int idx = tid + NTHR * i, t = idx >> 4, kg = idx & 15;
        const u32x4 z8 = *(const u32x4*)(projp + (size_t)(row0 + t) * DIN + C_HF + h * 128 + kg * 8);
        const f32x4 l0 = *(const LAS f32x4*)(lbs + kg * 8), l1 = *(const LAS f32x4*)(lbs + kg * 8 + 4);
        *(LAS f32x4*)(bL + t * HG_BSTR + kg * 8) = (f32x4){hg_logf2(bflo(z8.x), l0.x), hg_logf2(bfhi(z8.x), l0.y), hg_logf2(bflo(z8.y), l0.z), hg_logf2(bfhi(z8.y), l0.w)};
        *(LAS f32x4*)(bL + t * HG_BSTR + kg * 8 + 4) = (f32x4){hg_logf2(bflo(z8.z), l1.x), hg_logf2(bfhi(z8.z), l1.y), hg_logf2(bflo(z8.w), l1.z), hg_logf2(bfhi(z8.w), l1.w)}; }
    __syncthreads();
    { const int k = tid & 127, seg = tid >> 7; float run = 0.f;
        for (int tt = 0; tt < 32; ++tt) { const int t = seg * 32 + tt; run += bL[t * HG_BSTR + k]; bL[t * HG_BSTR + k] = run; }
        segtot[seg * 128 + k] = run;
        __syncthreads();
        float off = 0.f;
#pragma unroll
        for (int s = 0; s < 4; ++s) { const float v = segtot[s * 128 + k]; if (s < seg) off += v; }
        if (seg > 0) for (int tt = 0; tt < 32; ++tt) { const int t = seg * 32 + tt; bL[t * HG_BSTR + k] += off; }
    }
    __syncthreads();
}
__device__ __forceinline__ void hg_stage_vt(LAS bf16* VT, const bf16* projp, int row0, int h, int tid) {
#pragma unroll
    for (int i = 0; i < 4; ++i) { const int idx = tid + NTHR * i, vg = idx >> 7, t = idx & 127;
        const u32x4 w = *(const u32x4*)(projp + (size_t)(row0 + t) * DIN + C_HI + h * 128 + vg * 8);
        LAS bf16* d = VT + (vg * 8) * HG_HSTR + t;
        d[0] = (bf16)(w.x & 0xffffu); d[HG_HSTR] = (bf16)(w.x >> 16); d[2 * HG_HSTR] = (bf16)(w.y & 0xffffu); d[3 * HG_HSTR] = (bf16)(w.y >> 16);
        d[4 * HG_HSTR] = (bf16)(w.z & 0xffffu); d[5 * HG_HSTR] = (bf16)(w.z >> 16); d[6 * HG_HSTR] = (bf16)(w.w & 0xffffu); d[7 * HG_HSTR] = (bf16)(w.w >> 16); }
}
__device__ __forceinline__ void hgrn_local_unit(LAS unsigned char* lds, const bf16* projp, const float* lb_logits, float* stateg, float* dendg, int l, int unit, int tid_in, int lane_in, int wave) {
    int tid = tid_in; asm volatile("" : "+v"(tid)); int lane = tid & 63; (void)lane_in;
    const int bh = unit >> 5, c = unit & 31, b = bh >> 2, h = bh & 3, row0 = b * SEQ + c * 128;
    LAS float* bL = (LAS float*)lds; LAS bf16* VT = (LAS bf16*)(lds + HG_B_BYTES); LAS bf16* kdT = (LAS bf16*)(lds + HG_B_BYTES + HG_H_BYTES);
    LAS float* segtot = (LAS float*)(lds + HG_B_BYTES + 2 * HG_H_BYTES); LAS float* lbs = segtot + 512;
    __syncthreads();
    if (tid < 128) lbs[tid] = hg_lb(lb_logits, l, h * 128 + tid);
    __syncthreads();
    hg_cumsum(bL, segtot, lbs, projp, row0, h, tid);
    hg_stage_vt(VT, projp, row0, h, tid);
    if (tid < 128) dendg[(size_t)(bh * 32 + c) * 128 + tid] = __builtin_amdgcn_exp2f(bL[127 * HG_BSTR + tid]);
#pragma unroll 1
    for (int i = 0; i < 4; ++i) { const int idx = tid + NTHR * i, kg = idx >> 7, t = idx & 127;
        const u32x4 z8 = *(const u32x4*)(projp + (size_t)(row0 + t) * DIN + C_HF + h * 128 + kg * 8);
        const float zf[8] = {bflo(z8.x), bfhi(z8.x), bflo(z8.y), bfhi(z8.y), bflo(z8.z), bfhi(z8.z), bflo(z8.w), bfhi(z8.w)};
#pragma unroll
        for (int j = 0; j < 8; ++j) { const int k = kg * 8 + j; const float kk = (1.f - lbs[k]) / (1.f + expf(zf[j]));
            kdT[k * HG_HSTR + t] = (bf16)f2bf(kk * __builtin_amdgcn_exp2f(bL[127 * HG_BSTR + k] - bL[t * HG_BSTR + k])); } }
    __syncthreads();
    asm volatile("" : "+v"(tid)); lane = tid & 63;
    const int c32 = lane & 31, hh = lane >> 5;
#pragma unroll
    for (int ti = 0; ti < 2; ++ti) { const int tile = wave * 2 + ti, vt = tile >> 2, kt = tile & 3;
        f32x16 acc;
#pragma unroll
        for (int r = 0; r < 16; ++r) acc[r] = 0.f;
#pragma unroll
        for (int ks = 0; ks < 8; ++ks) { const bf16x8 af = *(const LAS bf16x8*)(VT + (32 * vt + c32) * HG_HSTR + 16 * ks + 8 * hh), bf = *(const LAS bf16x8*)(kdT + (32 * kt + c32) * HG_HSTR + 16 * ks + 8 * hh);
            acc = MFMA32(af, bf, acc); }
        float* sp = stateg + (size_t)(bh * 32 + c) * 16384 + 32 * kt + c32;
#pragma unroll
        for (int r = 0; r < 16; ++r) sp[(size_t)(32 * vt + krow16(r, hh)) * 128] = acc[r];
    }
    __syncthreads();
}
__device__ __forceinline__ void hgrn_out_unit(LAS unsigned char* lds, const bf16* projp, bf16* mixedp, const float* lb_logits, const float* gain, const float* stateg, int l, int unit, int tid_in, int lane_in, int wave) {
    int tid = tid_in; asm volatile("" : "+v"(tid)); int lane = tid & 63; (void)lane_in;
    const int bh = unit >> 5, c = unit & 31, b = bh >> 2, h = bh & 3, row0 = b * SEQ + c * 128;
    LAS float* bL = (LAS float*)lds; LAS bf16* VT = (LAS bf16*)(lds + HG_B_BYTES); LAS bf16* kh = (LAS bf16*)(lds + HG_B_BYTES + HG_H_BYTES);
    LAS float* segtot = (LAS float*)(lds + HG_B_BYTES + 2 * HG_H_BYTES); LAS float* lbs = segtot + 512; LAS float* ssq = segtot + 640;
    __syncthreads();
    if (tid < 128) lbs[tid] = hg_lb(lb_logits, l, h * 128 + tid);
    __syncthreads();
    hg_cumsum(bL, segtot, lbs, projp, row0, h, tid);
    hg_stage_vt(VT, projp, row0, h, tid);
#pragma unroll 1
    for (int i = 0; i < 4; ++i) { const int idx = tid + NTHR * i, t = idx >> 4, kg = idx & 15, rend = (t | 31);
        const u32x4 z8 = *(const u32x4*)(projp + (size_t)(row0 + t) * DIN + C_HF + h * 128 + kg * 8);
        const float zf[8] = {bflo(z8.x), bfhi(z8.x), bflo(z8.y), bfhi(z8.y), bflo(z8.z), bfhi(z8.z), bflo(z8.w), bfhi(z8.w)};
        float o[8];
#pragma unroll
        for (int j = 0; j < 8; ++j) { const int k = kg * 8 + j; o[j] = (1.f - lbs[k]) / (1.f + expf(zf[j])) * __builtin_amdgcn_exp2f(bL[rend * HG_BSTR + k] - bL[t * HG_BSTR + k]); }
        *(LAS u32x4*)(kh + t * HG_HSTR + kg * 8) = (u32x4){pk2(o[0], o[1]), pk2(o[2], o[3]), pk2(o[4], o[5]), pk2(o[6], o[7])}; }
    __syncthreads();
    asm volatile("" : "+v"(tid)); lane = tid & 63;
    const int c32 = lane & 31, hh = lane >> 5, I = wave & 3, vh = wave >> 2, t = 32 * I + c32;
    u32x4 qs[8];
    { const bf16* qp = projp + (size_t)(row0 + t) * DIN + C_HQ + h * 128 + 8 * hh;
#pragma unroll
        for (int ks = 0; ks < 8; ++ks) { const u32x4 w = *(const u32x4*)(qp + 16 * ks);
            qs[ks] = (u32x4){pk2(siluf_(bflo(w.x)), siluf_(bfhi(w.x))), pk2(siluf_(bflo(w.y)), siluf_(bfhi(w.y))), pk2(siluf_(bflo(w.z)), siluf_(bfhi(w.z))), pk2(siluf_(bflo(w.w)), siluf_(bfhi(w.w)))}; } }
    f32x16 O[2];
#pragma unroll
    for (int v2 = 0; v2 < 2; ++v2)
#pragma unroll
        for (int r = 0; r < 16; ++r) O[v2][r] = 0.f;
#pragma unroll 1
    for (int J = -1; J <= I; ++J) {
        bf16x8 qa[8];
#pragma unroll
        for (int ks = 0; ks < 8; ++ks) { const int k0 = 16 * ks + 8 * hh;
            const f32x4 b0 = *(const LAS f32x4*)(bL + t * HG_BSTR + k0), b1 = *(const LAS f32x4*)(bL + t * HG_BSTR + k0 + 4);
            f32x4 r0 = (f32x4){0.f, 0.f, 0.f, 0.f}, r1 = r0;
            if (J >= 0) { r0 = *(const LAS f32x4*)(bL + (32 * J + 31) * HG_BSTR + k0); r1 = *(const LAS f32x4*)(bL + (32 * J + 31) * HG_BSTR + k0 + 4); }
            const u32x4 q = qs[ks];
            u32x4 p;
            p.x = pk2(bflo(q.x) * __builtin_amdgcn_exp2f(fminf(b0.x - r0.x, 120.f)), bfhi(q.x) * __builtin_amdgcn_exp2f(fminf(b0.y - r0.y, 120.f)));
            p.y = pk2(bflo(q.y) * __builtin_amdgcn_exp2f(fminf(b0.z - r0.z, 120.f)), bfhi(q.y) * __builtin_amdgcn_exp2f(fminf(b0.w - r0.w, 120.f)));
            p.z = pk2(bflo(q.z) * __builtin_amdgcn_exp2f(fminf(b1.x - r1.x, 120.f)), bfhi(q.z) * __builtin_amdgcn_exp2f(fminf(b1.y - r1.y, 120.f)));
            p.w = pk2(bflo(q.w) * __builtin_amdgcn_exp2f(fminf(b1.z - r1.z, 120.f)), bfhi(q.w) * __builtin_amdgcn_exp2f(fminf(b1.w - r1.w, 120.f)));
            qa[ks] = __builtin_bit_cast(bf16x8, p); if (ks & 1) __builtin_amdgcn_sched_barrier(0); }
        if (J < 0) {
#pragma unroll
            for (int v2 = 0; v2 < 2; ++v2) { const float* sp = stateg + (size_t)(bh * 32 + c) * 16384 + (size_t)(32 * (2 * vh + v2) + c32) * 128 + 8 * hh;
#pragma unroll
                for (int ks = 0; ks < 8; ++ks) { const f32x4 s0 = *(const f32x4*)(sp + 16 * ks), s1 = *(const f32x4*)(sp + 16 * ks + 4);
                    const bf16x8 sf = __builtin_bit_cast(bf16x8, (u32x4){pk2(s0.x, s0.y), pk2(s0.z, s0.w), pk2(s1.x, s1.y), pk2(s1.z, s1.w)});
                    O[v2] = MFMA32(sf, qa[ks], O[v2]); if ((ks & 3) == 3) __builtin_amdgcn_sched_barrier(0); } }
        } else {
            f32x16 X;
#pragma unroll
            for (int r = 0; r < 16; ++r) X[r] = 0.f;
#pragma unroll
            for (int ks = 0; ks < 8; ++ks) { const bf16x8 kf = *(const LAS bf16x8*)(kh + (32 * J + c32) * HG_HSTR + 16 * ks + 8 * hh); X = MFMA32(kf, qa[ks], X); }
            if (J == I) {
#pragma unroll
                for (int r = 0; r < 16; ++r) if (krow16(r, hh) > c32) X[r] = 0.f;
            }
#pragma unroll
            for (int s2 = 0; s2 < 2; ++s2) { const bf16x8 pf = pack8(X, s2); const int kb = 32 * J + 16 * s2 + 4 * hh;
#pragma unroll
                for (int v2 = 0; v2 < 2; ++v2) { const LAS bf16* vp = VT + (32 * (2 * vh + v2) + c32) * HG_HSTR + kb;
                    const u32x2 v0 = *(const LAS u32x2*)vp, v1 = *(const LAS u32x2*)(vp + 8);
                    O[v2] = MFMA32(__builtin_bit_cast(bf16x8, (u32x4){v0.x, v0.y, v1.x, v1.y}), pf, O[v2]); } }
        }
    }
    float ss = 0.f;
#pragma unroll
    for (int v2 = 0; v2 < 2; ++v2)
#pragma unroll
        for (int r = 0; r < 16; ++r) ss += O[v2][r] * O[v2][r];
    ss += __shfl_xor(ss, 32);
    if (hh == 0) ssq[t * 2 + vh] = ss;
    __syncthreads();
    const float rr = 1.0f / sqrtf((ssq[t * 2] + ssq[t * 2 + 1]) * (1.0f / 128.0f) + RMS_EPS);
#pragma unroll
    for (int v2 = 0; v2 < 2; ++v2)
#pragma unroll
        for (int g4 = 0; g4 < 4; ++g4) { const int v0 = 32 * (2 * vh + v2) + 8 * g4 + 4 * hh;
            const u32x2 gw = *(const u32x2*)(projp + (size_t)(row0 + t) * DIN + C_HG + h * 128 + v0); const f32x4 gn = *(const f32x4*)(gain + h * 128 + v0);
            const float o0 = O[v2][4 * g4] * rr * gn.x * siluf_(bflo(gw.x)), o1 = O[v2][4 * g4 + 1] * rr * gn.y * siluf_(bfhi(gw.x)), o2 = O[v2][4 * g4 + 2] * rr * gn.z * siluf_(bflo(gw.y)), o3 = O[v2][4 * g4 + 3] * rr * gn.w * siluf_(bfhi(gw.y));
            *(u32x2*)(mixedp + (size_t)(row0 + t) * DM + h * 128 + v0) = (u32x2){pk2(o0, o1), pk2(o2, o3)}; }
    __syncthreads();
}

#define KAS __attribute__((address_space(4)))
#define PHASE_PTRS const char KAS* kp_ = (const char KAS*)__builtin_amdgcn_kernarg_segment_ptr(); asm volatile("" : "+s"(kp_)); unsigned char* const ws = *(unsigned char* const KAS*)(kp_ + 26 * 8); (void)ws;
#define INP(k) (*(const float* const KAS*)(kp_ + (k) * 8))
#define x_in INP(0)
#define ln0_g INP(1)
#define ln0_b INP(2)
#define w_in INP(3)
#define b_in INP(4)
#define lb_logits INP(5)
#define sw_sinks INP(6)
#define sg_ln_g INP(7)
#define sg_ln_b INP(8)
#define sg_w_s INP(9)
#define sg_b_s INP(10)
#define mix_gain INP(11)
#define w_out INP(12)
#define ln1_g INP(13)
#define ln1_b INP(14)
#define router_w INP(15)
#define router_b INP(16)
#define ew_gate INP(17)
#define ew_up INP(18)
#define ew_down INP(19)
#define sh_gate INP(20)
#define sh_up INP(21)
#define sh_down INP(22)
#define ln2_g INP(23)
#define ln2_b INP(24)
#define OUTP (*(float* const KAS*)(kp_ + 25 * 8))
#define list ((int*)(ws + WS_LIST))
#define wlist ((float*)(ws + WS_WLIST))
#define slot ((int*)(ws + WS_SLOT))
#define dendG ((float*)(ws + WS_DEND))
#define stateG ((float*)(ws + WS_STATE))
#define Hf ((float*)(ws + WS_HF))
#define Hb ((bf16*)(ws + WS_HB))
#define proj ((bf16*)(ws + WS_PROJ))
#define mixed ((bf16*)(ws + WS_MIXED))
#define Hs ((bf16*)(ws + WS_HS))
#define Yb ((bf16*)(ws + WS_Y))
#define ctl ((unsigned*)(ws + WS_CTL))
#define WLp ((const char*)(ws + WS_W + (size_t)l * WL_BYTES))
#define cntG (ctl + CW_CNT + l * 64)
__global__ void __launch_bounds__(NTHR, 2) fwd_kernel(Args args) {
    extern __shared__ __attribute__((aligned(16))) unsigned char lds_raw[];
    LAS unsigned char* const lds = (LAS unsigned char*)lds_raw;
    const int tid = threadIdx.x, lane = tid & 63, wave = __builtin_amdgcn_readfirstlane(tid >> 6);
    const int G = gridDim.x, bx = blockIdx.x;
    const int vcu = (G % 8 == 0) ? (bx % 8) * (G / 8) + bx / 8 : bx;
    volatile LAS unsigned* MISC = (volatile LAS unsigned*)(lds + MISC_OFF);
    if (tid < 64) MISC[tid] = 0u;
    __syncthreads();
    XcdBarrier bar; bar.bar = (unsigned*)(args.ws + WS_CTL) + CW_BAR; bar.x = 0; bar.st = nullptr;
    if (args.use_bar) bar = xcd_barrier_post((unsigned*)(args.ws + WS_CTL) + CW_BAR, MISC + 8);
    const int lo = args.ph_lo, hi = args.ph_hi;
#define PHASE_TID int tid_o_ = tid_of_wave(wave); asm volatile("" : "+v"(tid_o_)); const int tid = tid_o_, lane = tid & 63; (void)lane; (void)tid;
#ifndef BSEL
#define BSEL 7
#endif
#ifndef DBLMASK
#define DBLMASK 0
#endif
#define REP(i) (((DBLMASK >> (i)) & 1) ? 2 : 1)
#ifndef PHMASK
#define PHMASK 0x3ff
#endif
#define IN(k) (lo <= (k) && (k) < hi)
#define EN(i) ((PHMASK >> (i)) & 1)
#define SEAM(k) do { if (IN(k) && IN((k) + 1)) xcd_barrier(bar, wave); } while (0)

    for (int rep_ = 0; rep_ < REP(0); ++rep_)
    if (EN(0) && IN(0)) { PHASE_TID PHASE_PTRS
        LAS float* scr = (LAS float*)(lds + wave * 16384);
        const int gw = vcu * NWAVES + wave, NGW = G * NWAVES;
        for (int it = gw; it < 2 * IT_LAYER; it += NGW) {
            const int l = it / IT_LAYER; int r = it % IT_LAYER;
            bf16* const WL = (bf16*)(ws + WS_W + (size_t)l * WL_BYTES);
            if (r < IT_IN) { transpose_item(w_in + (size_t)l * DM * DIN, DM, DIN, (bf16*)((char*)WLp + WL_IN), 0, scr, r, lane); continue; } r -= IT_IN;
            if (r < IT_OUT) { transpose_item(w_out + (size_t)l * DM * DM, DM, DM, (bf16*)((char*)WLp + WL_OUT), 0, scr, r, lane); continue; } r -= IT_OUT;
            const int e = r / (2 * IT_G + IT_D); r = r % (2 * IT_G + IT_D);
            bf16* const gu = (bf16*)((char*)WLp + WL_GU + (size_t)e * W_GU_B); bf16* const dn = (bf16*)((char*)WLp + WL_D + (size_t)e * W_D_B);
            if (r < IT_G) { const float* src = (e < 64) ? ew_gate + ((size_t)l * 64 + e) * DM * DE : sh_gate + (size_t)l * DM * DE; transpose_item(src, DM, DE, gu, 1, scr, r, lane); continue; } r -= IT_G;
            if (r < IT_G) { const float* src = (e < 64) ? ew_up + ((size_t)l * 64 + e) * DM * DE : sh_up + (size_t)l * DM * DE; transpose_item(src, DM, DE, gu, 2, scr, r, lane); continue; } r -= IT_G;
            { const float* src = (e < 64) ? ew_down + ((size_t)l * 64 + e) * DE * DM : sh_down + (size_t)l * DE * DM; transpose_item(src, DE, DM, dn, 0, scr, r, lane); }
        }
        for (int m = gw; m < NTOK; m += NGW) {
            f32x4 v[8];
#pragma unroll
            for (int j = 0; j < 8; ++j) v[j] = ((const f32x4*)(x_in + (size_t)m * DM))[j * 64 + lane];
            ln_regs(v, ln0_g, ln0_b, lane);
            store_row_f32(Hf + (size_t)m * DM, v, lane); store_row_bf16(Hb + (size_t)m * DM, v, lane);
        }
    }
    SEAM(0);

    for (int l = 0; l < 2; ++l) {
        const int pb = 1 + l * 9;

        for (int rep_ = 0; rep_ < REP(1); ++rep_)
        if (EN(1) && IN(pb + 0)) { PHASE_PTRS
            pg8::PlainSched S; S.init(NTOK, DIN, DM, G, bx, WLp + WL_IN);
            pg8::EpiBf16Bias E{proj, DIN, b_in + (size_t)l * DIN};
            pg8::gemm_phase<pg8::EpiBf16Bias, pg8::PlainSched, true>(lds, (const char*)Hb, DM, S, E, wave);
        }
        SEAM(pb + 0);

        for (int rep_ = 0; rep_ < REP(2); ++rep_)
        if (EN(2) && IN(pb + 1)) {
            if (BSEL & 1) { PHASE_TID PHASE_PTRS
            for (int unit = bx; unit < 512; unit += G) hgrn_local_unit(lds, proj, lb_logits, stateG, dendG, l, unit, tid, lane, wave);
            }
            if (BSEL & 2) { PHASE_TID PHASE_PTRS
            for (int unit = bx; unit < 256; unit += G) swa_unit(lds, proj, mixed, sw_sinks + l * 16, mix_gain + (size_t)l * DM, unit, tid, lane, wave);
            }
            if (BSEL & 4) { PHASE_TID PHASE_PTRS
            for (int unit = bx; unit < 128; unit += G) {
                const int row0 = unit * 128;
                LAS float* vn = (LAS float*)lds;
                LAS float* wT = (LAS float*)(lds + 65536);
                LAS f32x2* stats = (LAS f32x2*)(lds + 133120);
                __syncthreads();
#pragma unroll 1
                for (int i = 0; i < 16; ++i) { const int s = wave * 16 + i;
                    const u32x4 w = *(const u32x4*)(proj + (size_t)(row0 + s) * DIN + C_SV + lane * 8);
                    float g[8] = {geluf_(bflo(w.x)), geluf_(bfhi(w.x)), geluf_(bflo(w.y)), geluf_(bfhi(w.y)), geluf_(bflo(w.z)), geluf_(bfhi(w.z)), geluf_(bflo(w.w)), geluf_(bfhi(w.w))};
                    float sm = 0.f;
#pragma unroll
                    for (int j = 0; j < 8; ++j) sm += g[j];
                    const float mean = wave_sum(sm) * (1.0f / 512.0f); float s2 = 0.f;
#pragma unroll
                    for (int j = 0; j < 8; ++j) { const float d = g[j] - mean; s2 += d * d; }
                    const float rstd = 1.0f / sqrtf(wave_sum(s2) * (1.0f / 512.0f) + LN_EPS);
                    if (lane == 0) stats[s] = (f32x2){mean, rstd};
                }
                float ssr[4] = {0.f, 0.f, 0.f, 0.f};
                const int tq = tid >> 4, cq = tid & 15, t0 = 4 * tq, c0 = 8 * cq;
#pragma unroll 1
                for (int g = 0; g < 4; ++g) {
                    __syncthreads();
#pragma unroll 1
                    for (int i = 0; i < 4; ++i) { const int idx = tid + NTHR * i, s = idx >> 4, cg = idx & 15;
                        const u32x4 w = *(const u32x4*)(proj + (size_t)(row0 + s) * DIN + C_SV + g * 128 + cg * 8);
                        const f32x2 st = stats[s]; const float* lg = sg_ln_g + (size_t)l * 512 + g * 128 + cg * 8; const float* lbp = sg_ln_b + (size_t)l * 512 + g * 128 + cg * 8;
                        const float x8[8] = {bflo(w.x), bfhi(w.x), bflo(w.y), bfhi(w.y), bflo(w.z), bfhi(w.z), bflo(w.w), bfhi(w.w)};
#pragma unroll
                        for (int j = 0; j < 8; ++j) vn[s * 128 + cg * 8 + j] = (geluf_(x8[j]) - st.x) * st.y * lg[j] + lbp[j];
                    }
                    { const float* wsrc = sg_w_s + ((size_t)l * 4 + g) * 128 * 128;
#pragma unroll
                        for (int i = 0; i < 8; ++i) { const int idx = tid + NTHR * i, s4 = (idx >> 7) * 4, t = idx & 127;
                            const f32x4 w4 = *(const f32x4*)(wsrc + t * 128 + s4);
#pragma unroll
                            for (int j = 0; j < 4; ++j) wT[(s4 + j) * 132 + t] = (s4 + j <= t) ? w4[j] : 0.f; } }
                    __syncthreads();
                    float acc[4][8];
#pragma unroll
                    for (int i = 0; i < 4; ++i)
#pragma unroll
                        for (int j = 0; j < 8; ++j) acc[i][j] = 0.f;
                    for (int s = 0; s <= t0 + 3; ++s) {
                        const f32x4 w4 = *(const LAS f32x4*)(wT + s * 132 + t0); const f32x4 va = *(const LAS f32x4*)(vn + s * 128 + c0), vb2 = *(const LAS f32x4*)(vn + s * 128 + c0 + 4);
                        const float vf[8] = {va.x, va.y, va.z, va.w, vb2.x, vb2.y, vb2.z, vb2.w};
#pragma unroll
                        for (int i = 0; i < 4; ++i)
#pragma unroll
                            for (int j = 0; j < 8; ++j) acc[i][j] += w4[i] * vf[j];
                    }
#pragma unroll 1
                    for (int i = 0; i < 4; ++i) { const float bs = sg_b_s[((size_t)l * 4 + g) * 128 + t0 + i];
                        const u32x4 w = *(const u32x4*)(proj + (size_t)(row0 + t0 + i) * DIN + C_SU + g * 128 + c0);
                        const float u8[8] = {bflo(w.x), bfhi(w.x), bflo(w.y), bfhi(w.y), bflo(w.z), bfhi(w.z), bflo(w.w), bfhi(w.w)};
                        float o8[8];
#pragma unroll
                        for (int j = 0; j < 8; ++j) { o8[j] = geluf_(u8[j]) * (acc[i][j] + bs); ssr[i] += o8[j] * o8[j]; }
                        *(u32x4*)(mixed + (size_t)(row0 + t0 + i) * DM + 1536 + g * 128 + c0) = (u32x4){pk2(o8[0], o8[1]), pk2(o8[2], o8[3]), pk2(o8[4], o8[5]), pk2(o8[6], o8[7])}; }
                }
                __syncthreads();
#pragma unroll
                for (int i = 0; i < 4; ++i) { float ss = ssr[i];
                    ss += __shfl_xor(ss, 1); ss += __shfl_xor(ss, 2); ss += __shfl_xor(ss, 4); ss += __shfl_xor(ss, 8);
                    const float rr = 1.0f / sqrtf(ss * (1.0f / 512.0f) + RMS_EPS);
#pragma unroll
                    for (int g = 0; g < 4; ++g) { const float* gp = mix_gain + (size_t)l * DM + 1536 + g * 128 + c0; bf16* op = mixed + (size_t)(row0 + t0 + i) * DM + 1536 + g * 128 + c0;
                        const u32x4 o = *(const u32x4*)op; const f32x4 g0 = *(const f32x4*)gp, g1 = *(const f32x4*)(gp + 4);
                        u32x4 w; w.x = pk2(bflo(o.x) * rr * g0.x, bfhi(o.x) * rr * g0.y); w.y = pk2(bflo(o.y) * rr * g0.z, bfhi(o.y) * rr * g0.w);
                        w.z = pk2(bflo(o.z) * rr * g1.x, bfhi(o.z) * rr * g1.y); w.w = pk2(bflo(o.w) * rr * g1.z, bfhi(o.w) * rr * g1.w);
                        *(u32x4*)op = w; }
                }
                __syncthreads();
            }
            }
        }
        SEAM(pb + 1);

        if (EN(3) && IN(pb + 2)) { PHASE_TID PHASE_PTRS
            for (int gi = bx * NTHR + tid; gi < 16 * 8192; gi += G * NTHR) {
                const int bh = gi >> 13, rem = gi & 8191, k = (rem & 63) * 2;
                float z0_ = 0.f; asm volatile("" : "+v"(z0_));
                f32x2 carry = (f32x2){z0_, z0_};
                for (int c = 0; c < 32; ++c) {
                    f32x2* p = (f32x2*)(stateG + (size_t)(bh * 32 + c) * 16384) + rem;
                    const f32x2 tmp = *p; *p = carry; const f32x2 d = *(const f32x2*)(dendG + (size_t)(bh * 32 + c) * 128 + k); carry = carry * d + tmp;
                }
            }
        }
        SEAM(pb + 2);

        for (int rep_ = 0; rep_ < REP(4); ++rep_)
        if (EN(4) && IN(pb + 3)) { PHASE_TID PHASE_PTRS
            for (int unit = bx; unit < 512; unit += G) hgrn_out_unit(lds, proj, mixed, lb_logits, mix_gain + (size_t)l * DM, stateG, l, unit, tid, lane, wave);
        }
        SEAM(pb + 3);

        if (EN(5) && IN(pb + 4)) { PHASE_PTRS
            pg8::PlainSched S; S.init(NTOK, DM, DM, G, bx, WLp + WL_OUT);
            pg8::EpiResF32 E{Hf, DM, ALPHA};
            pg8::gemm_phase<pg8::EpiResF32, pg8::PlainSched, true>(lds, (const char*)mixed, DM, S, E, wave);
        }
        SEAM(pb + 4);

        if (EN(6) && IN(pb + 5)) { PHASE_TID PHASE_PTRS
            LAS float* xs = (LAS float*)lds;
            LAS int* selr = (LAS int*)(lds + 131072);
            LAS float* gatel = (LAS float*)(lds + 131072 + 4096);
            const float* rw = router_w + (size_t)l * DM * NE;
            for (int bi = bx; bi < NTOK / 16; bi += G) {
                const int tok0 = bi * 16;
                __syncthreads();
#pragma unroll
                for (int jt = 0; jt < 2; ++jt) { const int tl = wave * 2 + jt, tok = tok0 + tl;
                    f32x4 v[8];
#pragma unroll
                    for (int j = 0; j < 8; ++j) v[j] = ((const f32x4*)(Hf + (size_t)tok * DM))[j * 64 + lane];
                    ln_regs(v, ln1_g + (size_t)l * DM, ln1_b + (size_t)l * DM, lane);
                    store_row_f32(Hf + (size_t)tok * DM, v, lane); store_row_bf16(Hb + (size_t)tok * DM, v, lane);
#pragma unroll
                    for (int j = 0; j < 8; ++j) ((LAS f32x4*)(xs + tl * DM))[j * 64 + lane] = v[j];
                }
                __syncthreads();
                float acc[16];
#pragma unroll
                for (int t = 0; t < 16; ++t) acc[t] = 0.f;
                for (int k4 = 0; k4 < 64; ++k4) { const int k = wave * 256 + k4 * 4;
                    const float w0 = rw[(size_t)(k + 0) * NE + lane], w1 = rw[(size_t)(k + 1) * NE + lane], w2 = rw[(size_t)(k + 2) * NE + lane], w3 = rw[(size_t)(k + 3) * NE + lane];
#pragma unroll
                    for (int t = 0; t < 16; ++t) { const f32x4 x4 = *(const LAS f32x4*)(xs + t * DM + k); acc[t] += x4.x * w0 + x4.y * w1 + x4.z * w2 + x4.w * w3; }
                }
                __syncthreads();
#pragma unroll
                for (int t = 0; t < 16; ++t) xs[(wave * 16 + t) * 64 + lane] = acc[t];
                __syncthreads();
#pragma unroll
                for (int jt = 0; jt < 2; ++jt) { const int tl = wave * 2 + jt;
                    float logit = 0.f;
#pragma unroll
                    for (int w = 0; w < 8; ++w) logit += xs[(w * 16 + tl) * 64 + lane];
                    const float score = 1.0f / (1.0f + expf(-logit));
                    const float sel = score + router_b[l * NE + lane];
                    float m1 = sel; m1 = fmaxf(m1, __shfl_xor(m1, 1)); m1 = fmaxf(m1, __shfl_xor(m1, 2)); m1 = fmaxf(m1, __shfl_xor(m1, 4));
                    const unsigned long long bm = __ballot(sel == m1); const int grp = lane >> 3; const unsigned gbits = (unsigned)(bm >> (grp * 8)) & 0xffu; const int first = __builtin_ctz(gbits);
                    float s2 = ((lane & 7) == first) ? -INFINITY : sel; s2 = fmaxf(s2, __shfl_xor(s2, 1)); s2 = fmaxf(s2, __shfl_xor(s2, 2)); s2 = fmaxf(s2, __shfl_xor(s2, 4));
                    const float gs = m1 + s2;
                    int grank = 0;
#pragma unroll
                    for (int j = 0; j < 8; ++j) { const float gj = __shfl(gs, j * 8); grank += (gj > gs || (gj == gs && j < grp)) ? 1 : 0; }
                    const bool chosen = grank < 4;
                    const float msel = chosen ? sel : -INFINITY;
                    int rk = 0;
#pragma unroll 8
                    for (int j = 0; j < 64; ++j) { const float vj = __shfl(msel, j); rk += (vj > msel || (vj == msel && j < lane)) ? 1 : 0; }
                    const bool selected = chosen && rk < 8;
                    const float ssum = wave_sum(selected ? score : 0.f);
                    selr[tl * 64 + lane] = selected ? rk : -1; gatel[tl * 64 + lane] = score / ssum * ROUTED_SCALE;
                }
                __syncthreads();
                if (wave == 0) {
                    int cl = 0; int lp[16];
#pragma unroll
                    for (int t = 0; t < 16; ++t) { lp[t] = cl; cl += (selr[t * 64 + lane] >= 0) ? 1 : 0; }
                    int base = 0; if (cl > 0) base = (int)__hip_atomic_fetch_add(cntG + lane, (unsigned)cl, RLX_AGENT);
#pragma unroll
                    for (int t = 0; t < 16; ++t) { const int rk = selr[t * 64 + lane];
                        if (rk >= 0) { const int pos = base + lp[t]; list[lane * NTOK + pos] = tok0 + t; wlist[lane * NTOK + pos] = gatel[t * 64 + lane]; slot[(size_t)(tok0 + t) * 8 + rk] = (lane << 16) | pos; } }
                }
            }
        }
        SEAM(pb + 5);

        LAS int* const cnts = (LAS int*)(lds + TAB_OFF); LAS int* const tstart = cnts + 64; LAS int* const tile_e = cnts + 192;
        int ntiles = 0;
        if ((EN(7) && IN(pb + 6)) || (EN(8) && IN(pb + 7)) || (EN(9) && IN(pb + 8))) { PHASE_TID PHASE_PTRS
            __syncthreads();
            if (tid < 64) cnts[tid] = (int)__hip_atomic_load(cntG + tid, RLX_AGENT);
            __syncthreads();
            if (tid == 0) { int s = 0; for (int e = 0; e < 64; ++e) { tstart[e] = s; s += (cnts[e] + 255) >> 8; } tstart[64] = s; }
            __syncthreads();
            if (tid < 64) for (int t = tstart[tid]; t < tstart[tid + 1]; ++t) tile_e[t] = tid;
            __syncthreads();
            ntiles = __builtin_amdgcn_readfirstlane(tstart[64]); if (ntiles > MAXTILES) ntiles = MAXTILES;
        }

        for (int rep_ = 0; rep_ < REP(7); ++rep_)
        if (EN(7) && IN(pb + 6)) { PHASE_PTRS
            { pg8::MoeSched<true> S{cnts, tstart, tile_e, ntiles, 4, G, vcu, DM, list, WLp + WL_GU, W_GU_B};
              pg8::EpiSwiGLU E{Hs};
              pg8::gemm_phase<pg8::EpiSwiGLU, pg8::MoeSched<true>, true>(lds, (const char*)Hb, DM, S, E, wave); }
            { pg8::PlainSched S; S.init(NTOK, 1024, DM, G, bx, WLp + WL_GU + 64 * W_GU_B);
              pg8::EpiSwiGLU E{Hs + (size_t)SH_ROW0 * DE};
              pg8::gemm_phase<pg8::EpiSwiGLU, pg8::PlainSched, true>(lds, (const char*)Hb, DM, S, E, wave); }
        }
        SEAM(pb + 6);

        if (EN(8) && IN(pb + 7)) { PHASE_PTRS
#if !defined(HSEL) || HSEL == 1
            for (int rep_ = 0; rep_ < REP(8); ++rep_)
            { pg8::MoeSched<false> S{cnts, tstart, tile_e, ntiles, 8, G, vcu, DE, nullptr, WLp + WL_D, W_D_B};
              pg8::EpiDownY E{Yb, wlist};
              pg8::gemm_phase<pg8::EpiDownY, pg8::MoeSched<false>, true>(lds, (const char*)Hs, DE, S, E, wave); }
#endif
#if !defined(HSEL) || HSEL == 2
            { pg8::PlainSched S; S.init(NTOK, DM, DE, G, bx, WLp + WL_D + 64 * W_D_B);
              pg8::EpiResF32 E{Hf, DM, ALPHA};
              pg8::gemm_phase<pg8::EpiResF32, pg8::PlainSched, true>(lds, (const char*)(Hs + (size_t)SH_ROW0 * DE), DE, S, E, wave); }
#endif
        }
        SEAM(pb + 7);

        if (EN(9) && IN(pb + 8)) { PHASE_TID PHASE_PTRS
            const int gw = vcu * NWAVES + wave, NGW = G * NWAVES;
            for (int tok = gw; tok < NTOK; tok += NGW) {
                f32x4 v[8];
#pragma unroll
                for (int j = 0; j < 8; ++j) v[j] = ((const f32x4*)(Hf + (size_t)tok * DM))[j * 64 + lane];
                const int myslot = slot[(size_t)tok * 8 + (lane & 7)];
#pragma unroll
                for (int k = 0; k < 8; ++k) { const int sl = __shfl(myslot, k); const int e = sl >> 16, pos = sl & 0xffff; const size_t row = (size_t)tstart[e] * 256 + pos;
                    const u32x2* yp = (const u32x2*)(Yb + row * DM);
#pragma unroll
                    for (int j = 0; j < 8; ++j) { const u32x2 w = yp[j * 64 + lane]; v[j].x += bflo(w.x); v[j].y += bfhi(w.x); v[j].z += bflo(w.y); v[j].w += bfhi(w.y); } }
                ln_regs(v, ln2_g + (size_t)l * DM, ln2_b + (size_t)l * DM, lane);
                if (l == 0) { store_row_f32(Hf + (size_t)tok * DM, v, lane); store_row_bf16(Hb + (size_t)tok * DM, v, lane); }
                else store_row_f32(OUTP + (size_t)tok * DM, v, lane);
            }
        }
        SEAM(pb + 8);
    }
#undef IN
#undef SEAM
}

constexpr int NPHASES = 19;
#ifndef ONE_LAUNCH
#define ONE_LAUNCH 1
#endif

extern "C" void kernel_launch(void* const* d_in, const int* in_sizes, int n_in, void* d_out, int out_size, void* d_ws, size_t ws_size, hipStream_t stream) {
    static int grid = 0;
    if (grid == 0) {
        if (n_in != 25 || out_size != NTOK * DM || ws_size < WS_END) { fprintf(stderr, "kernel_launch: unexpected shapes: n_in %d out %d ws %zu (need %zu)\n", n_in, out_size, ws_size, (size_t)WS_END); grid = -1; return; }
        int dev = 0, cus = 0, per_cu = 0;
        if (hipGetDevice(&dev) != hipSuccess || hipDeviceGetAttribute(&cus, hipDeviceAttributeMultiprocessorCount, dev) != hipSuccess) { grid = -1; return; }
        if (hipFuncSetAttribute((const void*)fwd_kernel, hipFuncAttributeMaxDynamicSharedMemorySize, LDS_BYTES) != hipSuccess) { fprintf(stderr, "kernel_launch: hipFuncSetAttribute failed\n"); grid = -1; return; }
        if (hipOccupancyMaxActiveBlocksPerMultiprocessor(&per_cu, (const void*)fwd_kernel, NTHR, LDS_BYTES) != hipSuccess || per_cu < 1) fprintf(stderr, "kernel_launch: occupancy query reports %d\n", per_cu);
        (void)hipGetLastError();
        grid = cus;
    }
    if (grid < 0) return;
    if (hipMemsetAsync((char*)d_ws + WS_CTL, 0, CTL_ZERO_BYTES, stream) != hipSuccess) return;
    Args a{};
    for (int i = 0; i < 25; ++i) a.in[i] = (const float*)d_in[i];
    a.out = (float*)d_out; a.ws = (unsigned char*)d_ws; a.pad = 0;
#if ONE_LAUNCH
    a.ph_lo = 0; a.ph_hi = NPHASES; a.use_bar = 1;
    hipLaunchKernelGGL(fwd_kernel, dim3(grid), dim3(NTHR), LDS_BYTES, stream, a);
#else
    for (int p = 0; p < NPHASES; ++p) { a.ph_lo = p; a.ph_hi = p + 1; a.use_bar = 0; hipLaunchKernelGGL(fwd_kernel, dim3(grid), dim3(NTHR), LDS_BYTES, stream, a); }
#endif
}
```

```cpp
#include <hip/hip_runtime.h>
#include <cstdio>
#include <cstdint>

#define GAS __attribute__((address_space(1)))
#define LAS __attribute__((address_space(3)))
typedef unsigned short bf16;
typedef unsigned short bf16_t;
typedef short bf16x8 __attribute__((ext_vector_type(8)));
typedef float f32x4 __attribute__((ext_vector_type(4)));
typedef float f32x2 __attribute__((ext_vector_type(2)));
typedef unsigned u32x4 __attribute__((ext_vector_type(4)));
typedef unsigned u32x2 __attribute__((ext_vector_type(2)));

constexpr int NTOK = 16384, DM = 2048, DIN = 4352, SEQ = 4096, NBATCH = 4;
constexpr int NE = 64, TOPK = 8, DE = 512;
constexpr float ALPHA = 1.4142135623730951f, LN_EPS = 1e-5f, RMS_EPS = 1e-6f, ROUTED_SCALE = 2.5f;
constexpr int C_HQ = 0, C_HF = 512, C_HI = 1024, C_HG = 1536, C_AQ = 2048, C_AK = 3072, C_AV = 3200, C_SU = 3328, C_SV = 3840;
constexpr int MAXTILES = 576;
constexpr int SH_ROW0 = MAXTILES * 256;
constexpr int HS_ROWS = SH_ROW0 + NTOK;

constexpr size_t MiB = 1u << 20;
constexpr size_t WS_CTL = 0, CTL_ZERO_BYTES = 1 * MiB;
constexpr size_t WS_LIST = 1 * MiB;
constexpr size_t WS_WLIST = 5 * MiB;
constexpr size_t WS_SLOT = 9 * MiB;
constexpr size_t WS_RT = 12 * MiB;
constexpr size_t WS_DEND = 10 * MiB;
constexpr size_t WS_STATE = 16 * MiB;
constexpr size_t WS_HF = 64 * MiB;
constexpr size_t WS_HB = 192 * MiB;
constexpr size_t WS_PROJ = 256 * MiB;
constexpr size_t WS_MIXED = 392 * MiB;
constexpr size_t WS_HS = 456 * MiB;
constexpr size_t WS_Y = 616 * MiB;
constexpr size_t WS_W = 1192 * MiB;
constexpr size_t W_IN_B = (size_t)DIN * DM * 2, W_OUT_B = (size_t)DM * DM * 2, W_GU_B = (size_t)1024 * DM * 2, W_D_B = (size_t)DM * DE * 2;
constexpr size_t WL_IN = 0, WL_OUT = W_IN_B, WL_GU = WL_OUT + W_OUT_B, WL_D = WL_GU + 65 * W_GU_B, WL_BYTES = WL_D + 65 * W_D_B;
constexpr size_t WS_END = WS_W + 2 * WL_BYTES;
static_assert(WS_HS + (size_t)HS_ROWS * 512 * 2 <= WS_Y && WS_Y + (size_t)MAXTILES * 256 * DM * 2 <= WS_W && WS_END <= 2048 * MiB, "d_ws map");
constexpr int CW_CNT = 64;
constexpr int CW_BAR = 4096;

constexpr int LDS_BYTES = 147456;
constexpr int MISC_OFF = LDS_BYTES - 256;
constexpr int TAB_OFF = 131072;
constexpr int NWAVES = 8, NTHR = 512;

#define LDS_WAIT() asm volatile("s_waitcnt lgkmcnt(0)" ::: "memory")
#define VM_WAIT() asm volatile("s_waitcnt vmcnt(0)" ::: "memory")
#define RLX_AGENT __ATOMIC_RELAXED, __HIP_MEMORY_SCOPE_AGENT

__device__ __forceinline__ unsigned f2bf(float f) { unsigned u = __builtin_bit_cast(unsigned, f); return (u + 0x7fffu + ((u >> 16) & 1u)) >> 16; }
__device__ __forceinline__ unsigned pk2(float lo, float hi) { return f2bf(lo) | (f2bf(hi) << 16); }
__device__ __forceinline__ float bflo(unsigned w) { return __uint_as_float(w << 16); }
__device__ __forceinline__ float bfhi(unsigned w) { return __uint_as_float(w & 0xffff0000u); }
__device__ __forceinline__ float bf2f(bf16 v) { return __uint_as_float((unsigned)v << 16); }
__device__ __forceinline__ float wave_sum(float v) {
#pragma unroll
    for (int o = 1; o < 64; o <<= 1) v += __shfl_xor(v, o);
    return v;
}
__device__ __forceinline__ int tid_of_wave(int wave) {
    int l; asm volatile("v_mbcnt_lo_u32_b32 %0, -1, 0\n\tv_mbcnt_hi_u32_b32 %0, -1, %0" : "=v"(l)); return wave * 64 + l; }
__device__ __forceinline__ float sigmoidf_(float x) { return 1.0f / (1.0f + __expf(-x)); }
__device__ __forceinline__ float siluf_(float x) { return x / (1.0f + __expf(-x)); }
__device__ __forceinline__ float geluf_(float x) { return 0.5f * x * (1.0f + erff(x * 0.70710678118654752f)); }

namespace pg8 {
#define PG8_LAS __attribute__((address_space(3)))
constexpr int BM = 256, BK = 64, HALF = 128, HTB = HALF * BK * 2, STAGE_BYTES = 8 * HTB, NXCD = 8, WGM = 8;
__host__ __device__ __forceinline__ int lds_byte(int r, int c) { const int st = (r >> 4) * 2 + (c >> 5), rr = r & 15, cc = c & 31, ob = rr * 64 + cc * 2; return st * 1024 + (ob ^ (((ob >> 9) & 1) << 5)); }
__host__ __device__ __forceinline__ void stage_rc(int b, int& R, int& C) { const int st = b / 1024, sb = b % 1024, swz = sb ^ (((sb >> 9) & 1) << 5); R = (st >> 1) * 16 + swz / 64; C = (st & 1) * 32 + (swz % 64) / 2; }
__host__ __device__ __forceinline__ int perm32(int rho) { const int n = rho >> 4, i = rho & 15; return 8 * (i >> 2) + 4 * n + (i & 3); }

struct Unit { int pm, pn, e, p0, nv; };

__device__ __forceinline__ unsigned cvt_pk_bf16(float lo, float hi) { unsigned r; asm volatile("v_cvt_pk_bf16_f32 %0, %1, %2" : "=v"(r) : "v"(lo), "v"(hi)); return r; }

struct PlainSched {
    static constexpr bool GATHER = false;
    int nM, nN, nwg, G, c, K; const char* Bt;
    __device__ void init(int M, int N, int K_, int G_, int c_, const void* Bt_) { nM = M / BM; nN = N / BM; nwg = nM * nN; G = G_; c = c_; K = K_; Bt = (const char*)Bt_; }
    __device__ __forceinline__ bool next(int i, Unit& u) const {
        const long L = (long)i * G + c; if (L >= nwg) return false;
        int wgid = (int)L; { const int q = nwg / NXCD, r = nwg % NXCD, xcd = wgid % NXCD, off = wgid / NXCD; wgid = (xcd < r ? xcd * (q + 1) : r * (q + 1) + (xcd - r) * q) + off; }
        const int nig = WGM * nN, gid = wgid / nig, fm = gid * WGM, gsz = (nM - fm) < WGM ? (nM - fm) : WGM;
        u.pm = fm + ((wgid % nig) % gsz); u.pn = (wgid % nig) / gsz; u.e = 0; u.p0 = 0; u.nv = 256; return true;
    }
    __device__ __forceinline__ unsigned arow(const Unit& u, int r) const { return 0u; }
    __device__ __forceinline__ size_t aoff(const Unit& u) const { return (size_t)u.pm * BM * K * 2; }
    __device__ __forceinline__ const char* bbase(const Unit& u) const { return Bt + (size_t)u.pn * BM * K * 2; }
};
template <bool GATHER_> struct MoeSched {
    static constexpr bool GATHER = GATHER_;
    const PG8_LAS int* cnts; const PG8_LAS int* tstart; const PG8_LAS int* tile_e;
    int ntiles, npn, G, vcu, K; const int* list; const char* Bt; size_t estride;
    __device__ __forceinline__ bool next(int i, Unit& u) const {
        const int U = i * G + vcu; if (U >= ntiles * npn) return false;
        u.pm = U / npn; u.pn = U % npn; u.e = __builtin_amdgcn_readfirstlane(tile_e[u.pm]); u.p0 = (u.pm - __builtin_amdgcn_readfirstlane(tstart[u.e])) * BM; const int rem = __builtin_amdgcn_readfirstlane(cnts[u.e]) - u.p0; u.nv = rem < BM ? rem : BM; return true;
    }
    __device__ __forceinline__ unsigned arow(const Unit& u, int r) const { const int tok = (r < u.nv) ? list[u.e * NTOK + u.p0 + r] : 0; return (unsigned)tok * (unsigned)(K * 2); }
    __device__ __forceinline__ size_t aoff(const Unit& u) const { return (size_t)u.pm * BM * K * 2; }
    __device__ __forceinline__ const char* bbase(const Unit& u) const { return Bt + (size_t)u.e * estride + (size_t)u.pn * BM * K * 2; }
};

struct EpiBf16Bias {
    static constexpr bool PERM = true;
    bf16_t* O; int ldc; const float* bias;
    __device__ __forceinline__ void operator()(const f32x4 (&acc)[2][2][4][2], const Unit& u, int wr, int wc, int fr, int fq) const {
        const int row0 = u.pm * BM + wr * 64 + fr, col0 = u.pn * BM + wc * 32 + 8 * fq;
        f32x4 bv[2][2];
#pragma unroll
        for (int bj = 0; bj < 2; ++bj)
#pragma unroll
            for (int n = 0; n < 2; ++n) bv[bj][n] = *(const f32x4*)(bias + col0 + bj * HALF + 4 * n);
#pragma unroll
        for (int ai = 0; ai < 2; ++ai)
#pragma unroll
            for (int m = 0; m < 4; ++m) { bf16_t* rowp = O + (size_t)(row0 + ai * HALF + m * 16) * ldc + col0;
#pragma unroll
                for (int bj = 0; bj < 2; ++bj) { const f32x4 v0 = acc[ai][bj][m][0] + bv[bj][0], v1 = acc[ai][bj][m][1] + bv[bj][1];
                    u32x4 w; w.x = cvt_pk_bf16(v0[0], v0[1]); w.y = cvt_pk_bf16(v0[2], v0[3]); w.z = cvt_pk_bf16(v1[0], v1[1]); w.w = cvt_pk_bf16(v1[2], v1[3]);
                    *(u32x4*)(rowp + bj * HALF) = w; } }
    }
};
struct EpiResF32 {
    static constexpr bool PERM = false;
    float* C; int ldc; float alpha;
    __device__ __forceinline__ void operator()(const f32x4 (&acc)[2][2][4][2], const Unit& u, int wr, int wc, int fr, int fq) const {
        const int row0 = u.pm * BM + wr * 64 + fr, col0 = u.pn * BM + wc * 32 + 4 * fq;
#pragma unroll
        for (int ai = 0; ai < 2; ++ai)
#pragma unroll
            for (int m = 0; m < 4; ++m) { float* rowp = C + (size_t)(row0 + ai * HALF + m * 16) * ldc + col0;
#pragma unroll
                for (int bj = 0; bj < 2; ++bj)
#pragma unroll
                    for (int n = 0; n < 2; ++n) { f32x4* p = (f32x4*)(rowp + bj * HALF + n * 16); const f32x4 o = *p; *p = o * alpha + acc[ai][bj][m][n]; } }
    }
};
struct EpiSwiGLU {
    static constexpr bool PERM = true;
    bf16_t* O;
    __device__ __forceinline__ void operator()(const f32x4 (&acc)[2][2][4][2], const Unit& u, int wr, int wc, int fr, int fq) const {
        const int row0 = u.pm * BM + wr * 64 + fr, col0 = u.pn * HALF + wc * 32 + 8 * fq;
#pragma unroll
        for (int ai = 0; ai < 2; ++ai)
#pragma unroll
            for (int m = 0; m < 4; ++m) { bf16_t* rowp = O + (size_t)(row0 + ai * HALF + m * 16) * DE + col0;
                float o[8];
#pragma unroll
                for (int n = 0; n < 2; ++n)
#pragma unroll
                    for (int j = 0; j < 4; ++j) { const float g = acc[ai][0][m][n][j], up = acc[ai][1][m][n][j]; o[n * 4 + j] = g / (1.0f + __expf(-g)) * up; }
                u32x4 w; w.x = cvt_pk_bf16(o[0], o[1]); w.y = cvt_pk_bf16(o[2], o[3]); w.z = cvt_pk_bf16(o[4], o[5]); w.w = cvt_pk_bf16(o[6], o[7]);
                *(u32x4*)rowp = w; }
    }
};
struct EpiDownY {
    static constexpr bool PERM = true;
    bf16_t* Y; const float* wlist;
    __device__ __forceinline__ void operator()(const f32x4 (&acc)[2][2][4][2], const Unit& u, int wr, int wc, int fr, int fq) const {
        const int rl0 = wr * 64 + fr, col0 = u.pn * BM + wc * 32 + 8 * fq;
#pragma unroll
        for (int ai = 0; ai < 2; ++ai)
#pragma unroll
            for (int m = 0; m < 4; ++m) { const int rl = rl0 + ai * HALF + m * 16; const float w8 = (rl < u.nv) ? wlist[u.e * NTOK + u.p0 + rl] : 0.f;
                bf16_t* rowp = Y + (size_t)(u.pm * BM + rl) * DM + col0;
#pragma unroll
                for (int bj = 0; bj < 2; ++bj) { const f32x4 v0 = acc[ai][bj][m][0] * w8, v1 = acc[ai][bj][m][1] * w8;
                    u32x4 w; w.x = cvt_pk_bf16(v0[0], v0[1]); w.y = cvt_pk_bf16(v0[2], v0[3]); w.z = cvt_pk_bf16(v1[0], v1[1]); w.w = cvt_pk_bf16(v1[2], v1[3]);
                    *(u32x4*)(rowp + bj * HALF) = w; } }
    }
};

template <class Epi, class Sched, bool ALIGN_EPI>
__device__ __forceinline__ void gemm_phase(PG8_LAS unsigned char* lds, const char* Abase, const int K, const Sched& S, const Epi& E, const int wave_s) {
    int tid_ = tid_of_wave(wave_s); asm volatile("" : "+v"(tid_));
    const int tid = tid_, wid = __builtin_amdgcn_readfirstlane(tid >> 6), lane = tid & 63, wr = wid >> 2, wc = wid & 3, fr = lane & 15, fq = lane >> 4;
    const int nt = K / BK;
    int RA[2]; unsigned CA2[2], voffB[2];
#pragma unroll
    for (int i = 0; i < 2; ++i) { int R, C; stage_rc(tid * 16 + i * 8192, R, C); const int Rb = Epi::PERM ? ((R & ~31) + perm32(R & 31)) : R;
        RA[i] = R; CA2[i] = (unsigned)C * 2u; voffB[i] = (unsigned)(Rb * K + C) * 2u; }
    const size_t kstep = (size_t)(BK * 2);
    const size_t hstep = (size_t)HALF * K * 2;
    const unsigned ldsw = (unsigned)wid * 1024u;
    const int aoff = lds_byte(wr * 64 + fr, fq * 8), boff = lds_byte(wc * 32 + fr, fq * 8);
#define PG8_SA(b, h) (((b) * 2 + (h)) * HTB)
#define PG8_SB(b, h) ((4 + (b) * 2 + (h)) * HTB)
#define PG8_STAGE(bufoff, gbase, voff) do { _Pragma("unroll") for (int _i = 0; _i < 2; ++_i) \
        __builtin_amdgcn_global_load_lds((const unsigned*)((const char*)(gbase) + (voff)[_i]), (PG8_LAS unsigned*)(lds + (bufoff) + ldsw + _i * 8192), 16, 0, 0); } while (0)
#define PG8_LDA(dst, b, h) do { _Pragma("unroll") for (int m = 0; m < 4; ++m) _Pragma("unroll") for (int k = 0; k < 2; ++k) dst[m][k] = *(const PG8_LAS bf16x8*)(lds + PG8_SA(b, h) + aoff + m * 2048 + k * 1024); } while (0)
#define PG8_LDB(dst, b, h) do { _Pragma("unroll") for (int n = 0; n < 2; ++n) _Pragma("unroll") for (int k = 0; k < 2; ++k) dst[n][k] = *(const PG8_LAS bf16x8*)(lds + PG8_SB(b, h) + boff + n * 2048 + k * 1024); } while (0)
#define PG8_MMA(ai, bj, At, Bt) do { __builtin_amdgcn_s_setprio(1); _Pragma("unroll") for (int m = 0; m < 4; ++m) _Pragma("unroll") for (int n = 0; n < 2; ++n) _Pragma("unroll") for (int k = 0; k < 2; ++k) \
        acc[ai][bj][m][n] = __builtin_amdgcn_mfma_f32_16x16x32_bf16(Bt[n][k], At[m][k], acc[ai][bj][m][n], 0, 0, 0); __builtin_amdgcn_s_setprio(0); } while (0)
#define PG8_WAIT_V(n) asm volatile("s_waitcnt vmcnt(" #n ")" ::: "memory")
#define PG8_WAIT_L(n) asm volatile("s_waitcnt lgkmcnt(" #n ")" ::: "memory")
#define PG8_BAR __builtin_amdgcn_s_barrier()
#define PG8_SCHED __builtin_amdgcn_sched_barrier(0)
    Unit cur, nxt; int ui = 0;
    if (!S.next(0, cur)) return;
    f32x4 acc[2][2][4][2];
#pragma unroll
    for (int a = 0; a < 2; ++a)
#pragma unroll
        for (int b = 0; b < 2; ++b)
#pragma unroll
            for (int m = 0; m < 4; ++m)
#pragma unroll
                for (int n = 0; n < 2; ++n) acc[a][b][m][n] = (f32x4){0.f, 0.f, 0.f, 0.f};
    bf16x8 At[4][2], B0[2][2], B1[2][2];
    unsigned voffA[2], ca0[2], ca1[2], na0[2], na1[2];
#pragma unroll
    for (int i = 0; i < 2; ++i) { voffA[i] = (unsigned)(RA[i] * K) * 2u + CA2[i]; ca0[i] = ca1[i] = na0[i] = na1[i] = 0u; }
    const char* cA = Abase; const char* cB = S.bbase(cur);
    if constexpr (Sched::GATHER) {
#pragma unroll
        for (int i = 0; i < 2; ++i) { ca0[i] = S.arow(cur, RA[i]) + CA2[i]; ca1[i] = S.arow(cur, HALF + RA[i]) + CA2[i]; }
    } else cA = Abase + S.aoff(cur);
#define PG8_STAGE_A(bufoff, p, h, g0, g1) do { if constexpr (Sched::GATHER) { if ((h) == 0) PG8_STAGE(bufoff, p, g0); else PG8_STAGE(bufoff, p, g1); } \
        else { PG8_STAGE(bufoff, (p) + (h) * hstep, voffA); } } while (0)
    PG8_STAGE(PG8_SB(0, 0), cB, voffB); PG8_STAGE(PG8_SB(0, 1), cB + hstep, voffB); PG8_STAGE_A(PG8_SA(0, 0), cA, 0, ca0, ca1); PG8_STAGE_A(PG8_SA(0, 1), cA, 1, ca0, ca1);
    if (wr == 1) PG8_BAR;
    PG8_WAIT_V(2); PG8_BAR;
    PG8_STAGE(PG8_SB(1, 0), cB + kstep, voffB); PG8_STAGE_A(PG8_SA(1, 0), cA + kstep, 0, ca0, ca1); PG8_STAGE(PG8_SB(1, 1), cB + hstep + kstep, voffB);
    PG8_WAIT_V(6); PG8_BAR;
    for (;;) {
        const bool has_next = S.next(ui + 1, nxt);
        const char* nA = cA; const char* nB = has_next ? S.bbase(nxt) : cB;
        if constexpr (Sched::GATHER) {
            if (has_next) {
#pragma unroll
                for (int i = 0; i < 2; ++i) { na0[i] = S.arow(nxt, RA[i]) + CA2[i]; na1[i] = S.arow(nxt, HALF + RA[i]) + CA2[i]; }
            } else {
#pragma unroll
                for (int i = 0; i < 2; ++i) { na0[i] = ca0[i]; na1[i] = ca1[i]; }
            }
        } else { if (has_next) nA = Abase + S.aoff(nxt); }
        for (int t = 0; t < nt; t += 2) {
            const bool last = (t == nt - 2);
            const char* a1 = cA + (size_t)(t + 1) * kstep;
            const char* a2 = last ? nA : cA + (size_t)(t + 2) * kstep; const char* b2 = last ? nB : cB + (size_t)(t + 2) * kstep;
            const char* a3 = a2 + kstep; const char* b3 = b2 + kstep;
            unsigned s0[2], s1[2];
#pragma unroll
            for (int i = 0; i < 2; ++i) { s0[i] = last ? na0[i] : ca0[i]; s1[i] = last ? na1[i] : ca1[i]; }
            PG8_LDB(B0, 0, 0); PG8_LDB(B1, 0, 1); PG8_SCHED; PG8_LDA(At, 0, 0); PG8_STAGE_A(PG8_SA(1, 1), a1, 1, ca0, ca1);
            PG8_WAIT_V(8); PG8_WAIT_L(0); PG8_BAR; PG8_MMA(0, 0, At, B0); PG8_MMA(0, 1, At, B1); PG8_BAR; PG8_SCHED;
            PG8_LDA(At, 0, 1); PG8_STAGE(PG8_SB(0, 0), b2, voffB); PG8_STAGE(PG8_SB(0, 1), b2 + hstep, voffB); PG8_STAGE_A(PG8_SA(0, 0), a2, 0, s0, s1);
            PG8_WAIT_V(8); PG8_WAIT_L(0); PG8_BAR; PG8_MMA(1, 0, At, B0); PG8_MMA(1, 1, At, B1); PG8_BAR; PG8_SCHED;
            PG8_LDB(B0, 1, 0); PG8_LDB(B1, 1, 1); PG8_SCHED; PG8_LDA(At, 1, 0); PG8_STAGE_A(PG8_SA(0, 1), a2, 1, s0, s1);
            PG8_WAIT_V(8); PG8_WAIT_L(0); PG8_BAR; PG8_MMA(0, 0, At, B0); PG8_MMA(0, 1, At, B1); PG8_BAR; PG8_SCHED;
            PG8_LDA(At, 1, 1); PG8_STAGE(PG8_SB(1, 0), b3, voffB); PG8_STAGE(PG8_SB(1, 1), b3 + hstep, voffB); PG8_STAGE_A(PG8_SA(1, 0), a3, 0, s0, s1);
            PG8_WAIT_V(8); PG8_WAIT_L(0); PG8_BAR; PG8_MMA(1, 0, At, B0); PG8_MMA(1, 1, At, B1); PG8_BAR; PG8_SCHED;
        }
        if constexpr (ALIGN_EPI) { if (wr == 0) PG8_BAR; }
        E(acc, cur, wr, wc, fr, fq);
        if (!has_next) break;
#pragma unroll
        for (int a = 0; a < 2; ++a)
#pragma unroll
            for (int b = 0; b < 2; ++b)
#pragma unroll
                for (int m = 0; m < 4; ++m)
#pragma unroll
                    for (int n = 0; n < 2; ++n) acc[a][b][m][n] = (f32x4){0.f, 0.f, 0.f, 0.f};
        cur = nxt; cA = nA; cB = nB; ++ui;
        if constexpr (Sched::GATHER) {
#pragma unroll
            for (int i = 0; i < 2; ++i) { ca0[i] = na0[i]; ca1[i] = na1[i]; }
        }
        if constexpr (ALIGN_EPI) { if (wr == 1) PG8_BAR; }
    }
    PG8_WAIT_V(0);
    if constexpr (!ALIGN_EPI) { if (wr == 0) PG8_BAR; }
    PG8_BAR;
#undef PG8_SA
#undef PG8_SB
#undef PG8_STAGE
#undef PG8_LDA
#undef PG8_LDB
#undef PG8_MMA
#undef PG8_WAIT_V
#undef PG8_WAIT_L
#undef PG8_BAR
#undef PG8_SCHED
#undef PG8_STAGE_A
}
}

#define XB_TMO      128
#define XB_XCNT(j)  (256  + 64 * (j))
#define XB_XSUB(j)  (1280 + 64 * (j))
#define XB_XGEN(j)  (2304 + 64 * (j))
#define XB_TOP      3328
#define XB_TOPGEN   3392
#define XCD_BAR_WORDS 3456
#define XB_SPIN_CAP (1u << 18)
__device__ __forceinline__ unsigned xb_ld(unsigned* p)              { return __hip_atomic_load(p, __ATOMIC_RELAXED, __HIP_MEMORY_SCOPE_AGENT); }
__device__ __forceinline__ unsigned xb_add(unsigned* p, unsigned v) { return __hip_atomic_fetch_add(p, v, __ATOMIC_RELAXED, __HIP_MEMORY_SCOPE_AGENT); }
__device__ __forceinline__ unsigned xb_xcc_id() { return (unsigned)__builtin_amdgcn_s_getreg((3 << 11) | 20) & 0xFu; }
#define XB_SPIN(cond, bar) do { unsigned _sp = 0; while (cond) { __builtin_amdgcn_s_sleep(1); \
    if ((++_sp & 255u) == 0u) { if (xb_ld(&(bar)[XB_TMO])) break; if (_sp > XB_SPIN_CAP) { atomicAdd(&(bar)[XB_TMO], 1u); break; } } } } while (0)
struct XcdBarrier { unsigned* bar; unsigned x; volatile LAS unsigned* st; };
__device__ __forceinline__ XcdBarrier xcd_barrier_post(unsigned* bar, volatile LAS unsigned* st) {
    XcdBarrier b; b.bar = bar; b.x = xb_xcc_id(); b.st = st;
    if (threadIdx.x == 0) (void)xb_add(&bar[XB_XCNT(b.x)], 1u);
    return b;
}
__device__ __forceinline__ void xcd_barrier_complete(unsigned* bar, unsigned x, unsigned& nloc, unsigned& nx) {
    const unsigned G = gridDim.x * gridDim.y * gridDim.z;
    unsigned sum, cnt, mine, sp = 0u;
    for (;;) {
        sum = 0u; cnt = 0u; mine = 0u;
#pragma unroll
        for (unsigned j = 0; j < 16; ++j) { const unsigned c = xb_ld(&bar[XB_XCNT(j)]); sum += c; cnt += (c > 0u) ? 1u : 0u; mine = (j == x) ? c : mine; }
        if (sum == G) break;
        __builtin_amdgcn_s_sleep(1);
        if ((++sp & 255u) == 0u) { if (xb_ld(&bar[XB_TMO])) break; if (sp > XB_SPIN_CAP) { atomicAdd(&bar[XB_TMO], 1u); break; } }
    }
    nloc = mine > 0u ? mine : 1u; nx = cnt > 0u ? cnt : 1u;
}
__device__ __forceinline__ void xcd_barrier(const XcdBarrier& b, const int wave_s) {
    asm volatile("s_waitcnt vmcnt(0)" ::: "memory");
    __syncthreads();
    if (tid_of_wave(wave_s) == 0) {
        unsigned* bar = b.bar;
        __builtin_amdgcn_s_waitcnt(0);
        unsigned nloc = b.st[0], nx = b.st[1];
        if (nloc == 0u) { xcd_barrier_complete(bar, b.x, nloc, nx); b.st[0] = nloc; b.st[1] = nx; }
        const unsigned old = xb_add(&bar[XB_XSUB(b.x)], 1u);
        const unsigned gen = old / nloc;
        if (old + 1u == (gen + 1u) * nloc) {
            __builtin_amdgcn_fence(__ATOMIC_RELEASE, "agent");
            asm volatile("s_waitcnt vmcnt(0)" ::: "memory");
            const unsigned og = xb_add(&bar[XB_TOP], 1u);
            const unsigned tg = og / nx;
            if (og + 1u == (tg + 1u) * nx) xb_add(&bar[XB_TOPGEN], 1u);
            else XB_SPIN(xb_ld(&bar[XB_TOPGEN]) == tg, bar);
            __builtin_amdgcn_fence(__ATOMIC_ACQUIRE, "agent");
            xb_add(&bar[XB_XGEN(b.x)], 1u);
            asm volatile("s_waitcnt vmcnt(0)" ::: "memory");
        } else {
            XB_SPIN(xb_ld(&bar[XB_XGEN(b.x)]) == gen, bar);
            __builtin_amdgcn_fence(__ATOMIC_ACQUIRE, "agent");
            asm volatile("s_waitcnt vmcnt(0)" ::: "memory");
        }
    }
    __syncthreads();
}

struct Args { const float* in[25]; float* out; unsigned char* ws; int ph_lo, ph_hi, use_bar, pad; };
struct Frame {
    LAS unsigned char* lds; unsigned* ctl; int tid, lane, wave, vcu, G;
    const float* const* in_;
};

__device__ __forceinline__ void transpose_item(const float* W, int K, int N, bf16* WT, int mode, LAS float* scr, int item, int lane) {
    const int nblk = N / 32, kb = item / nblk, nb = item % nblk, k0 = 64 * kb, n0 = 32 * nb;
#pragma unroll 8
    for (int i = 0; i < 32; ++i) { const int kk = 2 * i + (lane >> 5); scr[kk * 33 + (lane & 31)] = W[(size_t)(k0 + kk) * N + n0 + (lane & 31)]; }
    LDS_WAIT(); asm volatile("" ::: "memory");
    const int r0 = mode ? ((n0 >> 7) * 256 + (n0 & 127) + (mode == 2 ? 128 : 0)) : n0;
    const int c = lane & 7;
#pragma unroll
    for (int j = 0; j < 4; ++j) { const int n = (lane >> 3) + 8 * j; const LAS float* s = scr + (8 * c) * 33 + n;
        u32x4 o; o.x = pk2(s[0 * 33], s[1 * 33]); o.y = pk2(s[2 * 33], s[3 * 33]); o.z = pk2(s[4 * 33], s[5 * 33]); o.w = pk2(s[6 * 33], s[7 * 33]);
        *(u32x4*)(WT + (size_t)(r0 + n) * K + k0 + 8 * c) = o; }
    LDS_WAIT(); asm volatile("" ::: "memory");
}
constexpr int IT_IN = (DM / 64) * (DIN / 32), IT_OUT = (DM / 64) * (DM / 32), IT_G = (DM / 64) * (DE / 32), IT_D = (DE / 64) * (DM / 32);
constexpr int IT_LAYER = IT_IN + IT_OUT + 65 * (2 * IT_G + IT_D);

__device__ __forceinline__ void ln_regs(f32x4 (&v)[8], const float* gain, const float* bias, int lane) {
    float s = 0.f;
#pragma unroll
    for (int j = 0; j < 8; ++j) s += (v[j].x + v[j].y) + (v[j].z + v[j].w);
    const float mean = wave_sum(s) * (1.f / DM); float s2 = 0.f;
#pragma unroll
    for (int j = 0; j < 8; ++j) { v[j] = v[j] - mean; s2 += (v[j].x * v[j].x + v[j].y * v[j].y) + (v[j].z * v[j].z + v[j].w * v[j].w); }
    const float rstd = 1.f / sqrtf(wave_sum(s2) * (1.f / DM) + LN_EPS);
#pragma unroll
    for (int j = 0; j < 8; ++j) { const f32x4 g = ((const f32x4*)gain)[j * 64 + lane], b = ((const f32x4*)bias)[j * 64 + lane]; v[j] = v[j] * rstd * g + b; }
}
__device__ __forceinline__ void store_row_f32(float* dst, const f32x4 (&v)[8], int lane) {
#pragma unroll
    for (int j = 0; j < 8; ++j) ((f32x4*)dst)[j * 64 + lane] = v[j];
}
__device__ __forceinline__ void store_row_bf16(bf16* dst, const f32x4 (&v)[8], int lane) {
#pragma unroll
    for (int j = 0; j < 8; ++j) { u32x2 w; w.x = pk2(v[j].x, v[j].y); w.y = pk2(v[j].z, v[j].w); ((u32x2*)dst)[j * 64 + lane] = w; }
}


typedef float f32x16 __attribute__((ext_vector_type(16)));
#define MFMA32(a, b, c) __builtin_amdgcn_mfma_f32_32x32x16_bf16((a), (b), (c), 0, 0, 0)
__device__ __forceinline__ int krow16(int r, int h) { return (r & 3) + 8 * (r >> 2) + 4 * h; }
__device__ __forceinline__ bf16x8 pack8(const f32x16& x, int s) {
    u32x4 p; p.x = pk2(x[8 * s], x[8 * s + 1]); p.y = pk2(x[8 * s + 2], x[8 * s + 3]); p.z = pk2(x[8 * s + 4], x[8 * s + 5]); p.w = pk2(x[8 * s + 6], x[8 * s + 7]);
    return __builtin_bit_cast(bf16x8, p);
}
constexpr int SWA_KS_BYTES = 192 * 128, SWA_VT_STRIDE = 196, SWA_VT_BYTES = 64 * SWA_VT_STRIDE * 2;
__device__ __forceinline__ void swa_unit(LAS unsigned char* lds, const bf16* projp, bf16* mixedp, const float* sinks, const float* gain, int unit, int tid, int lane, int wave) {
    const int b = unit >> 6, blk = (unit >> 1) & 31, half = unit & 1;
    const int kp0 = blk * 128 - 128 + 64 * half, qp0 = blk * 128 + 64 * half;
    LAS unsigned char* Ks = lds;
    LAS bf16* Vt = (LAS bf16*)(lds + 2 * SWA_KS_BYTES);
    LAS float* ssq = (LAS float*)(lds + 2 * SWA_KS_BYTES + 2 * SWA_VT_BYTES);
    __syncthreads();
    for (int i = 0; i < 6; ++i) {
        const int idx = tid + NTHR * i, kvh = idx / 1536, rem = idx % 1536, s = rem >> 3, ch = rem & 7, kp = kp0 + s;
        u32x4 kw = (u32x4){0u, 0u, 0u, 0u}, vw = (u32x4){0u, 0u, 0u, 0u};
        if (kp >= 0) { const bf16* rp = projp + (size_t)(b * SEQ + kp) * DIN + kvh * 64 + ch * 8; kw = *(const u32x4*)(rp + C_AK); vw = *(const u32x4*)(rp + C_AV); }
        *(LAS u32x4*)(Ks + kvh * SWA_KS_BYTES + s * 128 + ((ch ^ (s & 7)) << 4)) = kw;
        LAS bf16* vd = Vt + kvh * (64 * SWA_VT_STRIDE) + (ch * 8) * SWA_VT_STRIDE + s;
        vd[0 * SWA_VT_STRIDE] = (bf16)(vw.x & 0xffffu); vd[1 * SWA_VT_STRIDE] = (bf16)(vw.x >> 16); vd[2 * SWA_VT_STRIDE] = (bf16)(vw.y & 0xffffu); vd[3 * SWA_VT_STRIDE] = (bf16)(vw.y >> 16);
        vd[4 * SWA_VT_STRIDE] = (bf16)(vw.z & 0xffffu); vd[5 * SWA_VT_STRIDE] = (bf16)(vw.z >> 16); vd[6 * SWA_VT_STRIDE] = (bf16)(vw.w & 0xffffu); vd[7 * SWA_VT_STRIDE] = (bf16)(vw.w >> 16);
    }
    __syncthreads();
    const int c32 = lane & 31, h = lane >> 5, kvh = wave >> 2;
    const LAS unsigned char* Kw = Ks + kvh * SWA_KS_BYTES; const LAS bf16* Vw = Vt + kvh * (64 * SWA_VT_STRIDE);
#pragma unroll 1
    for (int item = 0; item < 4; ++item) {
        const int hd = wave * 2 + (item >> 1), qi = item & 1, rho = 32 * qi + c32;
        const bf16* qp = projp + (size_t)(b * SEQ + qp0 + rho) * DIN + C_AQ + hd * 64 + 8 * h;
        bf16x8 qf[4];
#pragma unroll
        for (int ks = 0; ks < 4; ++ks) qf[ks] = __builtin_bit_cast(bf16x8, *(const u32x4*)(qp + 16 * ks));
        f32x16 X[5];
#pragma unroll
        for (int kt = 0; kt < 5; ++kt) {
            const int key = 32 * (qi + kt) + c32;
#pragma unroll
            for (int r = 0; r < 16; ++r) X[kt][r] = 0.f;
#pragma unroll
            for (int ks = 0; ks < 4; ++ks) { const bf16x8 kf = *(const LAS bf16x8*)(Kw + key * 128 + (((2 * ks + h) ^ (key & 7)) << 4)); X[kt] = MFMA32(kf, qf[ks], X[kt]); }
        }
        const float sink = sinks[hd];
        float m = sink;
#pragma unroll
        for (int kt = 0; kt < 5; ++kt)
#pragma unroll
            for (int r = 0; r < 16; ++r) { const int s = 32 * (qi + kt) + krow16(r, h); const bool valid = (s > rho) && (s <= rho + 128) && (kp0 + s >= 0);
                const float sc = valid ? X[kt][r] * 0.125f : -INFINITY; X[kt][r] = sc; m = fmaxf(m, sc); }
        m = fmaxf(m, __shfl_xor(m, 32));
        float lsum = 0.f;
#pragma unroll
        for (int kt = 0; kt < 5; ++kt)
#pragma unroll
            for (int r = 0; r < 16; ++r) { const float p = __expf(X[kt][r] - m); X[kt][r] = p; lsum += p; }
        lsum += __shfl_xor(lsum, 32); lsum += __expf(sink - m);
        f32x16 O[2];
#pragma unroll
        for (int dt = 0; dt < 2; ++dt)
#pragma unroll
            for (int r = 0; r < 16; ++r) O[dt][r] = 0.f;
#pragma unroll
        for (int kt = 0; kt < 5; ++kt)
#pragma unroll
            for (int s2 = 0; s2 < 2; ++s2) { const bf16x8 pf = pack8(X[kt], s2); const int kb = 32 * (qi + kt) + 16 * s2 + 4 * h;
#pragma unroll
                for (int dt = 0; dt < 2; ++dt) { const LAS bf16* vp = Vw + (32 * dt + c32) * SWA_VT_STRIDE + kb;
                    const u32x2 v0 = *(const LAS u32x2*)vp, v1 = *(const LAS u32x2*)(vp + 8);
                    const bf16x8 vf = __builtin_bit_cast(bf16x8, (u32x4){v0.x, v0.y, v1.x, v1.y}); O[dt] = MFMA32(vf, pf, O[dt]); } }
        const float inv = 1.0f / lsum; float ss = 0.f;
        bf16* op = mixedp + (size_t)(b * SEQ + qp0 + rho) * DM + 512 + hd * 64 + 4 * h;
#pragma unroll
        for (int dt = 0; dt < 2; ++dt)
#pragma unroll
            for (int g4 = 0; g4 < 4; ++g4) { const float o0 = O[dt][4 * g4] * inv, o1 = O[dt][4 * g4 + 1] * inv, o2 = O[dt][4 * g4 + 2] * inv, o3 = O[dt][4 * g4 + 3] * inv;
                ss += (o0 * o0 + o1 * o1) + (o2 * o2 + o3 * o3); *(u32x2*)(op + 32 * dt + 8 * g4) = (u32x2){pk2(o0, o1), pk2(o2, o3)}; }
        ss += __shfl_xor(ss, 32);
        if (h == 0) ssq[rho * 16 + hd] = ss;
    }
    __syncthreads();
#pragma unroll 1
    for (int item = 0; item < 4; ++item) {
        const int hd = wave * 2 + (item >> 1), qi = item & 1, rho = 32 * qi + c32;
        float tot = 0.f;
#pragma unroll
        for (int j = 0; j < 16; ++j) tot += ssq[rho * 16 + j];
        const float rr = 1.0f / sqrtf(tot * (1.0f / 1024.0f) + RMS_EPS);
        const float* gp = gain + 512 + hd * 64 + 4 * h;
        bf16* op = mixedp + (size_t)(b * SEQ + qp0 + rho) * DM + 512 + hd * 64 + 4 * h;
#pragma unroll
        for (int dt = 0; dt < 2; ++dt)
#pragma unroll
            for (int g4 = 0; g4 < 4; ++g4) { const u32x2 o = *(const u32x2*)(op + 32 * dt + 8 * g4); const f32x4 g = *(const f32x4*)(gp + 32 * dt + 8 * g4);
                *(u32x2*)(op + 32 * dt + 8 * g4) = (u32x2){pk2(bflo(o.x) * rr * g.x, bfhi(o.x) * rr * g.y), pk2(bflo(o.y) * rr * g.z, bfhi(o.y) * rr * g.w)}; }
    }
    __syncthreads();
}


constexpr int HG_BSTR = 132, HG_HSTR = 136;
constexpr int HG_B_BYTES = 128 * HG_BSTR * 4, HG_H_BYTES = 128 * HG_HSTR * 2;
__device__ __forceinline__ float hg_lb(const float* lb_logits, int l, int hk) { if (l == 0) return 0.f; const float a0 = lb_logits[hk], a1 = lb_logits[512 + hk]; return 1.0f / (1.0f + expf(a0 - a1)); }
__device__ __forceinline__ float hg_logf2(float z, float lb) {
    const float ls = fminf(z, 0.f) - log1pf(expf(-fabsf(z))); const float lf = (lb == 0.f) ? ls : logf(lb + (1.f - lb) * expf(ls)); return lf * 1.4426950408889634f; }
__device__ __forceinline__ void hg_cumsum(LAS float* bL, LAS float* segtot, LAS float* lbs, const bf16* projp, int row0, int h, int tid) {
#pragma unroll 1
    for (int i = 0; i < 4; ++i) { const int idx = tid + NTHR * i, t = idx >> 4, kg = idx & 15;
        const u32x4 z8 = *(const u32x4*)(projp + (size_t)(row0 + t) * DIN + C_HF + h * 128 + kg * 8);
        const f32x4 l0 = *(const LAS f32x4*)(lbs + kg * 8), l1 = *(const LAS f32x4*)(lbs + kg * 8 + 4);
        *(LAS f32x4*)(bL + t * HG_BSTR + kg * 8) = (f32x4){hg_logf2(bflo(z8.x), l0.x), hg_logf2(bfhi(z8.x), l0.y), hg_logf2(bflo(z8.y), l0.z), hg_logf2(bfhi(z8.y), l0.w)};
        *(LAS f32x4*)(bL + t * HG_BSTR + kg * 8 + 4) = (f32x4){hg_logf2(bflo(z8.z), l1.x), hg_logf2(bfhi(z8.z), l1.y), hg_logf2(bflo(z8.w), l1.z), hg_logf2(bfhi(z8.w), l1.w)}; }
    __syncthreads();
    { const int k = tid & 127, seg = tid >> 7; float run = 0.f;
        for (int tt = 0; tt < 32; ++tt) { const int t = seg * 32 + tt; run += bL[t * HG_BSTR + k]; bL[t * HG_BSTR + k] = run; }
        segtot[seg * 128 + k] = run;
        __syncthreads();
        float off = 0.f;
#pragma unroll
        for (int s = 0; s < 4; ++s) { const float v = segtot[s * 128 + k]; if (s < seg) off += v; }
        if (seg > 0) for (int tt = 0; tt < 32; ++tt) { const int t = seg * 32 + tt; bL[t * HG_BSTR + k] += off; }
    }
    __syncthreads();
}
__device__ __forceinline__ void hg_stage_vt(LAS bf16* VT, const bf16* projp, int row0, int h, int tid) {
#pragma unroll
    for (int i = 0; i < 4; ++i) { const int idx = tid + NTHR * i, vg = idx >> 7, t = idx & 127;
        const u32x4 w = *(const u32x4*)(projp + (size_t)(row0 + t) * DIN + C_HI + h * 128 + vg * 8);
        LAS bf16* d = VT + (vg * 8) * HG_HSTR + t;
        d[0] = (bf16)(w.x & 0xffffu); d[HG_HSTR] = (bf16)(w.x >> 16); d[2 * HG_HSTR] = (bf16)(w.y & 0xffffu); d[3 * HG_HSTR] = (bf16)(w.y >> 16);
        d[4 * HG_HSTR] = (bf16)(w.z & 0xffffu); d[5 * HG_HSTR] = (bf16)(w.z >> 16); d[6 * HG_HSTR] = (bf16)(w.w & 0xffffu); d[7 * HG_HSTR] = (bf16)(w.w >> 16); }
}
__device__ __forceinline__ void hgrn_local_unit(LAS unsigned char* lds, const bf16* projp, const float* lb_logits, float* stateg, float* dendg, int l, int unit, int tid_in, int lane_in, int wave) {
    int tid = tid_in; asm volatile("" : "+v"(tid)); int lane = tid & 63; (void)lane_in;
    const int bh = unit >> 5, c = unit & 31, b = bh >> 2, h = bh & 3, row0 = b * SEQ + c * 128;
    LAS float* bL = (LAS float*)lds; LAS bf16* VT = (LAS bf16*)(lds + HG_B_BYTES); LAS bf16* kdT = (LAS bf16*)(lds + HG_B_BYTES + HG_H_BYTES);
    LAS float* segtot = (LAS float*)(lds + HG_B_BYTES + 2 * HG_H_BYTES); LAS float* lbs = segtot + 512;
    __syncthreads();
    if (tid < 128) lbs[tid] = hg_lb(lb_logits, l, h * 128 + tid);
    __syncthreads();
    hg_cumsum(bL, segtot, lbs, projp, row0, h, tid);
    hg_stage_vt(VT, projp, row0, h, tid);
    if (tid < 128) dendg[(size_t)(bh * 32 + c) * 128 + tid] = __builtin_amdgcn_exp2f(bL[127 * HG_BSTR + tid]);
#pragma unroll 1
    for (int i = 0; i < 4; ++i) { const int idx = tid + NTHR * i, kg = idx >> 7, t = idx & 127;
        const u32x4 z8 = *(const u32x4*)(projp + (size_t)(row0 + t) * DIN + C_HF + h * 128 + kg * 8);
        const float zf[8] = {bflo(z8.x), bfhi(z8.x), bflo(z8.y), bfhi(z8.y), bflo(z8.z), bfhi(z8.z), bflo(z8.w), bfhi(z8.w)};
#pragma unroll
        for (int j = 0; j < 8; ++j) { const int k = kg * 8 + j; const float kk = (1.f - lbs[k]) / (1.f + expf(zf[j]));
            kdT[k * HG_HSTR + t] = (bf16)f2bf(kk * __builtin_amdgcn_exp2f(bL[127 * HG_BSTR + k] - bL[t * HG_BSTR + k])); } }
    __syncthreads();
    asm volatile("" : "+v"(tid)); lane = tid & 63;
    const int c32 = lane & 31, hh = lane >> 5;
#pragma unroll
    for (int ti = 0; ti < 2; ++ti) { const int tile = wave * 2 + ti, vt = tile >> 2, kt = tile & 3;
        f32x16 acc;
#pragma unroll
        for (int r = 0; r < 16; ++r) acc[r] = 0.f;
#pragma unroll
        for (int ks = 0; ks < 8; ++ks) { const bf16x8 af = *(const LAS bf16x8*)(VT + (32 * vt + c32) * HG_HSTR + 16 * ks + 8 * hh), bf = *(const LAS bf16x8*)(kdT + (32 * kt + c32) * HG_HSTR + 16 * ks + 8 * hh);
            acc = MFMA32(af, bf, acc); }
        float* sp = stateg + (size_t)(bh * 32 + c) * 16384 + 32 * kt + c32;
#pragma unroll
        for (int r = 0; r < 16; ++r) sp[(size_t)(32 * vt + krow16(r, hh)) * 128] = acc[r];
    }
    __syncthreads();
}
__device__ __forceinline__ void hgrn_out_unit(LAS unsigned char* lds, const bf16* projp, bf16* mixedp, const float* lb_logits, const float* gain, const float* stateg, int l, int unit, int tid_in, int lane_in, int wave) {
    int tid = tid_in; asm volatile("" : "+v"(tid)); int lane = tid & 63; (void)lane_in;
    const int bh = unit >> 5, c = unit & 31, b = bh >> 2, h = bh & 3, row0 = b * SEQ + c * 128;
    LAS float* bL = (LAS float*)lds; LAS bf16* VT = (LAS bf16*)(lds + HG_B_BYTES); LAS bf16* kh = (LAS bf16*)(lds + HG_B_BYTES + HG_H_BYTES);
    LAS float* segtot = (LAS float*)(lds + HG_B_BYTES + 2 * HG_H_BYTES); LAS float* lbs = segtot + 512; LAS float* ssq = segtot + 640;
    __syncthreads();
    if (tid < 128) lbs[tid] = hg_lb(lb_logits, l, h * 128 + tid);
    __syncthreads();
    hg_cumsum(bL, segtot, lbs, projp, row0, h, tid);
    hg_stage_vt(VT, projp, row0, h, tid);
#pragma unroll 1
    for (int i = 0; i < 4; ++i) { const int idx = tid + NTHR * i, t = idx >> 4, kg = idx & 15, rend = (t | 31);
        const u32x4 z8 = *(const u32x4*)(projp + (size_t)(row0 + t) * DIN + C_HF + h * 128 + kg * 8);
        const float zf[8] = {bflo(z8.x), bfhi(z8.x), bflo(z8.y), bfhi(z8.y), bflo(z8.z), bfhi(z8.z), bflo(z8.w), bfhi(z8.w)};
        float o[8];
#pragma unroll
        for (int j = 0; j < 8; ++j) { const int k = kg * 8 + j; o[j] = (1.f - lbs[k]) / (1.f + expf(zf[j])) * __builtin_amdgcn_exp2f(bL[rend * HG_BSTR + k] - bL[t * HG_BSTR + k]); }
        *(LAS u32x4*)(kh + t * HG_HSTR + kg * 8) = (u32x4){pk2(o[0], o[1]), pk2(o[2], o[3]), pk2(o[4], o[5]), pk2(o[6], o[7])}; }
    __syncthreads();
    asm volatile("" : "+v"(tid)); lane = tid & 63;
    const int c32 = lane & 31, hh = lane >> 5, I = wave & 3, vh = wave >> 2, t = 32 * I + c32;
    u32x4 qs[8];
    { const bf16* qp = projp + (size_t)(row0 + t) * DIN + C_HQ + h * 128 + 8 * hh;
#pragma unroll
        for (int ks = 0; ks < 8; ++ks) { const u32x4 w = *(const u32x4*)(qp + 16 * ks);
            qs[ks] = (u32x4){pk2(siluf_(bflo(w.x)), siluf_(bfhi(w.x))), pk2(siluf_(bflo(w.y)), siluf_(bfhi(w.y))), pk2(siluf_(bflo(w.z)), siluf_(bfhi(w.z))), pk2(siluf_(bflo(w.w)), siluf_(bfhi(w.w)))}; } }
    f32x16 O[2];
#pragma unroll
    for (int v2 = 0; v2 < 2; ++v2)
#pragma unroll
        for (int r = 0; r < 16; ++r) O[v2][r] = 0.f;
#pragma unroll 1
    for (int J = -1; J <= I; ++J) {
        bf16x8 qa[8];
#pragma unroll
        for (int ks = 0; ks < 8; ++ks) { const int k0 = 16 * ks + 8 * hh;
            const f32x4 b0 = *(const LAS f32x4*)(bL + t * HG_BSTR + k0), b1 = *(const LAS f32x4*)(bL + t * HG_BSTR + k0 + 4);
            f32x4 r0 = (f32x4){0.f, 0.f, 0.f, 0.f}, r1 = r0;
            if (J >= 0) { r0 = *(const LAS f32x4*)(bL + (32 * J + 31) * HG_BSTR + k0); r1 = *(const LAS f32x4*)(bL + (32 * J + 31) * HG_BSTR + k0 + 4); }
            const u32x4 q = qs[ks];
            u32x4 p;
            p.x = pk2(bflo(q.x) * __builtin_amdgcn_exp2f(fminf(b0.x - r0.x, 120.f)), bfhi(q.x) * __builtin_amdgcn_exp2f(fminf(b0.y - r0.y, 120.f)));
            p.y = pk2(bflo(q.y) * __builtin_amdgcn_exp2f(fminf(b0.z - r0.z, 120.f)), bfhi(q.y) * __builtin_amdgcn_exp2f(fminf(b0.w - r0.w, 120.f)));
            p.z = pk2(bflo(q.z) * __builtin_amdgcn_exp2f(fminf(b1.x - r1.x, 120.f)), bfhi(q.z) * __builtin_amdgcn_exp2f(fminf(b1.y - r1.y, 120.f)));
            p.w = pk2(bflo(q.w) * __builtin_amdgcn_exp2f(fminf(b1.z - r1.z, 120.f)), bfhi(q.w) * __builtin_amdgcn_exp2f(fminf(b1.w - r1.w, 120.f)));
            qa[ks] = __builtin_bit_cast(bf16x8, p); if (ks & 1) __builtin_amdgcn_sched_barrier(0); }
        if (J < 0) {
#pragma unroll
            for (int v2 = 0; v2 < 2; ++v2) { const float* sp = stateg + (size_t)(bh * 32 + c) * 16384 + (size_t)(32 * (2 * vh + v2) + c32) * 128 + 8 * hh;
#pragma unroll
                for (int ks = 0; ks < 8; ++ks) { const f32x4 s0 = *(const f32x4*)(sp + 16 * ks), s1 = *(const f32x4*)(sp + 16 * ks + 4);
                    const bf16x8 sf = __builtin_bit_cast(bf16x8, (u32x4){pk2(s0.x, s0.y), pk2(s0.z, s0.w), pk2(s1.x, s1.y), pk2(s1.z, s1.w)});
                    O[v2] = MFMA32(sf, qa[ks], O[v2]); if ((ks & 3) == 3) __builtin_amdgcn_sched_barrier(0); } }
        } else {
            f32x16 X;
#pragma unroll
            for (int r = 0; r < 16; ++r) X[r] = 0.f;
#pragma unroll
            for (int ks = 0; ks < 8; ++ks) { const bf16x8 kf = *(const LAS bf16x8*)(kh + (32 * J + c32) * HG_HSTR + 16 * ks + 8 * hh); X = MFMA32(kf, qa[ks], X); }
            if (J == I) {
#pragma unroll
                for (int r = 0; r < 16; ++r) if (krow16(r, hh) > c32) X[r] = 0.f;
            }
#pragma unroll
            for (int s2 = 0; s2 < 2; ++s2) { const bf16x8 pf = pack8(X, s2); const int kb = 32 * J + 16 * s2 + 4 * hh;
#pragma unroll
                for (int v2 = 0; v2 < 2; ++v2) { const LAS bf16* vp = VT + (32 * (2 * vh + v2) + c32) * HG_HSTR + kb;
                    const u32x2 v0 = *(const LAS u32x2*)vp, v1 = *(const LAS u32x2*)(vp + 8);
                    O[v2] = MFMA32(__builtin_bit_cast(bf16x8, (u32x4){v0.x, v0.y, v1.x, v1.y}), pf, O[v2]); } }
        }
    }
    float ss = 0.f;
#pragma unroll
    for (int v2 = 0; v2 < 2; ++v2)
#pragma unroll
        for (int r = 0; r < 16; ++r) ss += O[v2][r] * O[v2][r];
    ss += __shfl_xor(ss, 32);
    if (hh == 0) ssq[t * 2 + vh] = ss;
    __syncthreads();
    const float rr = 1.0f / sqrtf((ssq[t * 2] + ssq[t * 2 + 1]) * (1.0f / 128.0f) + RMS_EPS);
#pragma unroll
    for (int v2 = 0; v2 < 2; ++v2)
#pragma unroll
        for (int g4 = 0; g4 < 4; ++g4) { const int v0 = 32 * (2 * vh + v2) + 8 * g4 + 4 * hh;
            const u32x2 gw = *(const u32x2*)(projp + (size_t)(row0 + t) * DIN + C_HG + h * 128 + v0); const f32x4 gn = *(const f32x4*)(gain + h * 128 + v0);
            const float o0 = O[v2][4 * g4] * rr * gn.x * siluf_(bflo(gw.x)), o1 = O[v2][4 * g4 + 1] * rr * gn.y * siluf_(bfhi(gw.x)), o2 = O[v2][4 * g4 + 2] * rr * gn.z * siluf_(bflo(gw.y)), o3 = O[v2][4 * g4 + 3] * rr * gn.w * siluf_(bfhi(gw.y));
            *(u32x2*)(mixedp + (size_t)(row0 + t) * DM + h * 128 + v0) = (u32x2){pk2(o0, o1), pk2(o2, o3)}; }
    __syncthreads();
}

#define KAS __attribute__((address_space(4)))
#define PHASE_PTRS const char KAS* kp_ = (const char KAS*)__builtin_amdgcn_kernarg_segment_ptr(); asm volatile("" : "+s"(kp_)); unsigned char* const ws = *(unsigned char* const KAS*)(kp_ + 26 * 8); (void)ws;
#define INP(k) (*(const float* const KAS*)(kp_ + (k) * 8))
#define x_in INP(0)
#define ln0_g INP(1)
#define ln0_b INP(2)
#define w_in INP(3)
#define b_in INP(4)
#define lb_logits INP(5)
#define sw_sinks INP(6)
#define sg_ln_g INP(7)
#define sg_ln_b INP(8)
#define sg_w_s INP(9)
#define sg_b_s INP(10)
#define mix_gain INP(11)
#define w_out INP(12)
#define ln1_g INP(13)
#define ln1_b INP(14)
#define router_w INP(15)
#define router_b INP(16)
#define ew_gate INP(17)
#define ew_up INP(18)
#define ew_down INP(19)
#define sh_gate INP(20)
#define sh_up INP(21)
#define sh_down INP(22)
#define ln2_g INP(23)
#define ln2_b INP(24)
#define OUTP (*(float* const KAS*)(kp_ + 25 * 8))
#define list ((int*)(ws + WS_LIST))
#define wlist ((float*)(ws + WS_WLIST))
#define slot ((int*)(ws + WS_SLOT))
#define dendG ((float*)(ws + WS_DEND))
#define stateG ((float*)(ws + WS_STATE))
#define Hf ((float*)(ws + WS_HF))
#define Hb ((bf16*)(ws + WS_HB))
#define proj ((bf16*)(ws + WS_PROJ))
#define mixed ((bf16*)(ws + WS_MIXED))
#define Hs ((bf16*)(ws + WS_HS))
#define Yb ((bf16*)(ws + WS_Y))
#define ctl ((unsigned*)(ws + WS_CTL))
#define WLp ((const char*)(ws + WS_W + (size_t)l * WL_BYTES))
#define cntG (ctl + CW_CNT + l * 64)
__global__ void __launch_bounds__(NTHR, 2) fwd_kernel(Args args) {
    extern __shared__ __attribute__((aligned(16))) unsigned char lds_raw[];
    LAS unsigned char* const lds = (LAS unsigned char*)lds_raw;
    const int tid = threadIdx.x, lane = tid & 63, wave = __builtin_amdgcn_readfirstlane(tid >> 6);
    const int G = gridDim.x, bx = blockIdx.x;
    const int vcu = (G % 8 == 0) ? (bx % 8) * (G / 8) + bx / 8 : bx;
    volatile LAS unsigned* MISC = (volatile LAS unsigned*)(lds + MISC_OFF);
    if (tid < 64) MISC[tid] = 0u;
    __syncthreads();
    XcdBarrier bar; bar.bar = (unsigned*)(args.ws + WS_CTL) + CW_BAR; bar.x = 0; bar.st = nullptr;
    if (args.use_bar) bar = xcd_barrier_post((unsigned*)(args.ws + WS_CTL) + CW_BAR, MISC + 8);
    const int lo = args.ph_lo, hi = args.ph_hi;
#define PHASE_TID int tid_o_ = tid_of_wave(wave); asm volatile("" : "+v"(tid_o_)); const int tid = tid_o_, lane = tid & 63; (void)lane; (void)tid;
#ifndef BSEL
#define BSEL 7
#endif
#ifndef DBLMASK
#define DBLMASK 0
#endif
#define REP(i) (((DBLMASK >> (i)) & 1) ? 2 : 1)
#ifndef PHMASK
#define PHMASK 0x3ff
#endif
#define IN(k) (lo <= (k) && (k) < hi)
#define EN(i) ((PHMASK >> (i)) & 1)
#define SEAM(k) do { if (IN(k) && IN((k) + 1)) xcd_barrier(bar, wave); } while (0)

    for (int rep_ = 0; rep_ < REP(0); ++rep_)
    if (EN(0) && IN(0)) { PHASE_TID PHASE_PTRS
        LAS float* scr = (LAS float*)(lds + wave * 16384);
        const int gw = vcu * NWAVES + wave, NGW = G * NWAVES;
        for (int it = gw; it < 2 * IT_LAYER; it += NGW) {
            const int l = it / IT_LAYER; int r = it % IT_LAYER;
            bf16* const WL = (bf16*)(ws + WS_W + (size_t)l * WL_BYTES);
            if (r < IT_IN) { transpose_item(w_in + (size_t)l * DM * DIN, DM, DIN, (bf16*)((char*)WLp + WL_IN), 0, scr, r, lane); continue; } r -= IT_IN;
            if (r < IT_OUT) { transpose_item(w_out + (size_t)l * DM * DM, DM, DM, (bf16*)((char*)WLp + WL_OUT), 0, scr, r, lane); continue; } r -= IT_OUT;
            const int e = r / (2 * IT_G + IT_D); r = r % (2 * IT_G + IT_D);
            bf16* const gu = (bf16*)((char*)WLp + WL_GU + (size_t)e * W_GU_B); bf16* const dn = (bf16*)((char*)WLp + WL_D + (size_t)e * W_D_B);
            if (r < IT_G) { const float* src = (e < 64) ? ew_gate + ((size_t)l * 64 + e) * DM * DE : sh_gate + (size_t)l * DM * DE; transpose_item(src, DM, DE, gu, 1, scr, r, lane); continue; } r -= IT_G;
            if (r < IT_G) { const float* src = (e < 64) ? ew_up + ((size_t)l * 64 + e) * DM * DE : sh_up + (size_t)l * DM * DE; transpose_item(src, DM, DE, gu, 2, scr, r, lane); continue; } r -= IT_G;
            { const float* src = (e < 64) ? ew_down + ((size_t)l * 64 + e) * DE * DM : sh_down + (size_t)l * DE * DM; transpose_item(src, DE, DM, dn, 0, scr, r, lane); }
        }
        for (int m = gw; m < NTOK; m += NGW) {
            f32x4 v[8];
#pragma unroll
            for (int j = 0; j < 8; ++j) v[j] = ((const f32x4*)(x_in + (size_t)m * DM))[j * 64 + lane];
            ln_regs(v, ln0_g, ln0_b, lane);
            store_row_f32(Hf + (size_t)m * DM, v, lane); store_row_bf16(Hb + (size_t)m * DM, v, lane);
        }
        for (int it = (vcu * NTHR + tid); it < 2 * 64 * 256; it += G * NTHR) {
            const int l = it >> 14, e = it & 63, k8 = (it >> 6) & 255;
            const float* src = router_w + (size_t)l * DM * NE + (size_t)(k8 * 8) * NE + e;
            float w8[8]; unsigned hi[4], lo[4];
#pragma unroll
            for (int j = 0; j < 8; ++j) w8[j] = src[(size_t)j * NE];
#pragma unroll
            for (int j = 0; j < 4; ++j) { const unsigned h0 = f2bf(w8[2 * j]), h1 = f2bf(w8[2 * j + 1]); hi[j] = h0 | (h1 << 16); lo[j] = pk2(w8[2 * j] - __uint_as_float(h0 << 16), w8[2 * j + 1] - __uint_as_float(h1 << 16)); }
            bf16* dst = (bf16*)(ws + WS_RT) + (size_t)l * 2 * NE * DM + (size_t)e * DM + k8 * 8;
            *(u32x4*)dst = (u32x4){hi[0], hi[1], hi[2], hi[3]}; *(u32x4*)(dst + (size_t)NE * DM) = (u32x4){lo[0], lo[1], lo[2], lo[3]};
        }
    }
    SEAM(0);

    for (int l = 0; l < 2; ++l) {
        const int pb = 1 + l * 9;

        for (int rep_ = 0; rep_ < REP(1); ++rep_)
        if (EN(1) && IN(pb + 0)) { PHASE_PTRS
            pg8::PlainSched S; S.init(NTOK, DIN, DM, G, bx, WLp + WL_IN);
            pg8::EpiBf16Bias E{proj, DIN, b_in + (size_t)l * DIN};
            pg8::gemm_phase<pg8::EpiBf16Bias, pg8::PlainSched, true>(lds, (const char*)Hb, DM, S, E, wave);
        }
        SEAM(pb + 0);

        for (int rep_ = 0; rep_ < REP(2); ++rep_)
        if (EN(2) && IN(pb + 1)) {
            if (BSEL & 1) { PHASE_TID PHASE_PTRS
            for (int unit = bx; unit < 512; unit += G) hgrn_local_unit(lds, proj, lb_logits, stateG, dendG, l, unit, tid, lane, wave);
            }
            if (BSEL & 2) { PHASE_TID PHASE_PTRS
            for (int unit = bx; unit < 256; unit += G) swa_unit(lds, proj, mixed, sw_sinks + l * 16, mix_gain + (size_t)l * DM, unit, tid, lane, wave);
            }
            if (BSEL & 4) { PHASE_TID PHASE_PTRS
            for (int unit = bx; unit < 128; unit += G) {
                const int row0 = unit * 128;
                LAS float* vn = (LAS float*)lds;
                LAS float* wT = (LAS float*)(lds + 65536);
                LAS f32x2* stats = (LAS f32x2*)(lds + 133120);
                __syncthreads();
#pragma unroll 1
                for (int i = 0; i < 16; ++i) { const int s = wave * 16 + i;
                    const u32x4 w = *(const u32x4*)(proj + (size_t)(row0 + s) * DIN + C_SV + lane * 8);
                    float g[8] = {geluf_(bflo(w.x)), geluf_(bfhi(w.x)), geluf_(bflo(w.y)), geluf_(bfhi(w.y)), geluf_(bflo(w.z)), geluf_(bfhi(w.z)), geluf_(bflo(w.w)), geluf_(bfhi(w.w))};
                    float sm = 0.f;
#pragma unroll
                    for (int j = 0; j < 8; ++j) sm += g[j];
                    const float mean = wave_sum(sm) * (1.0f / 512.0f); float s2 = 0.f;
#pragma unroll
                    for (int j = 0; j < 8; ++j) { const float d = g[j] - mean; s2 += d * d; }
                    const float rstd = 1.0f / sqrtf(wave_sum(s2) * (1.0f / 512.0f) + LN_EPS);
                    if (lane == 0) stats[s] = (f32x2){mean, rstd};
                }
                float ssr[4] = {0.f, 0.f, 0.f, 0.f};
                const int tq = tid >> 4, cq = tid & 15, t0 = 4 * tq, c0 = 8 * cq;
#pragma unroll 1
                for (int g = 0; g < 4; ++g) {
                    __syncthreads();
#pragma unroll 1
                    for (int i = 0; i < 4; ++i) { const int idx = tid + NTHR * i, s = idx >> 4, cg = idx & 15;
                        const u32x4 w = *(const u32x4*)(proj + (size_t)(row0 + s) * DIN + C_SV + g * 128 + cg * 8);
                        const f32x2 st = stats[s]; const float* lg = sg_ln_g + (size_t)l * 512 + g * 128 + cg * 8; const float* lbp = sg_ln_b + (size_t)l * 512 + g * 128 + cg * 8;
                        const float x8[8] = {bflo(w.x), bfhi(w.x), bflo(w.y), bfhi(w.y), bflo(w.z), bfhi(w.z), bflo(w.w), bfhi(w.w)};
#pragma unroll
                        for (int j = 0; j < 8; ++j) vn[s * 128 + cg * 8 + j] = (geluf_(x8[j]) - st.x) * st.y * lg[j] + lbp[j];
                    }
                    { const float* wsrc = sg_w_s + ((size_t)l * 4 + g) * 128 * 128;
#pragma unroll
                        for (int i = 0; i < 8; ++i) { const int idx = tid + NTHR * i, s4 = (idx >> 7) * 4, t = idx & 127;
                            const f32x4 w4 = *(const f32x4*)(wsrc + t * 128 + s4);
#pragma unroll
                            for (int j = 0; j < 4; ++j) wT[(s4 + j) * 132 + t] = (s4 + j <= t) ? w4[j] : 0.f; } }
                    __syncthreads();
                    float acc[4][8];
#pragma unroll
                    for (int i = 0; i < 4; ++i)
#pragma unroll
                        for (int j = 0; j < 8; ++j) acc[i][j] = 0.f;
                    for (int s = 0; s <= t0 + 3; ++s) {
                        const f32x4 w4 = *(const LAS f32x4*)(wT + s * 132 + t0); const f32x4 va = *(const LAS f32x4*)(vn + s * 128 + c0), vb2 = *(const LAS f32x4*)(vn + s * 128 + c0 + 4);
                        const float vf[8] = {va.x, va.y, va.z, va.w, vb2.x, vb2.y, vb2.z, vb2.w};
#pragma unroll
                        for (int i = 0; i < 4; ++i)
#pragma unroll
                            for (int j = 0; j < 8; ++j) acc[i][j] += w4[i] * vf[j];
                    }
#pragma unroll 1
                    for (int i = 0; i < 4; ++i) { const float bs = sg_b_s[((size_t)l * 4 + g) * 128 + t0 + i];
                        const u32x4 w = *(const u32x4*)(proj + (size_t)(row0 + t0 + i) * DIN + C_SU + g * 128 + c0);
                        const float u8[8] = {bflo(w.x), bfhi(w.x), bflo(w.y), bfhi(w.y), bflo(w.z), bfhi(w.z), bflo(w.w), bfhi(w.w)};
                        float o8[8];
#pragma unroll
                        for (int j = 0; j < 8; ++j) { o8[j] = geluf_(u8[j]) * (acc[i][j] + bs); ssr[i] += o8[j] * o8[j]; }
                        *(u32x4*)(mixed + (size_t)(row0 + t0 + i) * DM + 1536 + g * 128 + c0) = (u32x4){pk2(o8[0], o8[1]), pk2(o8[2], o8[3]), pk2(o8[4], o8[5]), pk2(o8[6], o8[7])}; }
                }
                __syncthreads();
#pragma unroll
                for (int i = 0; i < 4; ++i) { float ss = ssr[i];
                    ss += __shfl_xor(ss, 1); ss += __shfl_xor(ss, 2); ss += __shfl_xor(ss, 4); ss += __shfl_xor(ss, 8);
                    const float rr = 1.0f / sqrtf(ss * (1.0f / 512.0f) + RMS_EPS);
#pragma unroll
                    for (int g = 0; g < 4; ++g) { const float* gp = mix_gain + (size_t)l * DM + 1536 + g * 128 + c0; bf16* op = mixed + (size_t)(row0 + t0 + i) * DM + 1536 + g * 128 + c0;
                        const u32x4 o = *(const u32x4*)op; const f32x4 g0 = *(const f32x4*)gp, g1 = *(const f32x4*)(gp + 4);
                        u32x4 w; w.x = pk2(bflo(o.x) * rr * g0.x, bfhi(o.x) * rr * g0.y); w.y = pk2(bflo(o.y) * rr * g0.z, bfhi(o.y) * rr * g0.w);
                        w.z = pk2(bflo(o.z) * rr * g1.x, bfhi(o.z) * rr * g1.y); w.w = pk2(bflo(o.w) * rr * g1.z, bfhi(o.w) * rr * g1.w);
                        *(u32x4*)op = w; }
                }
                __syncthreads();
            }
            }
        }
        SEAM(pb + 1);

        if (EN(3) && IN(pb + 2)) { PHASE_TID PHASE_PTRS
            for (int gi = bx * NTHR + tid; gi < 16 * 8192; gi += G * NTHR) {
                const int bh = gi >> 13, rem = gi & 8191, k = (rem & 63) * 2;
                float z0_ = 0.f; asm volatile("" : "+v"(z0_));
                f32x2 carry = (f32x2){z0_, z0_};
                for (int c = 0; c < 32; ++c) {
                    f32x2* p = (f32x2*)(stateG + (size_t)(bh * 32 + c) * 16384) + rem;
                    const f32x2 tmp = *p; *p = carry; const f32x2 d = *(const f32x2*)(dendG + (size_t)(bh * 32 + c) * 128 + k); carry = carry * d + tmp;
                }
            }
        }
        SEAM(pb + 2);

        for (int rep_ = 0; rep_ < REP(4); ++rep_)
        if (EN(4) && IN(pb + 3)) { PHASE_TID PHASE_PTRS
            for (int unit = bx; unit < 512; unit += G) hgrn_out_unit(lds, proj, mixed, lb_logits, mix_gain + (size_t)l * DM, stateG, l, unit, tid, lane, wave);
        }
        SEAM(pb + 3);

        if (EN(5) && IN(pb + 4)) { PHASE_PTRS
            pg8::PlainSched S; S.init(NTOK, DM, DM, G, bx, WLp + WL_OUT);
            pg8::EpiResF32 E{Hf, DM, ALPHA};
            pg8::gemm_phase<pg8::EpiResF32, pg8::PlainSched, true>(lds, (const char*)mixed, DM, S, E, wave);
        }
        SEAM(pb + 4);

        if (EN(6) && IN(pb + 5)) { PHASE_TID PHASE_PTRS
            constexpr int XSTR = 2056;
            LAS bf16* XH = (LAS bf16*)lds; LAS bf16* XL = (LAS bf16*)(lds + 16 * XSTR * 2);
            LAS float* xs = (LAS float*)lds;
            LAS int* selr = (LAS int*)(lds + 131584);
            LAS float* gatel = (LAS float*)(lds + 131584 + 4096);
            const bf16* wth = (const bf16*)(ws + WS_RT) + (size_t)l * 2 * NE * DM; const bf16* wtl = wth + (size_t)NE * DM;
            for (int bi = bx; bi < NTOK / 16; bi += G) {
                const int tok0 = bi * 16;
                __syncthreads();
#pragma unroll
                for (int jt = 0; jt < 2; ++jt) { const int tl = wave * 2 + jt, tok = tok0 + tl;
                    f32x4 v[8];
#pragma unroll
                    for (int j = 0; j < 8; ++j) v[j] = ((const f32x4*)(Hf + (size_t)tok * DM))[j * 64 + lane];
                    ln_regs(v, ln1_g + (size_t)l * DM, ln1_b + (size_t)l * DM, lane);
                    store_row_f32(Hf + (size_t)tok * DM, v, lane); store_row_bf16(Hb + (size_t)tok * DM, v, lane);
#pragma unroll
                    for (int j = 0; j < 8; ++j) { const unsigned h0 = f2bf(v[j].x), h1 = f2bf(v[j].y), h2 = f2bf(v[j].z), h3 = f2bf(v[j].w);
                        *(LAS u32x2*)(XH + tl * XSTR + (j * 64 + lane) * 4) = (u32x2){h0 | (h1 << 16), h2 | (h3 << 16)};
                        *(LAS u32x2*)(XL + tl * XSTR + (j * 64 + lane) * 4) = (u32x2){pk2(v[j].x - __uint_as_float(h0 << 16), v[j].y - __uint_as_float(h1 << 16)), pk2(v[j].z - __uint_as_float(h2 << 16), v[j].w - __uint_as_float(h3 << 16))}; }
                }
                __syncthreads();
                f32x4 acc[4];
#pragma unroll
                for (int nt = 0; nt < 4; ++nt) acc[nt] = (f32x4){0.f, 0.f, 0.f, 0.f};
                { const int fr = lane & 15, fq = lane >> 4;
#pragma unroll 2
                    for (int ks = 0; ks < 8; ++ks) { const int k0 = wave * 256 + ks * 32 + fq * 8;
                        const bf16x8 ah = *(const LAS bf16x8*)(XH + fr * XSTR + k0), al = *(const LAS bf16x8*)(XL + fr * XSTR + k0);
#pragma unroll
                        for (int nt = 0; nt < 4; ++nt) { const bf16x8 bh = __builtin_bit_cast(bf16x8, *(const u32x4*)(wth + (size_t)(nt * 16 + fr) * DM + k0)), bl = __builtin_bit_cast(bf16x8, *(const u32x4*)(wtl + (size_t)(nt * 16 + fr) * DM + k0));
                            acc[nt] = __builtin_amdgcn_mfma_f32_16x16x32_bf16(ah, bh, acc[nt], 0, 0, 0); acc[nt] = __builtin_amdgcn_mfma_f32_16x16x32_bf16(ah, bl, acc[nt], 0, 0, 0); acc[nt] = __builtin_amdgcn_mfma_f32_16x16x32_bf16(al, bh, acc[nt], 0, 0, 0); } }
                    __syncthreads();
#pragma unroll
                    for (int nt = 0; nt < 4; ++nt)
#pragma unroll
                        for (int r = 0; r < 4; ++r) xs[(wave * 16 + fq * 4 + r) * 64 + nt * 16 + fr] = acc[nt][r];
                }
                __syncthreads();
#pragma unroll
                for (int jt = 0; jt < 2; ++jt) { const int tl = wave * 2 + jt;
                    float logit = 0.f;
#pragma unroll
                    for (int w = 0; w < 8; ++w) logit += xs[(w * 16 + tl) * 64 + lane];
                    const float score = 1.0f / (1.0f + expf(-logit));
                    const float sel = score + router_b[l * NE + lane];
                    float m1 = sel; m1 = fmaxf(m1, __shfl_xor(m1, 1)); m1 = fmaxf(m1, __shfl_xor(m1, 2)); m1 = fmaxf(m1, __shfl_xor(m1, 4));
                    const unsigned long long bm = __ballot(sel == m1); const int grp = lane >> 3; const unsigned gbits = (unsigned)(bm >> (grp * 8)) & 0xffu; const int first = __builtin_ctz(gbits);
                    float s2 = ((lane & 7) == first) ? -INFINITY : sel; s2 = fmaxf(s2, __shfl_xor(s2, 1)); s2 = fmaxf(s2, __shfl_xor(s2, 2)); s2 = fmaxf(s2, __shfl_xor(s2, 4));
                    const float gs = m1 + s2;
                    int grank = 0;
#pragma unroll
                    for (int j = 0; j < 8; ++j) { const float gj = __shfl(gs, j * 8); grank += (gj > gs || (gj == gs && j < grp)) ? 1 : 0; }
                    const bool chosen = grank < 4;
                    const float msel = chosen ? sel : -INFINITY;
                    int rk = 0;
#pragma unroll 8
                    for (int j = 0; j < 64; ++j) { const float vj = __shfl(msel, j); rk += (vj > msel || (vj == msel && j < lane)) ? 1 : 0; }
                    const bool selected = chosen && rk < 8;
                    const float ssum = wave_sum(selected ? score : 0.f);
                    selr[tl * 64 + lane] = selected ? rk : -1; gatel[tl * 64 + lane] = score / ssum * ROUTED_SCALE;
                }
                __syncthreads();
                if (wave == 0) {
                    int cl = 0; int lp[16];
#pragma unroll
                    for (int t = 0; t < 16; ++t) { lp[t] = cl; cl += (selr[t * 64 + lane] >= 0) ? 1 : 0; }
                    int base = 0; if (cl > 0) base = (int)__hip_atomic_fetch_add(cntG + lane, (unsigned)cl, RLX_AGENT);
#pragma unroll
                    for (int t = 0; t < 16; ++t) { const int rk = selr[t * 64 + lane];
                        if (rk >= 0) { const int pos = base + lp[t]; list[lane * NTOK + pos] = tok0 + t; wlist[lane * NTOK + pos] = gatel[t * 64 + lane]; slot[(size_t)(tok0 + t) * 8 + rk] = (lane << 16) | pos; } }
                }
            }
        }
        SEAM(pb + 5);

        LAS int* const cnts = (LAS int*)(lds + TAB_OFF); LAS int* const tstart = cnts + 64; LAS int* const tile_e = cnts + 192;
        int ntiles = 0;
        if ((EN(7) && IN(pb + 6)) || (EN(8) && IN(pb + 7)) || (EN(9) && IN(pb + 8))) { PHASE_TID PHASE_PTRS
            __syncthreads();
            if (tid < 64) cnts[tid] = (int)__hip_atomic_load(cntG + tid, RLX_AGENT);
            __syncthreads();
            if (tid == 0) { int s = 0; for (int e = 0; e < 64; ++e) { tstart[e] = s; s += (cnts[e] + 255) >> 8; } tstart[64] = s; }
            __syncthreads();
            if (tid < 64) for (int t = tstart[tid]; t < tstart[tid + 1]; ++t) tile_e[t] = tid;
            __syncthreads();
            ntiles = __builtin_amdgcn_readfirstlane(tstart[64]); if (ntiles > MAXTILES) ntiles = MAXTILES;
        }

        for (int rep_ = 0; rep_ < REP(7); ++rep_)
        if (EN(7) && IN(pb + 6)) { PHASE_PTRS
            { pg8::MoeSched<true> S{cnts, tstart, tile_e, ntiles, 4, G, vcu, DM, list, WLp + WL_GU, W_GU_B};
              pg8::EpiSwiGLU E{Hs};
              pg8::gemm_phase<pg8::EpiSwiGLU, pg8::MoeSched<true>, true>(lds, (const char*)Hb, DM, S, E, wave); }
            { pg8::PlainSched S; S.init(NTOK, 1024, DM, G, bx, WLp + WL_GU + 64 * W_GU_B);
              pg8::EpiSwiGLU E{Hs + (size_t)SH_ROW0 * DE};
              pg8::gemm_phase<pg8::EpiSwiGLU, pg8::PlainSched, true>(lds, (const char*)Hb, DM, S, E, wave); }
        }
        SEAM(pb + 6);

        if (EN(8) && IN(pb + 7)) { PHASE_PTRS
#if !defined(HSEL) || HSEL == 1
            for (int rep_ = 0; rep_ < REP(8); ++rep_)
            { pg8::MoeSched<false> S{cnts, tstart, tile_e, ntiles, 8, G, vcu, DE, nullptr, WLp + WL_D, W_D_B};
              pg8::EpiDownY E{Yb, wlist};
              pg8::gemm_phase<pg8::EpiDownY, pg8::MoeSched<false>, true>(lds, (const char*)Hs, DE, S, E, wave); }
#endif
#if !defined(HSEL) || HSEL == 2
            { pg8::PlainSched S; S.init(NTOK, DM, DE, G, bx, WLp + WL_D + 64 * W_D_B);
              pg8::EpiResF32 E{Hf, DM, ALPHA};
              pg8::gemm_phase<pg8::EpiResF32, pg8::PlainSched, true>(lds, (const char*)(Hs + (size_t)SH_ROW0 * DE), DE, S, E, wave); }
#endif
        }
        SEAM(pb + 7);

        if (EN(9) && IN(pb + 8)) { PHASE_TID PHASE_PTRS
            const int gw = vcu * NWAVES + wave, NGW = G * NWAVES;
            for (int tok = gw; tok < NTOK; tok += NGW) {
                f32x4 v[8];
#pragma unroll
                for (int j = 0; j < 8; ++j) v[j] = ((const f32x4*)(Hf + (size_t)tok * DM))[j * 64 + lane];
                const int myslot = slot[(size_t)tok * 8 + (lane & 7)];
#pragma unroll
                for (int k = 0; k < 8; ++k) { const int sl = __shfl(myslot, k); const int e = sl >> 16, pos = sl & 0xffff; const size_t row = (size_t)tstart[e] * 256 + pos;
                    const u32x2* yp = (const u32x2*)(Yb + row * DM);
#pragma unroll
                    for (int j = 0; j < 8; ++j) { const u32x2 w = yp[j * 64 + lane]; v[j].x += bflo(w.x); v[j].y += bfhi(w.x); v[j].z += bflo(w.y); v[j].w += bfhi(w.y); } }
                ln_regs(v, ln2_g + (size_t)l * DM, ln2_b + (size_t)l * DM, lane);
                if (l == 0) { store_row_f32(Hf + (size_t)tok * DM, v, lane); store_row_bf16(Hb + (size_t)tok * DM, v, lane); }
                else store_row_f32(OUTP + (size_t)tok * DM, v, lane);
            }
        }
        SEAM(pb + 8);
    }
#undef IN
#undef SEAM
}

constexpr int NPHASES = 19;
#ifndef ONE_LAUNCH
#define ONE_LAUNCH 1
#endif

extern "C" void kernel_launch(void* const* d_in, const int* in_sizes, int n_in, void* d_out, int out_size, void* d_ws, size_t ws_size, hipStream_t stream) {
    static int grid = 0;
    if (grid == 0) {
        if (n_in != 25 || out_size != NTOK * DM || ws_size < WS_END) { fprintf(stderr, "kernel_launch: unexpected shapes: n_in %d out %d ws %zu (need %zu)\n", n_in, out_size, ws_size, (size_t)WS_END); grid = -1; return; }
        int dev = 0, cus = 0, per_cu = 0;
        if (hipGetDevice(&dev) != hipSuccess || hipDeviceGetAttribute(&cus, hipDeviceAttributeMultiprocessorCount, dev) != hipSuccess) { grid = -1; return; }
        if (hipFuncSetAttribute((const void*)fwd_kernel, hipFuncAttributeMaxDynamicSharedMemorySize, LDS_BYTES) != hipSuccess) { fprintf(stderr, "kernel_launch: hipFuncSetAttribute failed\n"); grid = -1; return; }
        if (hipOccupancyMaxActiveBlocksPerMultiprocessor(&per_cu, (const void*)fwd_kernel, NTHR, LDS_BYTES) != hipSuccess || per_cu < 1) fprintf(stderr, "kernel_launch: occupancy query reports %d\n", per_cu);
        (void)hipGetLastError();
        grid = cus;
    }
    if (grid < 0) return;
    if (hipMemsetAsync((char*)d_ws + WS_CTL, 0, CTL_ZERO_BYTES, stream) != hipSuccess) return;
    Args a{};
    for (int i = 0; i < 25; ++i) a.in[i] = (const float*)d_in[i];
    a.out = (float*)d_out; a.ws = (unsigned char*)d_ws; a.pad = 0;
#if ONE_LAUNCH
    a.ph_lo = 0; a.ph_hi = NPHASES; a.use_bar = 1;
    hipLaunchKernelGGL(fwd_kernel, dim3(grid), dim3(NTHR), LDS_BYTES, stream, a);
#else
    for (int p = 0; p < NPHASES; ++p) { a.ph_lo = p; a.ph_hi = p + 1; a.use_bar = 0; hipLaunchKernelGGL(fwd_kernel, dim3(grid), dim3(NTHR), LDS_BYTES, stream, a); }
#endif
}
```

```cpp
#include <hip/hip_runtime.h>
#include <cstdio>
#include <cstdint>

#define GAS __attribute__((address_space(1)))
#define LAS __attribute__((address_space(3)))
typedef unsigned short bf16;
typedef unsigned short bf16_t;
typedef short bf16x8 __attribute__((ext_vector_type(8)));
typedef float f32x4 __attribute__((ext_vector_type(4)));
typedef float f32x2 __attribute__((ext_vector_type(2)));
typedef unsigned u32x4 __attribute__((ext_vector_type(4)));
typedef unsigned u32x2 __attribute__((ext_vector_type(2)));

constexpr int NTOK = 16384, DM = 2048, DIN = 4352, SEQ = 4096, NBATCH = 4;
constexpr int NE = 64, TOPK = 8, DE = 512;
constexpr float ALPHA = 1.4142135623730951f, LN_EPS = 1e-5f, RMS_EPS = 1e-6f, ROUTED_SCALE = 2.5f;
constexpr int C_HQ = 0, C_HF = 512, C_HI = 1024, C_HG = 1536, C_AQ = 2048, C_AK = 3072, C_AV = 3200, C_SU = 3328, C_SV = 3840;
constexpr int MAXTILES = 576;
constexpr int SH_ROW0 = MAXTILES * 256;
constexpr int HS_ROWS = SH_ROW0 + NTOK;

constexpr size_t MiB = 1u << 20;
constexpr size_t WS_CTL = 0, CTL_ZERO_BYTES = 1 * MiB;
constexpr size_t WS_LIST = 1 * MiB;
constexpr size_t WS_WLIST = 5 * MiB;
constexpr size_t WS_SLOT = 9 * MiB;
constexpr size_t WS_RT = 12 * MiB;
constexpr size_t WS_DEND = 10 * MiB;
constexpr size_t WS_STATE = 16 * MiB;
constexpr size_t WS_HF = 64 * MiB;
constexpr size_t WS_HB = 192 * MiB;
constexpr size_t WS_PROJ = 256 * MiB;
constexpr size_t WS_MIXED = 392 * MiB;
constexpr size_t WS_HS = 456 * MiB;
constexpr size_t WS_Y = 616 * MiB;
constexpr size_t WS_W = 1192 * MiB;
constexpr size_t W_IN_B = (size_t)DIN * DM * 2, W_OUT_B = (size_t)DM * DM * 2, W_GU_B = (size_t)1024 * DM * 2, W_D_B = (size_t)DM * DE * 2;
constexpr size_t WL_IN = 0, WL_OUT = W_IN_B, WL_GU = WL_OUT + W_OUT_B, WL_D = WL_GU + 65 * W_GU_B, WL_BYTES = WL_D + 65 * W_D_B;
constexpr size_t WS_END = WS_W + 2 * WL_BYTES;
static_assert(WS_HS + (size_t)HS_ROWS * 512 * 2 <= WS_Y && WS_Y + (size_t)MAXTILES * 256 * DM * 2 <= WS_W && WS_END <= 2048 * MiB, "d_ws map");
constexpr int CW_CNT = 64;
constexpr int CW_BAR = 4096;

constexpr int LDS_BYTES = 147456;
constexpr int MISC_OFF = LDS_BYTES - 256;
constexpr int TAB_OFF = 131072;
constexpr int NWAVES = 8, NTHR = 512;

#define LDS_WAIT() asm volatile("s_waitcnt lgkmcnt(0)" ::: "memory")
#define VM_WAIT() asm volatile("s_waitcnt vmcnt(0)" ::: "memory")
#define RLX_AGENT __ATOMIC_RELAXED, __HIP_MEMORY_SCOPE_AGENT

__device__ __forceinline__ unsigned f2bf(float f) { unsigned u = __builtin_bit_cast(unsigned, f); return (u + 0x7fffu + ((u >> 16) & 1u)) >> 16; }
__device__ __forceinline__ unsigned pk2(float lo, float hi) { return f2bf(lo) | (f2bf(hi) << 16); }
__device__ __forceinline__ float bflo(unsigned w) { return __uint_as_float(w << 16); }
__device__ __forceinline__ float bfhi(unsigned w) { return __uint_as_float(w & 0xffff0000u); }
__device__ __forceinline__ float bf2f(bf16 v) { return __uint_as_float((unsigned)v << 16); }
__device__ __forceinline__ float wave_sum(float v) {
#pragma unroll
    for (int o = 1; o < 64; o <<= 1) v += __shfl_xor(v, o);
    return v;
}
__device__ __forceinline__ int tid_of_wave(int wave) {
    int l; asm volatile("v_mbcnt_lo_u32_b32 %0, -1, 0\n\tv_mbcnt_hi_u32_b32 %0, -1, %0" : "=v"(l)); return wave * 64 + l; }
__device__ __forceinline__ float sigmoidf_(float x) { return 1.0f / (1.0f + __expf(-x)); }
__device__ __forceinline__ float siluf_(float x) { return x / (1.0f + __expf(-x)); }
__device__ __forceinline__ float geluf_(float x) { return 0.5f * x * (1.0f + erff(x * 0.70710678118654752f)); }

namespace pg8 {
#define PG8_LAS __attribute__((address_space(3)))
constexpr int BM = 256, BK = 64, HALF = 128, HTB = HALF * BK * 2, STAGE_BYTES = 8 * HTB, NXCD = 8, WGM = 8;
__host__ __device__ __forceinline__ int lds_byte(int r, int c) { const int st = (r >> 4) * 2 + (c >> 5), rr = r & 15, cc = c & 31, ob = rr * 64 + cc * 2; return st * 1024 + (ob ^ (((ob >> 9) & 1) << 5)); }
__host__ __device__ __forceinline__ void stage_rc(int b, int& R, int& C) { const int st = b / 1024, sb = b % 1024, swz = sb ^ (((sb >> 9) & 1) << 5); R = (st >> 1) * 16 + swz / 64; C = (st & 1) * 32 + (swz % 64) / 2; }
__host__ __device__ __forceinline__ int perm32(int rho) { const int n = rho >> 4, i = rho & 15; return 8 * (i >> 2) + 4 * n + (i & 3); }

struct Unit { int pm, pn, e, p0, nv; };

__device__ __forceinline__ unsigned cvt_pk_bf16(float lo, float hi) { unsigned r; asm volatile("v_cvt_pk_bf16_f32 %0, %1, %2" : "=v"(r) : "v"(lo), "v"(hi)); return r; }

struct PlainSched {
    static constexpr bool GATHER = false;
    int nM, nN, nwg, G, c, K; const char* Bt;
    __device__ void init(int M, int N, int K_, int G_, int c_, const void* Bt_) { nM = M / BM; nN = N / BM; nwg = nM * nN; G = G_; c = c_; K = K_; Bt = (const char*)Bt_; }
    __device__ __forceinline__ bool next(int i, Unit& u) const {
        const long L = (long)i * G + c; if (L >= nwg) return false;
        int wgid = (int)L; { const int q = nwg / NXCD, r = nwg % NXCD, xcd = wgid % NXCD, off = wgid / NXCD; wgid = (xcd < r ? xcd * (q + 1) : r * (q + 1) + (xcd - r) * q) + off; }
        const int nig = WGM * nN, gid = wgid / nig, fm = gid * WGM, gsz = (nM - fm) < WGM ? (nM - fm) : WGM;
        u.pm = fm + ((wgid % nig) % gsz); u.pn = (wgid % nig) / gsz; u.e = 0; u.p0 = 0; u.nv = 256; return true;
    }
    __device__ __forceinline__ unsigned arow(const Unit& u, int r) const { return 0u; }
    __device__ __forceinline__ size_t aoff(const Unit& u) const { return (size_t)u.pm * BM * K * 2; }
    __device__ __forceinline__ const char* bbase(const Unit& u) const { return Bt + (size_t)u.pn * BM * K * 2; }
};
template <bool GATHER_> struct MoeSched {
    static constexpr bool GATHER = GATHER_;
    const PG8_LAS int* cnts; const PG8_LAS int* tstart; const PG8_LAS int* tile_e;
    int ntiles, npn, G, vcu, K; const int* list; const char* Bt; size_t estride;
    __device__ __forceinline__ bool next(int i, Unit& u) const {
        const int U = i * G + vcu; if (U >= ntiles * npn) return false;
        u.pm = U / npn; u.pn = U % npn; u.e = __builtin_amdgcn_readfirstlane(tile_e[u.pm]); u.p0 = (u.pm - __builtin_amdgcn_readfirstlane(tstart[u.e])) * BM; const int rem = __builtin_amdgcn_readfirstlane(cnts[u.e]) - u.p0; u.nv = rem < BM ? rem : BM; return true;
    }
    __device__ __forceinline__ unsigned arow(const Unit& u, int r) const { const int tok = (r < u.nv) ? list[u.e * NTOK + u.p0 + r] : 0; return (unsigned)tok * (unsigned)(K * 2); }
    __device__ __forceinline__ size_t aoff(const Unit& u) const { return (size_t)u.pm * BM * K * 2; }
    __device__ __forceinline__ const char* bbase(const Unit& u) const { return Bt + (size_t)u.e * estride + (size_t)u.pn * BM * K * 2; }
};

struct EpiBf16Bias {
    static constexpr bool PERM = true;
    bf16_t* O; int ldc; const float* bias;
    __device__ __forceinline__ void operator()(const f32x4 (&acc)[2][2][4][2], const Unit& u, int wr, int wc, int fr, int fq) const {
        const int row0 = u.pm * BM + wr * 64 + fr, col0 = u.pn * BM + wc * 32 + 8 * fq;
        f32x4 bv[2][2];
#pragma unroll
        for (int bj = 0; bj < 2; ++bj)
#pragma unroll
            for (int n = 0; n < 2; ++n) bv[bj][n] = *(const f32x4*)(bias + col0 + bj * HALF + 4 * n);
#pragma unroll
        for (int ai = 0; ai < 2; ++ai)
#pragma unroll
            for (int m = 0; m < 4; ++m) { bf16_t* rowp = O + (size_t)(row0 + ai * HALF + m * 16) * ldc + col0;
#pragma unroll
                for (int bj = 0; bj < 2; ++bj) { const f32x4 v0 = acc[ai][bj][m][0] + bv[bj][0], v1 = acc[ai][bj][m][1] + bv[bj][1];
                    u32x4 w; w.x = cvt_pk_bf16(v0[0], v0[1]); w.y = cvt_pk_bf16(v0[2], v0[3]); w.z = cvt_pk_bf16(v1[0], v1[1]); w.w = cvt_pk_bf16(v1[2], v1[3]);
                    *(u32x4*)(rowp + bj * HALF) = w; } }
    }
};
struct EpiResF32 {
    static constexpr bool PERM = false;
    float* C; int ldc; float alpha;
    __device__ __forceinline__ void operator()(const f32x4 (&acc)[2][2][4][2], const Unit& u, int wr, int wc, int fr, int fq) const {
        const int row0 = u.pm * BM + wr * 64 + fr, col0 = u.pn * BM + wc * 32 + 4 * fq;
#pragma unroll
        for (int ai = 0; ai < 2; ++ai)
#pragma unroll
            for (int m = 0; m < 4; ++m) { float* rowp = C + (size_t)(row0 + ai * HALF + m * 16) * ldc + col0;
#pragma unroll
                for (int bj = 0; bj < 2; ++bj)
#pragma unroll
                    for (int n = 0; n < 2; ++n) { f32x4* p = (f32x4*)(rowp + bj * HALF + n * 16); const f32x4 o = *p; *p = o * alpha + acc[ai][bj][m][n]; } }
    }
};
struct EpiSwiGLU {
    static constexpr bool PERM = true;
    bf16_t* O;
    __device__ __forceinline__ void operator()(const f32x4 (&acc)[2][2][4][2], const Unit& u, int wr, int wc, int fr, int fq) const {
        const int row0 = u.pm * BM + wr * 64 + fr, col0 = u.pn * HALF + wc * 32 + 8 * fq;
#pragma unroll
        for (int ai = 0; ai < 2; ++ai)
#pragma unroll
            for (int m = 0; m < 4; ++m) { bf16_t* rowp = O + (size_t)(row0 + ai * HALF + m * 16) * DE + col0;
                float o[8];
#pragma unroll
                for (int n = 0; n < 2; ++n)
#pragma unroll
                    for (int j = 0; j < 4; ++j) { const float g = acc[ai][0][m][n][j], up = acc[ai][1][m][n][j]; o[n * 4 + j] = g / (1.0f + __expf(-g)) * up; }
                u32x4 w; w.x = cvt_pk_bf16(o[0], o[1]); w.y = cvt_pk_bf16(o[2], o[3]); w.z = cvt_pk_bf16(o[4], o[5]); w.w = cvt_pk_bf16(o[6], o[7]);
                *(u32x4*)rowp = w; }
    }
};
struct EpiDownY {
    static constexpr bool PERM = true;
    bf16_t* Y; const float* wlist;
    __device__ __forceinline__ void operator()(const f32x4 (&acc)[2][2][4][2], const Unit& u, int wr, int wc, int fr, int fq) const {
        const int rl0 = wr * 64 + fr, col0 = u.pn * BM + wc * 32 + 8 * fq;
#pragma unroll
        for (int ai = 0; ai < 2; ++ai)
#pragma unroll
            for (int m = 0; m < 4; ++m) { const int rl = rl0 + ai * HALF + m * 16; const float w8 = (rl < u.nv) ? wlist[u.e * NTOK + u.p0 + rl] : 0.f;
                bf16_t* rowp = Y + (size_t)(u.pm * BM + rl) * DM + col0;
#pragma unroll
                for (int bj = 0; bj < 2; ++bj) { const f32x4 v0 = acc[ai][bj][m][0] * w8, v1 = acc[ai][bj][m][1] * w8;
                    u32x4 w; w.x = cvt_pk_bf16(v0[0], v0[1]); w.y = cvt_pk_bf16(v0[2], v0[3]); w.z = cvt_pk_bf16(v1[0], v1[1]); w.w = cvt_pk_bf16(v1[2], v1[3]);
                    *(u32x4*)(rowp + bj * HALF) = w; } }
    }
};

template <class Epi, class Sched, bool ALIGN_EPI>
__device__ __forceinline__ void gemm_phase(PG8_LAS unsigned char* lds, const char* Abase, const int K, const Sched& S, const Epi& E, const int wave_s) {
    int tid_ = tid_of_wave(wave_s); asm volatile("" : "+v"(tid_));
    const int tid = tid_, wid = __builtin_amdgcn_readfirstlane(tid >> 6), lane = tid & 63, wr = wid >> 2, wc = wid & 3, fr = lane & 15, fq = lane >> 4;
    const int nt = K / BK;
    int RA[2]; unsigned CA2[2], voffB[2];
#pragma unroll
    for (int i = 0; i < 2; ++i) { int R, C; stage_rc(tid * 16 + i * 8192, R, C); const int Rb = Epi::PERM ? ((R & ~31) + perm32(R & 31)) : R;
        RA[i] = R; CA2[i] = (unsigned)C * 2u; voffB[i] = (unsigned)(Rb * K + C) * 2u; }
    const size_t kstep = (size_t)(BK * 2);
    const size_t hstep = (size_t)HALF * K * 2;
    const unsigned ldsw = (unsigned)wid * 1024u;
    const int aoff = lds_byte(wr * 64 + fr, fq * 8), boff = lds_byte(wc * 32 + fr, fq * 8);
#define PG8_SA(b, h) (((b) * 2 + (h)) * HTB)
#define PG8_SB(b, h) ((4 + (b) * 2 + (h)) * HTB)
#define PG8_STAGE(bufoff, gbase, voff) do { _Pragma("unroll") for (int _i = 0; _i < 2; ++_i) \
        __builtin_amdgcn_global_load_lds((const unsigned*)((const char*)(gbase) + (voff)[_i]), (PG8_LAS unsigned*)(lds + (bufoff) + ldsw + _i * 8192), 16, 0, 0); } while (0)
#define PG8_LDA(dst, b, h) do { _Pragma("unroll") for (int m = 0; m < 4; ++m) _Pragma("unroll") for (int k = 0; k < 2; ++k) dst[m][k] = *(const PG8_LAS bf16x8*)(lds + PG8_SA(b, h) + aoff + m * 2048 + k * 1024); } while (0)
#define PG8_LDB(dst, b, h) do { _Pragma("unroll") for (int n = 0; n < 2; ++n) _Pragma("unroll") for (int k = 0; k < 2; ++k) dst[n][k] = *(const PG8_LAS bf16x8*)(lds + PG8_SB(b, h) + boff + n * 2048 + k * 1024); } while (0)
#define PG8_MMA(ai, bj, At, Bt) do { __builtin_amdgcn_s_setprio(1); _Pragma("unroll") for (int m = 0; m < 4; ++m) _Pragma("unroll") for (int n = 0; n < 2; ++n) _Pragma("unroll") for (int k = 0; k < 2; ++k) \
        acc[ai][bj][m][n] = __builtin_amdgcn_mfma_f32_16x16x32_bf16(Bt[n][k], At[m][k], acc[ai][bj][m][n], 0, 0, 0); __builtin_amdgcn_s_setprio(0); } while (0)
#define PG8_WAIT_V(n) asm volatile("s_waitcnt vmcnt(" #n ")" ::: "memory")
#define PG8_WAIT_L(n) asm volatile("s_waitcnt lgkmcnt(" #n ")" ::: "memory")
#define PG8_BAR __builtin_amdgcn_s_barrier()
#define PG8_SCHED __builtin_amdgcn_sched_barrier(0)
    Unit cur, nxt; int ui = 0;
    if (!S.next(0, cur)) return;
    f32x4 acc[2][2][4][2];
#pragma unroll
    for (int a = 0; a < 2; ++a)
#pragma unroll
        for (int b = 0; b < 2; ++b)
#pragma unroll
            for (int m = 0; m < 4; ++m)
#pragma unroll
                for (int n = 0; n < 2; ++n) acc[a][b][m][n] = (f32x4){0.f, 0.f, 0.f, 0.f};
    bf16x8 At[4][2], B0[2][2], B1[2][2];
    unsigned voffA[2], ca0[2], ca1[2], na0[2], na1[2];
#pragma unroll
    for (int i = 0; i < 2; ++i) { voffA[i] = (unsigned)(RA[i] * K) * 2u + CA2[i]; ca0[i] = ca1[i] = na0[i] = na1[i] = 0u; }
    const char* cA = Abase; const char* cB = S.bbase(cur);
    if constexpr (Sched::GATHER) {
#pragma unroll
        for (int i = 0; i < 2; ++i) { ca0[i] = S.arow(cur, RA[i]) + CA2[i]; ca1[i] = S.arow(cur, HALF + RA[i]) + CA2[i]; }
    } else cA = Abase + S.aoff(cur);
#define PG8_STAGE_A(bufoff, p, h, g0, g1) do { if constexpr (Sched::GATHER) { if ((h) == 0) PG8_STAGE(bufoff, p, g0); else PG8_STAGE(bufoff, p, g1); } \
        else { PG8_STAGE(bufoff, (p) + (h) * hstep, voffA); } } while (0)
    PG8_STAGE(PG8_SB(0, 0), cB, voffB); PG8_STAGE(PG8_SB(0, 1), cB + hstep, voffB); PG8_STAGE_A(PG8_SA(0, 0), cA, 0, ca0, ca1); PG8_STAGE_A(PG8_SA(0, 1), cA, 1, ca0, ca1);
    if (wr == 1) PG8_BAR;
    PG8_WAIT_V(2); PG8_BAR;
    PG8_STAGE(PG8_SB(1, 0), cB + kstep, voffB); PG8_STAGE_A(PG8_SA(1, 0), cA + kstep, 0, ca0, ca1); PG8_STAGE(PG8_SB(1, 1), cB + hstep + kstep, voffB);
    PG8_WAIT_V(6); PG8_BAR;
    for (;;) {
        const bool has_next = S.next(ui + 1, nxt);
        const char* nA = cA; const char* nB = has_next ? S.bbase(nxt) : cB;
        if constexpr (Sched::GATHER) {
            if (has_next) {
#pragma unroll
                for (int i = 0; i < 2; ++i) { na0[i] = S.arow(nxt, RA[i]) + CA2[i]; na1[i] = S.arow(nxt, HALF + RA[i]) + CA2[i]; }
            } else {
#pragma unroll
                for (int i = 0; i < 2; ++i) { na0[i] = ca0[i]; na1[i] = ca1[i]; }
            }
        } else { if (has_next) nA = Abase + S.aoff(nxt); }
        for (int t = 0; t < nt; t += 2) {
            const bool last = (t == nt - 2);
            const char* a1 = cA + (size_t)(t + 1) * kstep;
            const char* a2 = last ? nA : cA + (size_t)(t + 2) * kstep; const char* b2 = last ? nB : cB + (size_t)(t + 2) * kstep;
            const char* a3 = a2 + kstep; const char* b3 = b2 + kstep;
            unsigned s0[2], s1[2];
#pragma unroll
            for (int i = 0; i < 2; ++i) { s0[i] = last ? na0[i] : ca0[i]; s1[i] = last ? na1[i] : ca1[i]; }
            PG8_LDB(B0, 0, 0); PG8_LDB(B1, 0, 1); PG8_SCHED; PG8_LDA(At, 0, 0); PG8_STAGE_A(PG8_SA(1, 1), a1, 1, ca0, ca1);
            PG8_WAIT_V(8); PG8_WAIT_L(0); PG8_BAR; PG8_MMA(0, 0, At, B0); PG8_MMA(0, 1, At, B1); PG8_BAR; PG8_SCHED;
            PG8_LDA(At, 0, 1); PG8_STAGE(PG8_SB(0, 0), b2, voffB); PG8_STAGE(PG8_SB(0, 1), b2 + hstep, voffB); PG8_STAGE_A(PG8_SA(0, 0), a2, 0, s0, s1);
            PG8_WAIT_V(8); PG8_WAIT_L(0); PG8_BAR; PG8_MMA(1, 0, At, B0); PG8_MMA(1, 1, At, B1); PG8_BAR; PG8_SCHED;
            PG8_LDB(B0, 1, 0); PG8_LDB(B1, 1, 1); PG8_SCHED; PG8_LDA(At, 1, 0); PG8_STAGE_A(PG8_SA(0, 1), a2, 1, s0, s1);
            PG8_WAIT_V(8); PG8_WAIT_L(0); PG8_BAR; PG8_MMA(0, 0, At, B0); PG8_MMA(0, 1, At, B1); PG8_BAR; PG8_SCHED;
            PG8_LDA(At, 1, 1); PG8_STAGE(PG8_SB(1, 0), b3, voffB); PG8_STAGE(PG8_SB(1, 1), b3 + hstep, voffB); PG8_STAGE_A(PG8_SA(1, 0), a3, 0, s0, s1);
            PG8_WAIT_V(8); PG8_WAIT_L(0); PG8_BAR; PG8_MMA(1, 0, At, B0); PG8_MMA(1, 1, At, B1); PG8_BAR; PG8_SCHED;
        }
        if constexpr (ALIGN_EPI) { if (wr == 0) PG8_BAR; }
        E(acc, cur, wr, wc, fr, fq);
        if (!has_next) break;
#pragma unroll
        for (int a = 0; a < 2; ++a)
#pragma unroll
            for (int b = 0; b < 2; ++b)
#pragma unroll
                for (int m = 0; m < 4; ++m)
#pragma unroll
                    for (int n = 0; n < 2; ++n) acc[a][b][m][n] = (f32x4){0.f, 0.f, 0.f, 0.f};
        cur = nxt; cA = nA; cB = nB; ++ui;
        if constexpr (Sched::GATHER) {
#pragma unroll
            for (int i = 0; i < 2; ++i) { ca0[i] = na0[i]; ca1[i] = na1[i]; }
        }
        if constexpr (ALIGN_EPI) { if (wr == 1) PG8_BAR; }
    }
    PG8_WAIT_V(0);
    if constexpr (!ALIGN_EPI) { if (wr == 0) PG8_BAR; }
    PG8_BAR;
#undef PG8_SA
#undef PG8_SB
#undef PG8_STAGE
#undef PG8_LDA
#undef PG8_LDB
#undef PG8_MMA
#undef PG8_WAIT_V
#undef PG8_WAIT_L
#undef PG8_BAR
#undef PG8_SCHED
#undef PG8_STAGE_A
}
}

#define XB_TMO      128
#define XB_XCNT(j)  (256  + 64 * (j))
#define XB_XSUB(j)  (1280 + 64 * (j))
#define XB_XGEN(j)  (2304 + 64 * (j))
#define XB_TOP      3328
#define XB_TOPGEN   3392
#define XCD_BAR_WORDS 3456
#define XB_SPIN_CAP (1u << 18)
__device__ __forceinline__ unsigned xb_ld(unsigned* p)              { return __hip_atomic_load(p, __ATOMIC_RELAXED, __HIP_MEMORY_SCOPE_AGENT); }
__device__ __forceinline__ unsigned xb_add(unsigned* p, unsigned v) { return __hip_atomic_fetch_add(p, v, __ATOMIC_RELAXED, __HIP_MEMORY_SCOPE_AGENT); }
__device__ __forceinline__ unsigned xb_xcc_id() { return (unsigned)__builtin_amdgcn_s_getreg((3 << 11) | 20) & 0xFu; }
#define XB_SPIN(cond, bar) do { unsigned _sp = 0; while (cond) { __builtin_amdgcn_s_sleep(1); \
    if ((++_sp & 255u) == 0u) { if (xb_ld(&(bar)[XB_TMO])) break; if (_sp > XB_SPIN_CAP) { atomicAdd(&(bar)[XB_TMO], 1u); break; } } } } while (0)
struct XcdBarrier { unsigned* bar; unsigned x; volatile LAS unsigned* st; };
__device__ __forceinline__ XcdBarrier xcd_barrier_post(unsigned* bar, volatile LAS unsigned* st) {
    XcdBarrier b; b.bar = bar; b.x = xb_xcc_id(); b.st = st;
    if (threadIdx.x == 0) (void)xb_add(&bar[XB_XCNT(b.x)], 1u);
    return b;
}
__device__ __forceinline__ void xcd_barrier_complete(unsigned* bar, unsigned x, unsigned& nloc, unsigned& nx) {
    const unsigned G = gridDim.x * gridDim.y * gridDim.z;
    unsigned sum, cnt, mine, sp = 0u;
    for (;;) {
        sum = 0u; cnt = 0u; mine = 0u;
#pragma unroll
        for (unsigned j = 0; j < 16; ++j) { const unsigned c = xb_ld(&bar[XB_XCNT(j)]); sum += c; cnt += (c > 0u) ? 1u : 0u; mine = (j == x) ? c : mine; }
        if (sum == G) break;
        __builtin_amdgcn_s_sleep(1);
        if ((++sp & 255u) == 0u) { if (xb_ld(&bar[XB_TMO])) break; if (sp > XB_SPIN_CAP) { atomicAdd(&bar[XB_TMO], 1u); break; } }
    }
    nloc = mine > 0u ? mine : 1u; nx = cnt > 0u ? cnt : 1u;
}
__device__ __forceinline__ void xcd_barrier(const XcdBarrier& b, const int wave_s, volatile LAS unsigned* stamp = nullptr) {
    asm volatile("s_waitcnt vmcnt(0)" ::: "memory");
    __syncthreads();
    if (tid_of_wave(wave_s) == 0) {
        unsigned* bar = b.bar;
        __builtin_amdgcn_s_waitcnt(0);
        unsigned nloc = b.st[0], nx = b.st[1];
        if (nloc == 0u) { xcd_barrier_complete(bar, b.x, nloc, nx); b.st[0] = nloc; b.st[1] = nx; }
        const unsigned old = xb_add(&bar[XB_XSUB(b.x)], 1u);
        const unsigned gen = old / nloc;
        if (old + 1u == (gen + 1u) * nloc) {
            __builtin_amdgcn_fence(__ATOMIC_RELEASE, "agent");
            asm volatile("s_waitcnt vmcnt(0)" ::: "memory");
            const unsigned og = xb_add(&bar[XB_TOP], 1u);
            const unsigned tg = og / nx;
            if (og + 1u == (tg + 1u) * nx) xb_add(&bar[XB_TOPGEN], 1u);
            else XB_SPIN(xb_ld(&bar[XB_TOPGEN]) == tg, bar);
            __builtin_amdgcn_fence(__ATOMIC_ACQUIRE, "agent");
            xb_add(&bar[XB_XGEN(b.x)], 1u);
            asm volatile("s_waitcnt vmcnt(0)" ::: "memory");
        } else {
            XB_SPIN(xb_ld(&bar[XB_XGEN(b.x)]) == gen, bar);
            __builtin_amdgcn_fence(__ATOMIC_ACQUIRE, "agent");
            asm volatile("s_waitcnt vmcnt(0)" ::: "memory");
        }
        if (stamp) { const unsigned long long t_ = __builtin_amdgcn_s_memrealtime(); stamp[0] = (unsigned)t_; stamp[1] = (unsigned)(t_ >> 32); }
    }
    __syncthreads();
}

struct Args { const float* in[25]; float* out; unsigned char* ws; int ph_lo, ph_hi, use_bar, pad; };
struct Frame {
    LAS unsigned char* lds; unsigned* ctl; int tid, lane, wave, vcu, G;
    const float* const* in_;
};

__device__ __forceinline__ void transpose_pair(const float* W, int K, int N, bf16* WT, int mode, LAS float* scr, int item, int lane) {
    const int nblk = N / 32, kb = item / nblk, nb = item % nblk, k0 = 64 * kb, n0 = 32 * nb;
    f32x4 v[16];
#pragma unroll
    for (int i = 0; i < 16; ++i) { const int kk = 4 * i + (lane >> 4); v[i] = *(const f32x4*)(W + (size_t)(k0 + kk) * N + n0 + (lane & 15) * 4); }
#pragma unroll
    for (int i = 0; i < 16; ++i) { const int kk = 4 * i + (lane >> 4); LAS float* d = scr + kk * 65 + (lane & 15) * 4; d[0] = v[i].x; d[1] = v[i].y; d[2] = v[i].z; d[3] = v[i].w; }
    LDS_WAIT(); asm volatile("" ::: "memory");
    const int r0 = mode ? ((n0 >> 7) * 256 + (n0 & 127) + (mode == 2 ? 128 : 0)) : n0;
    const int c = lane & 7;
#pragma unroll
    for (int j = 0; j < 8; ++j) { const int n = (lane >> 3) + 8 * j; const LAS float* sp = scr + (8 * c) * 65 + n;
        u32x4 o; o.x = pk2(sp[0 * 65], sp[1 * 65]); o.y = pk2(sp[2 * 65], sp[3 * 65]); o.z = pk2(sp[4 * 65], sp[5 * 65]); o.w = pk2(sp[6 * 65], sp[7 * 65]);
        *(u32x4*)(WT + (size_t)(r0 + n) * K + k0 + 8 * c) = o; }
    LDS_WAIT(); asm volatile("" ::: "memory");
}
constexpr int IT_IN = (DM / 64) * (DIN / 32), IT_OUT = (DM / 64) * (DM / 32), IT_G = (DM / 64) * (DE / 32), IT_D = (DE / 64) * (DM / 32);
constexpr int IT_LAYER = IT_IN + IT_OUT + 65 * (2 * IT_G + IT_D);
static_assert(IT_LAYER % 2 == 0 && IT_IN % 2 == 0 && IT_OUT % 2 == 0 && IT_G % 2 == 0 && IT_D % 2 == 0, "pairs of transpose items stay inside one matrix");

__device__ __forceinline__ void ln_regs(f32x4 (&v)[8], const float* gain, const float* bias, int lane) {
    float s = 0.f;
#pragma unroll
    for (int j = 0; j < 8; ++j) s += (v[j].x + v[j].y) + (v[j].z + v[j].w);
    const float mean = wave_sum(s) * (1.f / DM); float s2 = 0.f;
#pragma unroll
    for (int j = 0; j < 8; ++j) { v[j] = v[j] - mean; s2 += (v[j].x * v[j].x + v[j].y * v[j].y) + (v[j].z * v[j].z + v[j].w * v[j].w); }
    const float rstd = 1.f / sqrtf(wave_sum(s2) * (1.f / DM) + LN_EPS);
#pragma unroll
    for (int j = 0; j < 8; ++j) { const f32x4 g = ((const f32x4*)gain)[j * 64 + lane], b = ((const f32x4*)bias)[j * 64 + lane]; v[j] = v[j] * rstd * g + b; }
}
__device__ __forceinline__ void store_row_f32(float* dst, const f32x4 (&v)[8], int lane) {
#pragma unroll
    for (int j = 0; j < 8; ++j) ((f32x4*)dst)[j * 64 + lane] = v[j];
}
__device__ __forceinline__ void store_row_bf16(bf16* dst, const f32x4 (&v)[8], int lane) {
#pragma unroll
    for (int j = 0; j < 8; ++j) { u32x2 w; w.x = pk2(v[j].x, v[j].y); w.y = pk2(v[j].z, v[j].w); ((u32x2*)dst)[j * 64 + lane] = w; }
}


typedef float f32x16 __attribute__((ext_vector_type(16)));
#define MFMA32(a, b, c) __builtin_amdgcn_mfma_f32_32x32x16_bf16((a), (b), (c), 0, 0, 0)
__device__ __forceinline__ int krow16(int r, int h) { return (r & 3) + 8 * (r >> 2) + 4 * h; }
__device__ __forceinline__ bf16x8 pack8(const f32x16& x, int s) {
    u32x4 p; p.x = pk2(x[8 * s], x[8 * s + 1]); p.y = pk2(x[8 * s + 2], x[8 * s + 3]); p.z = pk2(x[8 * s + 4], x[8 * s + 5]); p.w = pk2(x[8 * s + 6], x[8 * s + 7]);
    return __builtin_bit_cast(bf16x8, p);
}
constexpr int SWA_KS_BYTES = 192 * 128, SWA_VT_STRIDE = 196, SWA_VT_BYTES = 64 * SWA_VT_STRIDE * 2;
__device__ __forceinline__ void swa_unit(LAS unsigned char* lds, const bf16* projp, bf16* mixedp, const float* sinks, const float* gain, int unit, int tid, int lane, int wave) {
    const int b = unit >> 6, blk = (unit >> 1) & 31, half = unit & 1;
    const int kp0 = blk * 128 - 128 + 64 * half, qp0 = blk * 128 + 64 * half;
    LAS unsigned char* Ks = lds;
    LAS bf16* Vt = (LAS bf16*)(lds + 2 * SWA_KS_BYTES);
    LAS float* ssq = (LAS float*)(lds + 2 * SWA_KS_BYTES + 2 * SWA_VT_BYTES);
    __syncthreads();
    for (int i = 0; i < 6; ++i) {
        const int idx = tid + NTHR * i, kvh = idx / 1536, rem = idx % 1536, s = rem >> 3, ch = rem & 7, kp = kp0 + s;
        u32x4 kw = (u32x4){0u, 0u, 0u, 0u}, vw = (u32x4){0u, 0u, 0u, 0u};
        if (kp >= 0) { const bf16* rp = projp + (size_t)(b * SEQ + kp) * DIN + kvh * 64 + ch * 8; kw = *(const u32x4*)(rp + C_AK); vw = *(const u32x4*)(rp + C_AV); }
        *(LAS u32x4*)(Ks + kvh * SWA_KS_BYTES + s * 128 + ((ch ^ (s & 7)) << 4)) = kw;
        LAS bf16* vd = Vt + kvh * (64 * SWA_VT_STRIDE) + (ch * 8) * SWA_VT_STRIDE + s;
        vd[0 * SWA_VT_STRIDE] = (bf16)(vw.x & 0xffffu); vd[1 * SWA_VT_STRIDE] = (bf16)(vw.x >> 16); vd[2 * SWA_VT_STRIDE] = (bf16)(vw.y & 0xffffu); vd[3 * SWA_VT_STRIDE] = (bf16)(vw.y >> 16);
        vd[4 * SWA_VT_STRIDE] = (bf16)(vw.z & 0xffffu); vd[5 * SWA_VT_STRIDE] = (bf16)(vw.z >> 16); vd[6 * SWA_VT_STRIDE] = (bf16)(vw.w & 0xffffu); vd[7 * SWA_VT_STRIDE] = (bf16)(vw.w >> 16);
    }
    __syncthreads();
    const int c32 = lane & 31, h = lane >> 5, kvh = wave >> 2;
    const LAS unsigned char* Kw = Ks + kvh * SWA_KS_BYTES; const LAS bf16* Vw = Vt + kvh * (64 * SWA_VT_STRIDE);
#pragma unroll 1
    for (int item = 0; item < 4; ++item) {
        const int hd = wave * 2 + (item >> 1), qi = item & 1, rho = 32 * qi + c32;
        const bf16* qp = projp + (size_t)(b * SEQ + qp0 + rho) * DIN + C_AQ + hd * 64 + 8 * h;
        bf16x8 qf[4];
#pragma unroll
        for (int ks = 0; ks < 4; ++ks) qf[ks] = __builtin_bit_cast(bf16x8, *(const u32x4*)(qp + 16 * ks));
        f32x16 X[5];
#pragma unroll
        for (int kt = 0; kt < 5; ++kt) {
            const int key = 32 * (qi + kt) + c32;
#pragma unroll
            for (int r = 0; r < 16; ++r) X[kt][r] = 0.f;
#pragma unroll
            for (int ks = 0; ks < 4; ++ks) { const bf16x8 kf = *(const LAS bf16x8*)(Kw + key * 128 + (((2 * ks + h) ^ (key & 7)) << 4)); X[kt] = MFMA32(kf, qf[ks], X[kt]); }
        }
        const float sink = sinks[hd];
        float m = sink;
#pragma unroll
        for (int kt = 0; kt < 5; ++kt)
#pragma unroll
            for (int r = 0; r < 16; ++r) { const int s = 32 * (qi + kt) + krow16(r, h); const bool valid = (s > rho) && (s <= rho + 128) && (kp0 + s >= 0);
                const float sc = valid ? X[kt][r] * 0.125f : -INFINITY; X[kt][r] = sc; m = fmaxf(m, sc); }
        m = fmaxf(m, __shfl_xor(m, 32));
        float lsum = 0.f;
#pragma unroll
        for (int kt = 0; kt < 5; ++kt)
#pragma unroll
            for (int r = 0; r < 16; ++r) { const float p = __expf(X[kt][r] - m); X[kt][r] = p; lsum += p; }
        lsum += __shfl_xor(lsum, 32); lsum += __expf(sink - m);
        f32x16 O[2];
#pragma unroll
        for (int dt = 0; dt < 2; ++dt)
#pragma unroll
            for (int r = 0; r < 16; ++r) O[dt][r] = 0.f;
#pragma unroll
        for (int kt = 0; kt < 5; ++kt)
#pragma unroll
            for (int s2 = 0; s2 < 2; ++s2) { const bf16x8 pf = pack8(X[kt], s2); const int kb = 32 * (qi + kt) + 16 * s2 + 4 * h;
#pragma unroll
                for (int dt = 0; dt < 2; ++dt) { const LAS bf16* vp = Vw + (32 * dt + c32) * SWA_VT_STRIDE + kb;
                    const u32x2 v0 = *(const LAS u32x2*)vp, v1 = *(const LAS u32x2*)(vp + 8);
                    const bf16x8 vf = __builtin_bit_cast(bf16x8, (u32x4){v0.x, v0.y, v1.x, v1.y}); O[dt] = MFMA32(vf, pf, O[dt]); } }
        const float inv = 1.0f / lsum; float ss = 0.f;
        bf16* op = mixedp + (size_t)(b * SEQ + qp0 + rho) * DM + 512 + hd * 64 + 4 * h;
#pragma unroll
        for (int dt = 0; dt < 2; ++dt)
#pragma unroll
            for (int g4 = 0; g4 < 4; ++g4) { const float o0 = O[dt][4 * g4] * inv, o1 = O[dt][4 * g4 + 1] * inv, o2 = O[dt][4 * g4 + 2] * inv, o3 = O[dt][4 * g4 + 3] * inv;
                ss += (o0 * o0 + o1 * o1) + (o2 * o2 + o3 * o3); *(u32x2*)(op + 32 * dt + 8 * g4) = (u32x2){pk2(o0, o1), pk2(o2, o3)}; }
        ss += __shfl_xor(ss, 32);
        if (h == 0) ssq[rho * 16 + hd] = ss;
    }
    __syncthreads();
#pragma unroll 1
    for (int item = 0; item < 4; ++item) {
        const int hd = wave * 2 + (item >> 1), qi = item & 1, rho = 32 * qi + c32;
        float tot = 0.f;
#pragma unroll
        for (int j = 0; j < 16; ++j) tot += ssq[rho * 16 + j];
        const float rr = 1.0f / sqrtf(tot * (1.0f / 1024.0f) + RMS_EPS);
        const float* gp = gain + 512 + hd * 64 + 4 * h;
        bf16* op = mixedp + (size_t)(b * SEQ + qp0 + rho) * DM + 512 + hd * 64 + 4 * h;
#pragma unroll
        for (int dt = 0; dt < 2; ++dt)
#pragma unroll
            for (int g4 = 0; g4 < 4; ++g4) { const u32x2 o = *(const u32x2*)(op + 32 * dt + 8 * g4); const f32x4 g = *(const f32x4*)(gp + 32 * dt + 8 * g4);
                *(u32x2*)(op + 32 * dt + 8 * g4) = (u32x2){pk2(bflo(o.x) * rr * g.x, bfhi(o.x) * rr * g.y), pk2(bflo(o.y) * rr * g.z, bfhi(o.y) * rr * g.w)}; }
    }
    __syncthreads();
}


constexpr int HG_BSTR = 132, HG_HSTR = 136;
constexpr int HG_B_BYTES = 128 * HG_BSTR * 4, HG_H_BYTES = 128 * HG_HSTR * 2;
__device__ __forceinline__ float hg_lb(const float* lb_logits, int l, int hk) { if (l == 0) return 0.f; const float a0 = lb_logits[hk], a1 = lb_logits[512 + hk]; return 1.0f / (1.0f + expf(a0 - a1)); }
__device__ __forceinline__ float hg_logf2(float z, float lb) {
    const float ls = fminf(z, 0.f) - log1pf(expf(-fabsf(z))); const float lf = (lb == 0.f) ? ls : logf(lb + (1.f - lb) * expf(ls)); return lf * 1.4426950408889634f; }
__device__ __forceinline__ void hg_cumsum(LAS float* bL, LAS float* segtot, LAS float* lbs, const bf16* projp, int row0, int h, int tid) {
#pragma unroll 1
    for (int i = 0; i < 4; ++i) { const int idx = tid + NTHR * i, t = idx >> 4, kg = idx & 15;
        const u32x4 z8 = *(const u32x4*)(projp + (size_t)(row0 + t) * DIN + C_HF + h * 128 + kg * 8);
        const f32x4 l0 = *(const LAS f32x4*)(lbs + kg * 8), l1 = *(const LAS f32x4*)(lbs + kg * 8 + 4);
        *(LAS f32x4*)(bL + t * HG_BSTR + kg * 8) = (f32x4){hg_logf2(bflo(z8.x), l0.x), hg_logf2(bfhi(z8.x), l0.y), hg_logf2(bflo(z8.y), l0.z), hg_logf2(bfhi(z8.y), l0.w)};
        *(LAS f32x4*)(bL + t * HG_BSTR + kg * 8 + 4) = (f32x4){hg_logf2(bflo(z8.z), l1.x), hg_logf2(bfhi(z8.z), l1.y), hg_logf2(bflo(z8.w), l1.z), hg_logf2(bfhi(z8.w), l1.w)}; }
    __syncthreads();
    { const int k = tid & 127, seg = tid >> 7; float run = 0.f;
        for (int tt = 0; tt < 32; ++tt) { const int t = seg * 32 + tt; run += bL[t * HG_BSTR + k]; bL[t * HG_BSTR + k] = run; }
        segtot[seg * 128 + k] = run;
        __syncthreads();
        float off = 0.f;
#pragma unroll
        for (int s = 0; s < 4; ++s) { const float v = segtot[s * 128 + k]; if (s < seg) off += v; }
        if (seg > 0) for (int tt = 0; tt < 32; ++tt) { const int t = seg * 32 + tt; bL[t * HG_BSTR + k] += off; }
    }
    __syncthreads();
}
__device__ __forceinline__ void hg_stage_vt(LAS bf16* VT, const bf16* projp, int row0, int h, int tid) {
#pragma unroll
    for (int i = 0; i < 4; ++i) { const int idx = tid + NTHR * i, vg = idx >> 7, t = idx & 127;
        const u32x4 w = *(const u32x4*)(projp + (size_t)(row0 + t) * DIN + C_HI + h * 128 + vg * 8);
        LAS bf16* d = VT + (vg * 8) * HG_HSTR + t;
        d[0] = (bf16)(w.x & 0xffffu); d[HG_HSTR] = (bf16)(w.x >> 16); d[2 * HG_HSTR] = (bf16)(w.y & 0xffffu); d[3 * HG_HSTR] = (bf16)(w.y >> 16);
        d[4 * HG_HSTR] = (bf16)(w.z & 0xffffu); d[5 * HG_HSTR] = (bf16)(w.z >> 16); d[6 * HG_HSTR] = (bf16)(w.w & 0xffffu); d[7 * HG_HSTR] = (bf16)(w.w >> 16); }
}
__device__ __forceinline__ void hgrn_local_unit(LAS unsigned char* lds, const bf16* projp, const float* lb_logits, float* stateg, float* dendg, int l, int unit, int tid_in, int lane_in, int wave) {
    int tid = tid_in; asm volatile("" : "+v"(tid)); int lane = tid & 63; (void)lane_in;
    const int bh = unit >> 5, c = unit & 31, b = bh >> 2, h = bh & 3, row0 = b * SEQ + c * 128;
    LAS float* bL = (LAS float*)lds; LAS bf16* VT = (LAS bf16*)(lds + HG_B_BYTES); LAS bf16* kdT = (LAS bf16*)(lds + HG_B_BYTES + HG_H_BYTES);
    LAS float* segtot = (LAS float*)(lds + HG_B_BYTES + 2 * HG_H_BYTES); LAS float* lbs = segtot + 512;
    __syncthreads();
    if (tid < 128) lbs[tid] = hg_lb(lb_logits, l, h * 128 + tid);
    __syncthreads();
    hg_cumsum(bL, segtot, lbs, projp, row0, h, tid);
    hg_stage_vt(VT, projp, row0, h, tid);
    if (tid < 128) dendg[(size_t)(bh * 32 + c) * 128 + tid] = __builtin_amdgcn_exp2f(bL[127 * HG_BSTR + tid]);
#pragma unroll 1
    for (int i = 0; i < 4; ++i) { const int idx = tid + NTHR * i, kg = idx >> 7, t = idx & 127;
        const u32x4 z8 = *(const u32x4*)(projp + (size_t)(row0 + t) * DIN + C_HF + h * 128 + kg * 8);
        const float zf[8] = {bflo(z8.x), bfhi(z8.x), bflo(z8.y), bfhi(z8.y), bflo(z8.z), bfhi(z8.z), bflo(z8.w), bfhi(z8.w)};
#pragma unroll
        for (int j = 0; j < 8; ++j) { const int k = kg * 8 + j; const float kk = (1.f - lbs[k]) / (1.f + expf(zf[j]));
            kdT[k * HG_HSTR + t] = (bf16)f2bf(kk * __builtin_amdgcn_exp2f(bL[127 * HG_BSTR + k] - bL[t * HG_BSTR + k])); } }
    __syncthreads();
    asm volatile("" : "+v"(tid)); lane = tid & 63;
    const int c32 = lane & 31, hh = lane >> 5;
#pragma unroll
    for (int ti = 0; ti < 2; ++ti) { const int tile = wave * 2 + ti, vt = tile >> 2, kt = tile & 3;
        f32x16 acc;
#pragma unroll
        for (int r = 0; r < 16; ++r) acc[r] = 0.f;
#pragma unroll
        for (int ks = 0; ks < 8; ++ks) { const bf16x8 af = *(const LAS bf16x8*)(VT + (32 * vt + c32) * HG_HSTR + 16 * ks + 8 * hh), bf = *(const LAS bf16x8*)(kdT + (32 * kt + c32) * HG_HSTR + 16 * ks + 8 * hh);
            acc = MFMA32(af, bf, acc); }
        float* sp = stateg + (size_t)(bh * 32 + c) * 16384 + 32 * kt + c32;
#pragma unroll
        for (int r = 0; r < 16; ++r) sp[(size_t)(32 * vt + krow16(r, hh)) * 128] = acc[r];
    }
    __syncthreads();
}
__device__ __forceinline__ void hgrn_out_unit(LAS unsigned char* lds, const bf16* projp, bf16* mixedp, const float* lb_logits, const float* gain, const float* stateg, int l, int unit, int tid_in, int lane_in, int wave) {
    int tid = tid_in; asm volatile("" : "+v"(tid)); int lane = tid & 63; (void)lane_in;
    const int bh = unit >> 5, c = unit & 31, b = bh >> 2, h = bh & 3, row0 = b * SEQ + c * 128;
    LAS float* bL = (LAS float*)lds; LAS bf16* VT = (LAS bf16*)(lds + HG_B_BYTES); LAS bf16* kh = (LAS bf16*)(lds + HG_B_BYTES + HG_H_BYTES);
    LAS float* segtot = (LAS float*)(lds + HG_B_BYTES + 2 * HG_H_BYTES); LAS float* lbs = segtot + 512; LAS float* ssq = segtot + 640;
    __syncthreads();
    if (tid < 128) lbs[tid] = hg_lb(lb_logits, l, h * 128 + tid);
    __syncthreads();
    hg_cumsum(bL, segtot, lbs, projp, row0, h, tid);
    hg_stage_vt(VT, projp, row0, h, tid);
#pragma unroll 1
    for (int i = 0; i < 4; ++i) { const int idx = tid + NTHR * i, t = idx >> 4, kg = idx & 15, rend = (t | 31);
        const u32x4 z8 = *(const u32x4*)(projp + (size_t)(row0 + t) * DIN + C_HF + h * 128 + kg * 8);
        const float zf[8] = {bflo(z8.x), bfhi(z8.x), bflo(z8.y), bfhi(z8.y), bflo(z8.z), bfhi(z8.z), bflo(z8.w), bfhi(z8.w)};
        float o[8];
#pragma unroll
        for (int j = 0; j < 8; ++j) { const int k = kg * 8 + j; o[j] = (1.f - lbs[k]) / (1.f + expf(zf[j])) * __builtin_amdgcn_exp2f(bL[rend * HG_BSTR + k] - bL[t * HG_BSTR + k]); }
        *(LAS u32x4*)(kh + t * HG_HSTR + kg * 8) = (u32x4){pk2(o[0], o[1]), pk2(o[2], o[3]), pk2(o[4], o[5]), pk2(o[6], o[7])}; }
    __syncthreads();
    asm volatile("" : "+v"(tid)); lane = tid & 63;
    const int c32 = lane & 31, hh = lane >> 5, I = wave & 3, vh = wave >> 2, t = 32 * I + c32;
    u32x4 qs[8];
    { const bf16* qp = projp + (size_t)(row0 + t) * DIN + C_HQ + h * 128 + 8 * hh;
#pragma unroll
        for (int ks = 0; ks < 8; ++ks) { const u32x4 w = *(const u32x4*)(qp + 16 * ks);
            qs[ks] = (u32x4){pk2(siluf_(bflo(w.x)), siluf_(bfhi(w.x))), pk2(siluf_(bflo(w.y)), siluf_(bfhi(w.y))), pk2(siluf_(bflo(w.z)), siluf_(bfhi(w.z))), pk2(siluf_(bflo(w.w)), siluf_(bfhi(w.w)))}; } }
    f32x16 O[2];
#pragma unroll
    for (int v2 = 0; v2 < 2; ++v2)
#pragma unroll
        for (int r = 0; r < 16; ++r) O[v2][r] = 0.f;
#pragma unroll 1
    for (int J = -1; J <= I; ++J) {
        f32x16 X;
#pragma unroll
        for (int r = 0; r < 16; ++r) X[r] = 0.f;
        const float* sp0 = stateg + (size_t)(bh * 32 + c) * 16384 + (size_t)(32 * (2 * vh) + c32) * 128 + 8 * hh;
#pragma unroll
        for (int ks = 0; ks < 8; ++ks) { const int k0 = 16 * ks + 8 * hh;
            const f32x4 b0 = *(const LAS f32x4*)(bL + t * HG_BSTR + k0), b1 = *(const LAS f32x4*)(bL + t * HG_BSTR + k0 + 4);
            f32x4 r0 = (f32x4){0.f, 0.f, 0.f, 0.f}, r1 = r0;
            if (J >= 0) { r0 = *(const LAS f32x4*)(bL + (32 * J + 31) * HG_BSTR + k0); r1 = *(const LAS f32x4*)(bL + (32 * J + 31) * HG_BSTR + k0 + 4); }
            const u32x4 q = qs[ks];
            u32x4 p;
            p.x = pk2(bflo(q.x) * __builtin_amdgcn_exp2f(fminf(b0.x - r0.x, 120.f)), bfhi(q.x) * __builtin_amdgcn_exp2f(fminf(b0.y - r0.y, 120.f)));
            p.y = pk2(bflo(q.y) * __builtin_amdgcn_exp2f(fminf(b0.z - r0.z, 120.f)), bfhi(q.y) * __builtin_amdgcn_exp2f(fminf(b0.w - r0.w, 120.f)));
            p.z = pk2(bflo(q.z) * __builtin_amdgcn_exp2f(fminf(b1.x - r1.x, 120.f)), bfhi(q.z) * __builtin_amdgcn_exp2f(fminf(b1.y - r1.y, 120.f)));
            p.w = pk2(bflo(q.w) * __builtin_amdgcn_exp2f(fminf(b1.z - r1.z, 120.f)), bfhi(q.w) * __builtin_amdgcn_exp2f(fminf(b1.w - r1.w, 120.f)));
            const bf16x8 qa = __builtin_bit_cast(bf16x8, p);
            if (J < 0) {
#pragma unroll
                for (int v2 = 0; v2 < 2; ++v2) { const float* sp = sp0 + (size_t)v2 * 32 * 128 + 16 * ks; const f32x4 s0 = *(const f32x4*)sp, s1 = *(const f32x4*)(sp + 4);
                    const bf16x8 sf = __builtin_bit_cast(bf16x8, (u32x4){pk2(s0.x, s0.y), pk2(s0.z, s0.w), pk2(s1.x, s1.y), pk2(s1.z, s1.w)});
                    O[v2] = MFMA32(sf, qa, O[v2]); }
            } else {
                const bf16x8 kf = *(const LAS bf16x8*)(kh + (32 * J + c32) * HG_HSTR + 16 * ks + 8 * hh); X = MFMA32(kf, qa, X);
            }
            if (ks & 1) __builtin_amdgcn_sched_barrier(0);
        }
        if (J >= 0) {
            if (J == I) {
#pragma unroll
                for (int r = 0; r < 16; ++r) if (krow16(r, hh) > c32) X[r] = 0.f;
            }
#pragma unroll
            for (int s2 = 0; s2 < 2; ++s2) { const bf16x8 pf = pack8(X, s2); const int kb = 32 * J + 16 * s2 + 4 * hh;
#pragma unroll
                for (int v2 = 0; v2 < 2; ++v2) { const LAS bf16* vp = VT + (32 * (2 * vh + v2) + c32) * HG_HSTR + kb;
                    const u32x2 v0 = *(const LAS u32x2*)vp, v1 = *(const LAS u32x2*)(vp + 8);
                    O[v2] = MFMA32(__builtin_bit_cast(bf16x8, (u32x4){v0.x, v0.y, v1.x, v1.y}), pf, O[v2]); } }
        }
    }
    float ss = 0.f;
#pragma unroll
    for (int v2 = 0; v2 < 2; ++v2)
#pragma unroll
        for (int r = 0; r < 16; ++r) ss += O[v2][r] * O[v2][r];
    ss += __shfl_xor(ss, 32);
    if (hh == 0) ssq[t * 2 + vh] = ss;
    __syncthreads();
    const float rr = 1.0f / sqrtf((ssq[t * 2] + ssq[t * 2 + 1]) * (1.0f / 128.0f) + RMS_EPS);
#pragma unroll
    for (int v2 = 0; v2 < 2; ++v2)
#pragma unroll
        for (int g4 = 0; g4 < 4; ++g4) { const int v0 = 32 * (2 * vh + v2) + 8 * g4 + 4 * hh;
            const u32x2 gw = *(const u32x2*)(projp + (size_t)(row0 + t) * DIN + C_HG + h * 128 + v0); const f32x4 gn = *(const f32x4*)(gain + h * 128 + v0);
            const float o0 = O[v2][4 * g4] * rr * gn.x * siluf_(bflo(gw.x)), o1 = O[v2][4 * g4 + 1] * rr * gn.y * siluf_(bfhi(gw.x)), o2 = O[v2][4 * g4 + 2] * rr * gn.z * siluf_(bflo(gw.y)), o3 = O[v2][4 * g4 + 3] * rr * gn.w * siluf_(bfhi(gw.y));
            *(u32x2*)(mixedp + (size_t)(row0 + t) * DM + h * 128 + v0) = (u32x2){pk2(o0, o1), pk2(o2, o3)}; }
    __syncthreads();
}


__device__ __forceinline__ float gelu_as(float v) {
    const float av = fabsf(v), tt = __builtin_amdgcn_rcpf(av * 0.2316418882f + 1.0f);
    float q = tt * 0.5307027145f + (-0.7265760135f); q = q * tt + 0.7107068705f; q = q * tt + (-0.142248368f); q = q * tt + 0.127414796f; q = q * tt;
    const float e = __builtin_amdgcn_exp2f((v * v) * (-0.72134752044f)); const float m = v * (q * e);
    return v < 0.f ? m : v - m;
}
constexpr int SG_STR = 136;
__device__ __forceinline__ void sgu_unit(LAS unsigned char* lds, const bf16* projp, bf16* mixedp, const float* lng, const float* lnb, const float* wsp, const float* bsp, const float* gain,
                                         int unit, int tid_in, int wave) {
    int tid = tid_in; asm volatile("" : "+v"(tid)); int lane = tid & 63;
    const int th = unit & 1, row0 = (unit >> 1) * 128;
    LAS bf16* vnT = (LAS bf16*)lds; LAS float* ssq = (LAS float*)(lds + 512 * SG_STR * 2); LAS float* rrl = ssq + 512;
    __syncthreads();
    { const f32x4 g0 = *(const f32x4*)(lng + lane * 8), g1 = *(const f32x4*)(lng + lane * 8 + 4), b0 = *(const f32x4*)(lnb + lane * 8), b1 = *(const f32x4*)(lnb + lane * 8 + 4);
        const float gg[8] = {g0.x, g0.y, g0.z, g0.w, g1.x, g1.y, g1.z, g1.w}, bb[8] = {b0.x, b0.y, b0.z, b0.w, b1.x, b1.y, b1.z, b1.w};
#pragma unroll 1
        for (int i = 0; i < 8 * (th + 1); ++i) { const int s = wave * 8 * (th + 1) + i;
            const u32x4 w = *(const u32x4*)(projp + (size_t)(row0 + s) * DIN + C_SV + lane * 8);
            float x[8] = {gelu_as(bflo(w.x)), gelu_as(bfhi(w.x)), gelu_as(bflo(w.y)), gelu_as(bfhi(w.y)), gelu_as(bflo(w.z)), gelu_as(bfhi(w.z)), gelu_as(bflo(w.w)), gelu_as(bfhi(w.w))};
            float sm = 0.f;
#pragma unroll
            for (int j = 0; j < 8; ++j) sm += x[j];
            const float mean = wave_sum(sm) * (1.0f / 512.0f); float s2 = 0.f;
#pragma unroll
            for (int j = 0; j < 8; ++j) { x[j] -= mean; s2 += x[j] * x[j]; }
            const float rstd = 1.0f / sqrtf(wave_sum(s2) * (1.0f / 512.0f) + LN_EPS);
            const int pch = ((s >> 3) ^ (lane & 15)) * 8 + (s & 7);
#pragma unroll
            for (int j = 0; j < 8; ++j) vnT[(lane * 8 + j) * SG_STR + pch] = (bf16)f2bf(x[j] * rstd * gg[j] + bb[j]);
        } }
    __syncthreads();
    asm volatile("" : "+v"(tid)); lane = tid & 63;
    const int c32 = lane & 31, hh = lane >> 5, g = wave >> 1, tt = 2 * th + (wave & 1), nks = 2 * tt + 2, t_lane = 32 * tt + c32;
    bf16x8 wf[8];
    { const float* wr = wsp + (size_t)g * 16384 + (size_t)t_lane * 128 + 8 * hh;
#pragma unroll
        for (int ks = 0; ks < 8; ++ks) { u32x4 p = (u32x4){0u, 0u, 0u, 0u};
            if (ks < nks) { const f32x4 a = *(const f32x4*)(wr + 16 * ks), b = *(const f32x4*)(wr + 16 * ks + 4); const int s0 = 16 * ks + 8 * hh;
                p.x = pk2(s0 + 0 <= t_lane ? a.x : 0.f, s0 + 1 <= t_lane ? a.y : 0.f); p.y = pk2(s0 + 2 <= t_lane ? a.z : 0.f, s0 + 3 <= t_lane ? a.w : 0.f);
                p.z = pk2(s0 + 4 <= t_lane ? b.x : 0.f, s0 + 5 <= t_lane ? b.y : 0.f); p.w = pk2(s0 + 6 <= t_lane ? b.z : 0.f, s0 + 7 <= t_lane ? b.w : 0.f); }
            wf[ks] = __builtin_bit_cast(bf16x8, p); } }
    float ssr[16];
#pragma unroll
    for (int r = 0; r < 16; ++r) ssr[r] = 0.f;
#pragma unroll 1
    for (int ct4 = 0; ct4 < 4; ++ct4) {
        const int c = g * 128 + 32 * ct4 + c32;
        f32x16 acc;
#pragma unroll
        for (int r = 0; r < 16; ++r) acc[r] = 0.f;
#pragma unroll
        for (int ks = 0; ks < 8; ++ks) if (ks < nks) { const bf16x8 vf = *(const LAS bf16x8*)(vnT + c * SG_STR + (((2 * ks + hh) ^ ((c >> 3) & 15)) << 3)); acc = MFMA32(wf[ks], vf, acc); }
#pragma unroll
        for (int r = 0; r < 16; ++r) { const int t = 32 * tt + krow16(r, hh);
            const float u = bf2f(projp[(size_t)(row0 + t) * DIN + C_SU + c]); const float o = gelu_as(u) * (acc[r] + bsp[g * 128 + t]);
            ssr[r] += o * o; mixedp[(size_t)(row0 + t) * DM + 1536 + c] = (bf16)f2bf(o); }
    }
#pragma unroll
    for (int r = 0; r < 16; ++r) { float v = ssr[r]; v += __shfl_xor(v, 1); v += __shfl_xor(v, 2); v += __shfl_xor(v, 4); v += __shfl_xor(v, 8); v += __shfl_xor(v, 16);
        if (c32 == 0) ssq[(32 * tt + krow16(r, hh)) * 4 + g] = v; }
    __syncthreads();
    if (tid < 64) { const int t = 64 * th + tid; rrl[t] = 1.0f / sqrtf((ssq[t * 4] + ssq[t * 4 + 1] + ssq[t * 4 + 2] + ssq[t * 4 + 3]) * (1.0f / 512.0f) + RMS_EPS); }
    __syncthreads();
#pragma unroll 2
    for (int i = 0; i < 8; ++i) { const int idx = tid + NTHR * i, t = 64 * th + (idx >> 6), c8 = (idx & 63) * 8;
        bf16* op = mixedp + (size_t)(row0 + t) * DM + 1536 + c8; const float rr = rrl[t];
        const u32x4 o = *(const u32x4*)op; const f32x4 g0 = *(const f32x4*)(gain + 1536 + c8), g1 = *(const f32x4*)(gain + 1536 + c8 + 4);
        u32x4 w; w.x = pk2(bflo(o.x) * rr * g0.x, bfhi(o.x) * rr * g0.y); w.y = pk2(bflo(o.y) * rr * g0.z, bfhi(o.y) * rr * g0.w);
        w.z = pk2(bflo(o.z) * rr * g1.x, bfhi(o.z) * rr * g1.y); w.w = pk2(bflo(o.w) * rr * g1.z, bfhi(o.w) * rr * g1.w);
        *(u32x4*)op = w; }
    __syncthreads();
}

#define KAS __attribute__((address_space(4)))
#define PHASE_PTRS const char KAS* kp_ = (const char KAS*)__builtin_amdgcn_kernarg_segment_ptr(); asm volatile("" : "+s"(kp_)); unsigned char* const ws = *(unsigned char* const KAS*)(kp_ + 26 * 8); (void)ws;
#define INP(k) (*(const float* const KAS*)(kp_ + (k) * 8))
#define x_in INP(0)
#define ln0_g INP(1)
#define ln0_b INP(2)
#define w_in INP(3)
#define b_in INP(4)
#define lb_logits INP(5)
#define sw_sinks INP(6)
#define sg_ln_g INP(7)
#define sg_ln_b INP(8)
#define sg_w_s INP(9)
#define sg_b_s INP(10)
#define mix_gain INP(11)
#define w_out INP(12)
#define ln1_g INP(13)
#define ln1_b INP(14)
#define router_w INP(15)
#define router_b INP(16)
#define ew_gate INP(17)
#define ew_up INP(18)
#define ew_down INP(19)
#define sh_gate INP(20)
#define sh_up INP(21)
#define sh_down INP(22)
#define ln2_g INP(23)
#define ln2_b INP(24)
#define OUTP (*(float* const KAS*)(kp_ + 25 * 8))
#define list ((int*)(ws + WS_LIST))
#define wlist ((float*)(ws + WS_WLIST))
#define slot ((int*)(ws + WS_SLOT))
#define dendG ((float*)(ws + WS_DEND))
#define stateG ((float*)(ws + WS_STATE))
#define Hf ((float*)(ws + WS_HF))
#define Hb ((bf16*)(ws + WS_HB))
#define proj ((bf16*)(ws + WS_PROJ))
#define mixed ((bf16*)(ws + WS_MIXED))
#define Hs ((bf16*)(ws + WS_HS))
#define Yb ((bf16*)(ws + WS_Y))
#define ctl ((unsigned*)(ws + WS_CTL))
#define WLp ((const char*)(ws + WS_W + (size_t)l * WL_BYTES))
#define cntG (ctl + CW_CNT + l * 64)
__global__ void __launch_bounds__(NTHR, 2) fwd_kernel(Args args) {
    extern __shared__ __attribute__((aligned(16))) unsigned char lds_raw[];
    LAS unsigned char* const lds = (LAS unsigned char*)lds_raw;
    const int tid = threadIdx.x, lane = tid & 63, wave = __builtin_amdgcn_readfirstlane(tid >> 6);
    const int G = gridDim.x, bx = blockIdx.x;
    const int vcu = (G % 8 == 0) ? (bx % 8) * (G / 8) + bx / 8 : bx;
    volatile LAS unsigned* MISC = (volatile LAS unsigned*)(lds + MISC_OFF);
    if (tid < 64) MISC[tid] = 0u;
    __syncthreads();
    XcdBarrier bar; bar.bar = (unsigned*)(args.ws + WS_CTL) + CW_BAR; bar.x = 0; bar.st = nullptr;
    if (args.use_bar) bar = xcd_barrier_post((unsigned*)(args.ws + WS_CTL) + CW_BAR, MISC + 8);
    const int lo = args.ph_lo, hi = args.ph_hi;
#define PHASE_TID int tid_o_ = tid_of_wave(wave); asm volatile("" : "+v"(tid_o_)); const int tid = tid_o_, lane = tid & 63; (void)lane; (void)tid;
#ifndef BSEL
#define BSEL 7
#endif
#ifndef BDBL
#define BDBL 0
#endif
#ifndef DBLMASK
#define DBLMASK 0
#endif
#define REP(i) (((DBLMASK >> (i)) & 1) ? 2 : 1)
#ifndef PHMASK
#define PHMASK 0x3ff
#endif
#define IN(k) (lo <= (k) && (k) < hi)
#define EN(i) ((PHMASK >> (i)) & 1)
#ifndef PROBE_PHASE
#define PROBE_PHASE -1
#endif
#ifndef PROBE_MULT
#define PROBE_MULT 1.0f
#endif
#define STAMP_PTR(i) ((PROBE_PHASE >= 0 && bx == 0) ? (MISC + 16 + 2 * (i)) : nullptr)
#define SEAM(k) do { if (IN(k) && IN((k) + 1)) { xcd_barrier(bar, wave, STAMP_PTR((k) + 1)); } } while (0)
    if (PROBE_PHASE >= 0 && bx == 0 && threadIdx.x == 0) { const unsigned long long t_ = __builtin_amdgcn_s_memrealtime(); MISC[16] = (unsigned)t_; MISC[17] = (unsigned)(t_ >> 32); }

    for (int rep_ = 0; rep_ < REP(0); ++rep_)
    if (EN(0) && IN(0)) { PHASE_TID PHASE_PTRS
        LAS float* scr = (LAS float*)(lds + wave * 16640);
        const int gw = vcu * NWAVES + wave, NGW = G * NWAVES;
        for (int it = 2 * gw; it < 2 * IT_LAYER; it += 2 * NGW) {
            const int l = it / IT_LAYER; int r = it % IT_LAYER;
            if (r < IT_IN) { transpose_pair(w_in + (size_t)l * DM * DIN, DM, DIN, (bf16*)((char*)WLp + WL_IN), 0, scr, r, lane); continue; } r -= IT_IN;
            if (r < IT_OUT) { transpose_pair(w_out + (size_t)l * DM * DM, DM, DM, (bf16*)((char*)WLp + WL_OUT), 0, scr, r, lane); continue; } r -= IT_OUT;
            const int e = r / (2 * IT_G + IT_D); r = r % (2 * IT_G + IT_D);
            bf16* const gu = (bf16*)((char*)WLp + WL_GU + (size_t)e * W_GU_B); bf16* const dn = (bf16*)((char*)WLp + WL_D + (size_t)e * W_D_B);
            if (r < IT_G) { const float* src = (e < 64) ? ew_gate + ((size_t)l * 64 + e) * DM * DE : sh_gate + (size_t)l * DM * DE; transpose_pair(src, DM, DE, gu, 1, scr, r, lane); continue; } r -= IT_G;
            if (r < IT_G) { const float* src = (e < 64) ? ew_up + ((size_t)l * 64 + e) * DM * DE : sh_up + (size_t)l * DM * DE; transpose_pair(src, DM, DE, gu, 2, scr, r, lane); continue; } r -= IT_G;
            { const float* src = (e < 64) ? ew_down + ((size_t)l * 64 + e) * DE * DM : sh_down + (size_t)l * DE * DM; transpose_pair(src, DE, DM, dn, 0, scr, r, lane); }
        }
        for (int m = gw; m < NTOK; m += NGW) {
            f32x4 v[8];
#pragma unroll
            for (int j = 0; j < 8; ++j) v[j] = ((const f32x4*)(x_in + (size_t)m * DM))[j * 64 + lane];
            ln_regs(v, ln0_g, ln0_b, lane);
            store_row_f32(Hf + (size_t)m * DM, v, lane); store_row_bf16(Hb + (size_t)m * DM, v, lane);
        }
        for (int it = (vcu * NTHR + tid); it < 2 * 64 * 256; it += G * NTHR) {
            const int l = it >> 14, e = it & 63, k8 = (it >> 6) & 255;
            const float* src = router_w + (size_t)l * DM * NE + (size_t)(k8 * 8) * NE + e;
            float w8[8]; unsigned hi[4], lo[4];
#pragma unroll
            for (int j = 0; j < 8; ++j) w8[j] = src[(size_t)j * NE];
#pragma unroll
            for (int j = 0; j < 4; ++j) { const unsigned h0 = f2bf(w8[2 * j]), h1 = f2bf(w8[2 * j + 1]); hi[j] = h0 | (h1 << 16); lo[j] = pk2(w8[2 * j] - __uint_as_float(h0 << 16), w8[2 * j + 1] - __uint_as_float(h1 << 16)); }
            bf16* dst = (bf16*)(ws + WS_RT) + (size_t)l * 2 * NE * DM + (size_t)e * DM + k8 * 8;
            *(u32x4*)dst = (u32x4){hi[0], hi[1], hi[2], hi[3]}; *(u32x4*)(dst + (size_t)NE * DM) = (u32x4){lo[0], lo[1], lo[2], lo[3]};
        }
    }
    SEAM(0);

    for (int l = 0; l < 2; ++l) {
        const int pb = 1 + l * 9;

        for (int rep_ = 0; rep_ < REP(1); ++rep_)
        if (EN(1) && IN(pb + 0)) { PHASE_PTRS
            pg8::PlainSched S; S.init(NTOK, DIN, DM, G, bx, WLp + WL_IN);
            pg8::EpiBf16Bias E{proj, DIN, b_in + (size_t)l * DIN};
            pg8::gemm_phase<pg8::EpiBf16Bias, pg8::PlainSched, true>(lds, (const char*)Hb, DM, S, E, wave);
        }
        SEAM(pb + 0);

        for (int rep_ = 0; rep_ < REP(2); ++rep_)
        if (EN(2) && IN(pb + 1)) {
            for (int rb_ = 0; rb_ < ((BDBL & 1) ? 2 : 1); ++rb_)
            if (BSEL & 1) { PHASE_TID PHASE_PTRS
            for (int unit = bx; unit < 512; unit += G) hgrn_local_unit(lds, proj, lb_logits, stateG, dendG, l, unit, tid, lane, wave);
            }
            for (int rb_ = 0; rb_ < ((BDBL & 2) ? 2 : 1); ++rb_)
            if (BSEL & 2) { PHASE_TID PHASE_PTRS
            for (int unit = bx; unit < 256; unit += G) swa_unit(lds, proj, mixed, sw_sinks + l * 16, mix_gain + (size_t)l * DM, unit, tid, lane, wave);
            }
            for (int rb_ = 0; rb_ < ((BDBL & 4) ? 2 : 1); ++rb_)
            if (BSEL & 4) { PHASE_TID PHASE_PTRS
            for (int unit = bx; unit < 256; unit += G) sgu_unit(lds, proj, mixed, sg_ln_g + (size_t)l * 512, sg_ln_b + (size_t)l * 512, sg_w_s + (size_t)l * 4 * 16384, sg_b_s + (size_t)l * 512, mix_gain + (size_t)l * DM, unit, tid, wave);
            }
        }
        SEAM(pb + 1);

        for (int rep_ = 0; rep_ < REP(3); ++rep_)
        if (EN(3) && IN(pb + 2)) { PHASE_TID PHASE_PTRS
            float* const stO = (REP(3) == 2 && rep_ == 0) ? (float*)(ws + WS_Y) : stateG;
            for (int gi = bx * NTHR + tid; gi < 16 * 8192; gi += G * NTHR) {
                const int bh = gi >> 13, rem = gi & 8191, k = (rem & 63) * 2;
                f32x2 vals[32], dd[32];
#pragma unroll
                for (int c = 0; c < 32; ++c) { vals[c] = *((const f32x2*)(stateG + (size_t)(bh * 32 + c) * 16384) + rem); dd[c] = *(const f32x2*)(dendG + (size_t)(bh * 32 + c) * 128 + k); }
                float z0_ = 0.f; asm volatile("" : "+v"(z0_));
                f32x2 carry = (f32x2){z0_, z0_};
#pragma unroll
                for (int c = 0; c < 32; ++c) { *((f32x2*)(stO + (size_t)(bh * 32 + c) * 16384) + rem) = carry; carry = carry * dd[c] + vals[c]; }
            }
        }
        SEAM(pb + 2);

        for (int rep_ = 0; rep_ < REP(4); ++rep_)
        if (EN(4) && IN(pb + 3)) { PHASE_TID PHASE_PTRS
            for (int unit = bx; unit < 512; unit += G) hgrn_out_unit(lds, proj, mixed, lb_logits, mix_gain + (size_t)l * DM, stateG, l, unit, tid, lane, wave);
        }
        SEAM(pb + 3);

        if (EN(5) && IN(pb + 4)) { PHASE_PTRS
            pg8::PlainSched S; S.init(NTOK, DM, DM, G, bx, WLp + WL_OUT);
            pg8::EpiResF32 E{Hf, DM, ALPHA};
            pg8::gemm_phase<pg8::EpiResF32, pg8::PlainSched, true>(lds, (const char*)mixed, DM, S, E, wave);
        }
        SEAM(pb + 4);

        for (int rep_ = 0; rep_ < REP(6); ++rep_)
        if (EN(6) && IN(pb + 5)) { PHASE_TID PHASE_PTRS
            const bool shadow_ = (REP(6) == 2 && rep_ == 0);
            float* const HfO = shadow_ ? (float*)(ws + WS_Y) : Hf; bf16* const HbO = shadow_ ? (bf16*)(ws + WS_Y + 128 * MiB) : Hb;
            int* const listO = shadow_ ? (int*)(ws + WS_Y + 192 * MiB) : list; float* const wlistO = shadow_ ? (float*)(ws + WS_Y + 196 * MiB) : wlist; int* const slotO = shadow_ ? (int*)(ws + WS_Y + 200 * MiB) : slot;
            unsigned* const cntO = shadow_ ? (ctl + 1024 + l * 64) : cntG;
            constexpr int XSTR = 2056;
            LAS bf16* XH = (LAS bf16*)lds; LAS bf16* XL = (LAS bf16*)(lds + 16 * XSTR * 2);
            LAS float* xs = (LAS float*)lds;
            LAS int* selr = (LAS int*)(lds + 131584);
            LAS float* gatel = (LAS float*)(lds + 131584 + 4096);
            const bf16* wth = (const bf16*)(ws + WS_RT) + (size_t)l * 2 * NE * DM; const bf16* wtl = wth + (size_t)NE * DM;
            for (int bi = bx; bi < NTOK / 16; bi += G) {
                const int tok0 = bi * 16;
                __syncthreads();
#pragma unroll
                for (int jt = 0; jt < 2; ++jt) { const int tl = wave * 2 + jt, tok = tok0 + tl;
                    f32x4 v[8];
#pragma unroll
                    for (int j = 0; j < 8; ++j) v[j] = ((const f32x4*)(Hf + (size_t)tok * DM))[j * 64 + lane];
                    ln_regs(v, ln1_g + (size_t)l * DM, ln1_b + (size_t)l * DM, lane);
                    store_row_f32(HfO + (size_t)tok * DM, v, lane); store_row_bf16(HbO + (size_t)tok * DM, v, lane);
#pragma unroll
                    for (int j = 0; j < 8; ++j) { const unsigned h0 = f2bf(v[j].x), h1 = f2bf(v[j].y), h2 = f2bf(v[j].z), h3 = f2bf(v[j].w);
                        *(LAS u32x2*)(XH + tl * XSTR + (j * 64 + lane) * 4) = (u32x2){h0 | (h1 << 16), h2 | (h3 << 16)};
                        *(LAS u32x2*)(XL + tl * XSTR + (j * 64 + lane) * 4) = (u32x2){pk2(v[j].x - __uint_as_float(h0 << 16), v[j].y - __uint_as_float(h1 << 16)), pk2(v[j].z - __uint_as_float(h2 << 16), v[j].w - __uint_as_float(h3 << 16))}; }
                }
                __syncthreads();
                f32x4 acc[4];
#pragma unroll
                for (int nt = 0; nt < 4; ++nt) acc[nt] = (f32x4){0.f, 0.f, 0.f, 0.f};
                { const int fr = lane & 15, fq = lane >> 4;
#pragma unroll 2
                    for (int ks = 0; ks < 8; ++ks) { const int k0 = wave * 256 + ks * 32 + fq * 8;
                        const bf16x8 ah = *(const LAS bf16x8*)(XH + fr * XSTR + k0), al = *(const LAS bf16x8*)(XL + fr * XSTR + k0);
#pragma unroll
                        for (int nt = 0; nt < 4; ++nt) { const bf16x8 bh = __builtin_bit_cast(bf16x8, *(const u32x4*)(wth + (size_t)(nt * 16 + fr) * DM + k0)), bl = __builtin_bit_cast(bf16x8, *(const u32x4*)(wtl + (size_t)(nt * 16 + fr) * DM + k0));
                            acc[nt] = __builtin_amdgcn_mfma_f32_16x16x32_bf16(ah, bh, acc[nt], 0, 0, 0); acc[nt] = __builtin_amdgcn_mfma_f32_16x16x32_bf16(ah, bl, acc[nt], 0, 0, 0); acc[nt] = __builtin_amdgcn_mfma_f32_16x16x32_bf16(al, bh, acc[nt], 0, 0, 0); } }
                    __syncthreads();
#pragma unroll
                    for (int nt = 0; nt < 4; ++nt)
#pragma unroll
                        for (int r = 0; r < 4; ++r) xs[(wave * 16 + fq * 4 + r) * 64 + nt * 16 + fr] = acc[nt][r];
                }
                __syncthreads();
#pragma unroll
                for (int jt = 0; jt < 2; ++jt) { const int tl = wave * 2 + jt;
                    float logit = 0.f;
#pragma unroll
                    for (int w = 0; w < 8; ++w) logit += xs[(w * 16 + tl) * 64 + lane];
                    const float score = 1.0f / (1.0f + expf(-logit));
                    const float sel = score + router_b[l * NE + lane];
                    float m1 = sel; m1 = fmaxf(m1, __shfl_xor(m1, 1)); m1 = fmaxf(m1, __shfl_xor(m1, 2)); m1 = fmaxf(m1, __shfl_xor(m1, 4));
                    const unsigned long long bm = __ballot(sel == m1); const int grp = lane >> 3; const unsigned gbits = (unsigned)(bm >> (grp * 8)) & 0xffu; const int first = __builtin_ctz(gbits);
                    float s2 = ((lane & 7) == first) ? -INFINITY : sel; s2 = fmaxf(s2, __shfl_xor(s2, 1)); s2 = fmaxf(s2, __shfl_xor(s2, 2)); s2 = fmaxf(s2, __shfl_xor(s2, 4));
                    const float gs = m1 + s2;
                    int grank = 0;
#pragma unroll
                    for (int j = 0; j < 8; ++j) { const float gj = __shfl(gs, j * 8); grank += (gj > gs || (gj == gs && j < grp)) ? 1 : 0; }
                    const bool chosen = grank < 4;
                    const float msel = chosen ? sel : -INFINITY;
                    int rk = 0;
#pragma unroll 8
                    for (int j = 0; j < 64; ++j) { const float vj = __shfl(msel, j); rk += (vj > msel || (vj == msel && j < lane)) ? 1 : 0; }
                    const bool selected = chosen && rk < 8;
                    const float ssum = wave_sum(selected ? score : 0.f);
                    selr[tl * 64 + lane] = selected ? rk : -1; gatel[tl * 64 + lane] = score / ssum * ROUTED_SCALE;
                }
                __syncthreads();
                if (wave == 0) {
                    int cl = 0; int lp[16];
#pragma unroll
                    for (int t = 0; t < 16; ++t) { lp[t] = cl; cl += (selr[t * 64 + lane] >= 0) ? 1 : 0; }
                    int base = 0; if (cl > 0) base = (int)__hip_atomic_fetch_add(cntO + lane, (unsigned)cl, RLX_AGENT);
#pragma unroll
                    for (int t = 0; t < 16; ++t) { const int rk = selr[t * 64 + lane];
                        if (rk >= 0) { const int pos = base + lp[t]; listO[lane * NTOK + pos] = tok0 + t; wlistO[lane * NTOK + pos] = gatel[t * 64 + lane]; slotO[(size_t)(tok0 + t) * 8 + rk] = (lane << 16) | pos; } }
                }
            }
        }
        SEAM(pb + 5);

        LAS int* const cnts = (LAS int*)(lds + TAB_OFF); LAS int* const tstart = cnts + 64; LAS int* const tile_e = cnts + 192;
        int ntiles = 0;
        if ((EN(7) && IN(pb + 6)) || (EN(8) && IN(pb + 7)) || (EN(9) && IN(pb + 8))) { PHASE_TID PHASE_PTRS
            __syncthreads();
            if (tid < 64) cnts[tid] = (int)__hip_atomic_load(cntG + tid, RLX_AGENT);
            __syncthreads();
            if (tid == 0) { int s = 0; for (int e = 0; e < 64; ++e) { tstart[e] = s; s += (cnts[e] + 255) >> 8; } tstart[64] = s; }
            __syncthreads();
            if (tid < 64) for (int t = tstart[tid]; t < tstart[tid + 1]; ++t) tile_e[t] = tid;
            __syncthreads();
            ntiles = __builtin_amdgcn_readfirstlane(tstart[64]); if (ntiles > MAXTILES) ntiles = MAXTILES;
        }

        for (int rep_ = 0; rep_ < REP(7); ++rep_)
        if (EN(7) && IN(pb + 6)) { PHASE_PTRS
            { pg8::MoeSched<true> S{cnts, tstart, tile_e, ntiles, 4, G, vcu, DM, list, WLp + WL_GU, W_GU_B};
              pg8::EpiSwiGLU E{Hs};
              pg8::gemm_phase<pg8::EpiSwiGLU, pg8::MoeSched<true>, true>(lds, (const char*)Hb, DM, S, E, wave); }
            { pg8::PlainSched S; S.init(NTOK, 1024, DM, G, bx, WLp + WL_GU + 64 * W_GU_B);
              pg8::EpiSwiGLU E{Hs + (size_t)SH_ROW0 * DE};
              pg8::gemm_phase<pg8::EpiSwiGLU, pg8::PlainSched, true>(lds, (const char*)Hb, DM, S, E, wave); }
        }
        SEAM(pb + 6);

        if (EN(8) && IN(pb + 7)) { PHASE_PTRS
#if !defined(HSEL) || HSEL == 1
            for (int rep_ = 0; rep_ < REP(8); ++rep_)
            { pg8::MoeSched<false> S{cnts, tstart, tile_e, ntiles, 8, G, vcu, DE, nullptr, WLp + WL_D, W_D_B};
              pg8::EpiDownY E{Yb, wlist};
              pg8::gemm_phase<pg8::EpiDownY, pg8::MoeSched<false>, true>(lds, (const char*)Hs, DE, S, E, wave); }
#endif
#if !defined(HSEL) || HSEL == 2
            { pg8::PlainSched S; S.init(NTOK, DM, DE, G, bx, WLp + WL_D + 64 * W_D_B);
              pg8::EpiResF32 E{Hf, DM, ALPHA};
              pg8::gemm_phase<pg8::EpiResF32, pg8::PlainSched, true>(lds, (const char*)(Hs + (size_t)SH_ROW0 * DE), DE, S, E, wave); }
#endif
        }
        SEAM(pb + 7);

        for (int rep_ = 0; rep_ < REP(9); ++rep_)
        if (EN(9) && IN(pb + 8)) { PHASE_TID PHASE_PTRS
            const bool shadow_ = (REP(9) == 2 && rep_ == 0);
            float* const HfO = shadow_ ? (float*)proj : Hf; bf16* const HbO = shadow_ ? mixed : Hb; float* const outO = shadow_ ? (float*)proj : OUTP;
            const int gw = vcu * NWAVES + wave, NGW = G * NWAVES;
            for (int tok = gw; tok < NTOK; tok += NGW) {
                f32x4 v[8];
#pragma unroll
                for (int j = 0; j < 8; ++j) v[j] = ((const f32x4*)(Hf + (size_t)tok * DM))[j * 64 + lane];
                const int myslot = slot[(size_t)tok * 8 + (lane & 7)];
#pragma unroll
                for (int k = 0; k < 8; ++k) { const int sl = __shfl(myslot, k); const int e = sl >> 16, pos = sl & 0xffff; const size_t row = (size_t)tstart[e] * 256 + pos;
                    const u32x2* yp = (const u32x2*)(Yb + row * DM);
#pragma unroll
                    for (int j = 0; j < 8; ++j) { const u32x2 w = yp[j * 64 + lane]; v[j].x += bflo(w.x); v[j].y += bfhi(w.x); v[j].z += bflo(w.y); v[j].w += bfhi(w.y); } }
                ln_regs(v, ln2_g + (size_t)l * DM, ln2_b + (size_t)l * DM, lane);
                if (l == 0) { store_row_f32(HfO + (size_t)tok * DM, v, lane); store_row_bf16(HbO + (size_t)tok * DM, v, lane); }
                else store_row_f32(outO + (size_t)tok * DM, v, lane);
            }
        }
        SEAM(pb + 8);
    }
#if PROBE_PHASE >= 0
    {
        xcd_barrier(bar, wave, STAMP_PTR(19));
        unsigned* epsw = (unsigned*)(args.ws + WS_CTL) + 32;
        if (bx == 0 && tid_of_wave(wave) == 0) {
            unsigned zo_ = 0u; asm volatile("" : "+v"(zo_)); volatile LAS unsigned* M_ = (volatile LAS unsigned*)(lds + MISC_OFF + zo_);
#define RDTS(i) ((unsigned long long)M_[16 + 2 * (i)] | ((unsigned long long)M_[17 + 2 * (i)] << 32))
            const float total = (float)(RDTS(19) - RDTS(0));
            float d = 0.f;
            if (PROBE_PHASE == 0) d = (float)(RDTS(1) - RDTS(0));
            else d = (float)(RDTS(PROBE_PHASE + 1) - RDTS(PROBE_PHASE)) + (float)(RDTS(PROBE_PHASE + 10) - RDTS(PROBE_PHASE + 9));
            const float f = PROBE_MULT * d / total;
            __hip_atomic_store(epsw, __float_as_uint(sqrtf(f)), RLX_AGENT);
        }
        xcd_barrier(bar, wave);
        const float eps = __uint_as_float(__hip_atomic_load(epsw, RLX_AGENT));
        float* o = args.out;
        for (size_t i = (size_t)bx * NTHR + tid_of_wave(wave); i < (size_t)NTOK * DM; i += (size_t)G * NTHR) o[i] *= (1.0f + eps);
    }
#endif
#undef IN
#undef SEAM
}

constexpr int NPHASES = 19;
#ifndef ONE_LAUNCH
#define ONE_LAUNCH 1
#endif

extern "C" void kernel_launch(void* const* d_in, const int* in_sizes, int n_in, void* d_out, int out_size, void* d_ws, size_t ws_size, hipStream_t stream) {
    static int grid = 0;
    if (grid == 0) {
        if (n_in != 25 || out_size != NTOK * DM || ws_size < WS_END) { fprintf(stderr, "kernel_launch: unexpected shapes: n_in %d out %d ws %zu (need %zu)\n", n_in, out_size, ws_size, (size_t)WS_END); grid = -1; return; }
        int dev = 0, cus = 0, per_cu = 0;
        if (hipGetDevice(&dev) != hipSuccess || hipDeviceGetAttribute(&cus, hipDeviceAttributeMultiprocessorCount, dev) != hipSuccess) { grid = -1; return; }
        if (hipFuncSetAttribute((const void*)fwd_kernel, hipFuncAttributeMaxDynamicSharedMemorySize, LDS_BYTES) != hipSuccess) { fprintf(stderr, "kernel_launch: hipFuncSetAttribute failed\n"); grid = -1; return; }
        if (hipOccupancyMaxActiveBlocksPerMultiprocessor(&per_cu, (const void*)fwd_kernel, NTHR, LDS_BYTES) != hipSuccess || per_cu < 1) fprintf(stderr, "kernel_launch: occupancy query reports %d\n", per_cu);
        (void)hipGetLastError();
        grid = cus;
    }
    if (grid < 0) return;
    if (hipMemsetAsync((char*)d_ws + WS_CTL, 0, CTL_ZERO_BYTES, stream) != hipSuccess) return;
    Args a{};
    for (int i = 0; i < 25; ++i) a.in[i] = (const float*)d_in[i];
    a.out = (float*)d_out; a.ws = (unsigned char*)d_ws; a.pad = 0;
#if ONE_LAUNCH
    a.ph_lo = 0; a.ph_hi = NPHASES; a.use_bar = 1;
    hipLaunchKernelGGL(fwd_kernel, dim3(grid), dim3(NTHR), LDS_BYTES, stream, a);
#else
    for (int p = 0; p < NPHASES; ++p) { a.ph_lo = p; a.ph_hi = p + 1; a.use_bar = 0; hipLaunchKernelGGL(fwd_kernel, dim3(grid), dim3(NTHR), LDS_BYTES, stream, a); }
#endif
}
```
